# Optimizing an MI355X kernel written in HIP

```python
import math
import jax, jax.numpy as jnp
from jax import lax
import numpy as np

D_MODEL = 1024
BATCH = 4
SEQ = 4096
DEPTH = 2

D_MIX = D_MODEL
D_SSM = D_MIX // 2
D_ATTN = D_MIX - D_SSM
SSM_P = 16
SSM_G = D_SSM // SSM_P
SSM_N = 64
HEAD_DIM = 64
N_HEADS = D_ATTN // HEAD_DIM
D_IN = D_SSM + 3 * D_ATTN + N_HEADS
D_FF = 4 * D_MODEL
Q_BLOCK = 128
EPS = 1e-6
DT_MIN = 1e-3
DT_MAX = 1e-1

kernel_name = "hybrid_s5_fox_parallel_heads"


def rms_norm(x, g):
    xf = x.astype(jnp.float32)
    out = xf * lax.rsqrt(jnp.mean(xf * xf, axis=-1, keepdims=True) + EPS)
    return (out * g.astype(jnp.float32)).astype(x.dtype)


def _ssm_combine(left, right):
    ar1, ai1, br1, bi1 = left
    ar2, ai2, br2, bi2 = right
    ar = ar2 * ar1 - ai2 * ai1
    ai = ar2 * ai1 + ai2 * ar1
    br = ar2 * br1 - ai2 * bi1 + br2
    bi = ar2 * bi1 + ai2 * br1 + bi2
    return (ar, ai, br, bi)


def s5_mixer(u, log_dt, lam_re, lam_im, b_re, b_im, c_re, c_im, d_skip, glu_w, glu_b):
    f32 = jnp.float32
    bsz, seq, _ = u.shape
    uf = u.astype(f32).reshape(bsz, seq, SSM_G, SSM_P).transpose(1, 0, 2, 3)
    lam_re = lam_re.astype(f32)
    lam_im = lam_im.astype(f32)
    dt = jnp.exp(log_dt.astype(f32))[:, None]
    mag = jnp.exp(lam_re * dt)
    a_re = mag * jnp.cos(lam_im * dt)
    a_im = mag * jnp.sin(lam_im * dt)
    den = lam_re * lam_re + lam_im * lam_im
    nr = a_re - 1.0
    s_re = (nr * lam_re + a_im * lam_im) / den
    s_im = (a_im * lam_re - nr * lam_im) / den
    b_re = b_re.astype(f32)
    b_im = b_im.astype(f32)
    bb_re = s_re[..., None] * b_re - s_im[..., None] * b_im
    bb_im = s_re[..., None] * b_im + s_im[..., None] * b_re
    bu_re = jnp.einsum('lbgp,gnp->lbgn', uf, bb_re)
    bu_im = jnp.einsum('lbgp,gnp->lbgn', uf, bb_im)
    a_re_l = jnp.broadcast_to(a_re[None, None], (seq, 1, SSM_G, SSM_N))
    a_im_l = jnp.broadcast_to(a_im[None, None], (seq, 1, SSM_G, SSM_N))
    _, _, x_re, x_im = lax.associative_scan(_ssm_combine, (a_re_l, a_im_l, bu_re, bu_im), axis=0)
    y = (jnp.einsum('lbgn,gpn->lbgp', x_re, c_re.astype(f32))
         - jnp.einsum('lbgn,gpn->lbgp', x_im, c_im.astype(f32)))
    y = y + d_skip.astype(f32).reshape(SSM_G, SSM_P) * uf
    y = y.transpose(1, 0, 2, 3).reshape(bsz, seq, D_SSM)
    g = jax.nn.gelu(y)
    out = g * jax.nn.sigmoid(g @ glu_w.astype(f32) + glu_b.astype(f32))
    return out.astype(u.dtype)


def forgetting_attention(q, k, v, f_logit, f_bias):
    bsz, seq, _ = q.shape
    def heads(t):
        return t.reshape(bsz, seq, N_HEADS, HEAD_DIM).transpose(0, 2, 1, 3)
    qh, kh, vh = heads(q), heads(k), heads(v)
    log_f = jax.nn.log_sigmoid(f_logit.astype(jnp.float32) + f_bias.astype(jnp.float32))
    csum = jnp.cumsum(log_f, axis=1).transpose(0, 2, 1)
    scale = 1.0 / math.sqrt(HEAD_DIM)
    outs = []
    for i in range(seq // Q_BLOCK):
        q0 = i * Q_BLOCK
        kend = q0 + Q_BLOCK
        qb = qh[:, :, q0:kend]
        kb = kh[:, :, :kend]
        vb = vh[:, :, :kend]
        s = jnp.einsum('bhqd,bhkd->bhqk', qb, kb).astype(jnp.float32) * scale
        s = s + csum[:, :, q0:kend, None] - csum[:, :, None, :kend]
        mask = (q0 + jnp.arange(Q_BLOCK))[:, None] >= jnp.arange(kend)[None, :]
        s = jnp.where(mask[None, None], s, -jnp.inf)
        p = jax.nn.softmax(s, axis=-1)
        outs.append(jnp.einsum('bhqk,bhkd->bhqd', p.astype(vb.dtype), vb))
    o = jnp.concatenate(outs, axis=2)
    return o.transpose(0, 2, 1, 3).reshape(bsz, seq, D_ATTN)


def sq_relu_mlp(x, w_up, w_down):
    h = jax.nn.relu(x @ w_up)
    return (h * h) @ w_down


def setup_inputs(seed: int = 0) -> dict:
    key = jax.random.key(seed)
    ks = jax.random.split(key, 22)
    f32 = jnp.float32
    nrm = lambda k, s: jax.random.normal(k, s, f32)
    x = nrm(ks[0], (BATCH, SEQ, D_MODEL))
    ln1_g = 1.0 + 0.02 * nrm(ks[1], (DEPTH, D_MODEL))
    w_in = nrm(ks[2], (DEPTH, D_MODEL, D_IN)) * D_MODEL ** -0.5
    gate_scale = jnp.concatenate([jnp.ones((D_IN - N_HEADS,), f32), jnp.full((N_HEADS,), 0.1, f32)])
    w_in = w_in * gate_scale
    ssm_log_dt = jax.random.uniform(ks[3], (DEPTH, SSM_G), f32, math.log(DT_MIN), math.log(DT_MAX))
    ssm_lambda_re = -0.5 + 0.01 * nrm(ks[4], (DEPTH, SSM_G, SSM_N))
    ssm_lambda_im = jnp.broadcast_to(jnp.pi * jnp.arange(SSM_N, dtype=f32), (DEPTH, SSM_G, SSM_N))
    b_scale = (2.0 * SSM_P) ** -0.5
    ssm_b_re = nrm(ks[5], (DEPTH, SSM_G, SSM_N, SSM_P)) * b_scale
    ssm_b_im = nrm(ks[6], (DEPTH, SSM_G, SSM_N, SSM_P)) * b_scale
    c_scale = (2.0 * SSM_N) ** -0.5
    ssm_c_re = nrm(ks[7], (DEPTH, SSM_G, SSM_P, SSM_N)) * c_scale
    ssm_c_im = nrm(ks[8], (DEPTH, SSM_G, SSM_P, SSM_N)) * c_scale
    ssm_d = nrm(ks[9], (DEPTH, D_SSM))
    glu_w = nrm(ks[10], (DEPTH, D_SSM, D_SSM)) * D_SSM ** -0.5
    glu_b = 0.01 * nrm(ks[11], (DEPTH, D_SSM))
    fgate_b = 4.0 + 0.5 * nrm(ks[12], (DEPTH, N_HEADS))
    gn_ssm_g = 1.0 + 0.02 * nrm(ks[13], (DEPTH, D_SSM))
    gn_attn_g = 1.0 + 0.02 * nrm(ks[14], (DEPTH, D_ATTN))
    w_out = nrm(ks[15], (DEPTH, D_MIX, D_MODEL)) * D_MIX ** -0.5
    ln2_g = 1.0 + 0.02 * nrm(ks[16], (DEPTH, D_MODEL))
    w_up = nrm(ks[17], (DEPTH, D_MODEL, D_FF)) * D_MODEL ** -0.5
    w_down = nrm(ks[18], (DEPTH, D_FF, D_MODEL)) * D_FF ** -0.5
    final_g = 1.0 + 0.02 * nrm(ks[19], (D_MODEL,))
    return {"x": x, "ln1_g": ln1_g, "w_in": w_in, "ssm_log_dt": ssm_log_dt,
            "ssm_lambda_re": ssm_lambda_re, "ssm_lambda_im": ssm_lambda_im,
            "ssm_b_re": ssm_b_re, "ssm_b_im": ssm_b_im, "ssm_c_re": ssm_c_re, "ssm_c_im": ssm_c_im,
            "ssm_d": ssm_d, "glu_w": glu_w, "glu_b": glu_b, "fgate_b": fgate_b,
            "gn_ssm_g": gn_ssm_g, "gn_attn_g": gn_attn_g, "w_out": w_out, "ln2_g": ln2_g,
            "w_up": w_up, "w_down": w_down, "final_g": final_g}


def reference(x, ln1_g, w_in, ssm_log_dt, ssm_lambda_re, ssm_lambda_im, ssm_b_re, ssm_b_im,
              ssm_c_re, ssm_c_im, ssm_d, glu_w, glu_b, fgate_b, gn_ssm_g, gn_attn_g, w_out,
              ln2_g, w_up, w_down, final_g):
    h = x
    splits = [D_SSM, D_SSM + D_ATTN, D_SSM + 2 * D_ATTN, D_SSM + 3 * D_ATTN]
    for l in range(DEPTH):
        xn = rms_norm(h, ln1_g[l])
        proj = xn @ w_in[l]
        u, q, k, v, f_logit = jnp.split(proj, splits, axis=-1)
        y_ssm = s5_mixer(u, ssm_log_dt[l], ssm_lambda_re[l], ssm_lambda_im[l], ssm_b_re[l],
                         ssm_b_im[l], ssm_c_re[l], ssm_c_im[l], ssm_d[l], glu_w[l], glu_b[l])
        y_att = forgetting_attention(q, k, v, f_logit, fgate_b[l])
        mixed = jnp.concatenate([rms_norm(y_ssm, gn_ssm_g[l]), rms_norm(y_att, gn_attn_g[l])], axis=-1)
        h = h + mixed @ w_out[l]
        h = h + sq_relu_mlp(rms_norm(h, ln2_g[l]), w_up[l], w_down[l])
    return rms_norm(h, final_g)
```

```cpp
#include <hip/hip_runtime.h>
#include <cstdio>
#include <cstdint>

constexpr int D_MODEL = 1024, BATCH = 4, SEQ = 4096, DEPTH = 2, M = BATCH * SEQ;
constexpr int D_SSM = 512, D_ATTN = 512, SSM_P = 16, SSM_G = 32, SSM_N = 64, HEAD_DIM = 64, N_HEADS = 8;
constexpr int D_IN = 2056, D_FF = 4096;
constexpr float EPS = 1e-6f;

__global__ __launch_bounds__(256) void rmsnorm_k(const float* in, int ld_in, const float* g, float* out, int ld_out, int D, int rows) {
    const int row = blockIdx.x * 4 + (threadIdx.x >> 6), lane = threadIdx.x & 63;
    if (row >= rows) return;
    const float* x = in + (size_t)row * ld_in;
    float ss = 0.f;
    for (int i = lane; i < D; i += 64) { const float v = x[i]; ss += v * v; }
#pragma unroll
    for (int o = 1; o < 64; o <<= 1) ss += __shfl_xor(ss, o);
    const float r = rsqrtf(ss / (float)D + EPS);
    float* y = out + (size_t)row * ld_out;
    for (int i = lane; i < D; i += 64) y[i] = x[i] * r * g[i];
}

template <int EPI>
__global__ __launch_bounds__(256) void gemm_f32(const float* A, int lda, const float* B, int ldb, float* C, int ldc, const float* R, int ldr, int Mrows, int N, int K) {
    __shared__ float As[16][132];
    __shared__ float Bs[16][132];
    const int tid = threadIdx.x, tx = tid & 15, ty = tid >> 4;
    const int m0 = blockIdx.y * 128, n0 = blockIdx.x * 128;
    float acc[8][8];
#pragma unroll
    for (int i = 0; i < 8; ++i)
#pragma unroll
        for (int j = 0; j < 8; ++j) acc[i][j] = 0.f;
    for (int k0 = 0; k0 < K; k0 += 16) {
#pragma unroll
        for (int p = 0; p < 2; ++p) {
            const int r = (tid >> 2) + p * 64, c4 = (tid & 3) * 4;
            const float4 v = *(const float4*)(A + (size_t)(m0 + r) * lda + k0 + c4);
            As[c4 + 0][r] = v.x; As[c4 + 1][r] = v.y; As[c4 + 2][r] = v.z; As[c4 + 3][r] = v.w;
        }
#pragma unroll
        for (int p = 0; p < 2; ++p) {
            const int r = (tid >> 5) + p * 8, c4 = (tid & 31) * 4;
            float4 v = make_float4(0.f, 0.f, 0.f, 0.f);
            if (n0 + c4 < N) v = *(const float4*)(B + (size_t)(k0 + r) * ldb + n0 + c4);
            *(float4*)&Bs[r][c4] = v;
        }
        __syncthreads();
#pragma unroll
        for (int kk = 0; kk < 16; ++kk) {
            float a[8], b[8];
            const float4 a0 = *(const float4*)&As[kk][ty * 8], a1 = *(const float4*)&As[kk][ty * 8 + 4];
            const float4 b0 = *(const float4*)&Bs[kk][tx * 8], b1 = *(const float4*)&Bs[kk][tx * 8 + 4];
            a[0] = a0.x; a[1] = a0.y; a[2] = a0.z; a[3] = a0.w; a[4] = a1.x; a[5] = a1.y; a[6] = a1.z; a[7] = a1.w;
            b[0] = b0.x; b[1] = b0.y; b[2] = b0.z; b[3] = b0.w; b[4] = b1.x; b[5] = b1.y; b[6] = b1.z; b[7] = b1.w;
#pragma unroll
            for (int i = 0; i < 8; ++i)
#pragma unroll
                for (int j = 0; j < 8; ++j) acc[i][j] = fmaf(a[i], b[j], acc[i][j]);
        }
        __syncthreads();
    }
#pragma unroll
    for (int i = 0; i < 8; ++i) {
        const int row = m0 + ty * 8 + i;
#pragma unroll
        for (int j4 = 0; j4 < 2; ++j4) {
            const int col = n0 + tx * 8 + j4 * 4;
            if (col < N) {
                float4 v = make_float4(acc[i][j4 * 4], acc[i][j4 * 4 + 1], acc[i][j4 * 4 + 2], acc[i][j4 * 4 + 3]);
                if (EPI == 1) { const float4 r = *(const float4*)(R + (size_t)row * ldr + col); v.x += r.x; v.y += r.y; v.z += r.z; v.w += r.w; }
                if (EPI == 2) { v.x = fmaxf(v.x, 0.f); v.y = fmaxf(v.y, 0.f); v.z = fmaxf(v.z, 0.f); v.w = fmaxf(v.w, 0.f); v.x *= v.x; v.y *= v.y; v.z *= v.z; v.w *= v.w; }
                *(float4*)(C + (size_t)row * ldc + col) = v;
            }
        }
    }
}

__global__ void ssm_params_k(const float* log_dt, const float* lam_re, const float* lam_im, const float* b_re, const float* b_im, float* a_out, float* bb_out) {
    const int i = blockIdx.x * blockDim.x + threadIdx.x;
    if (i >= SSM_G * SSM_N) return;
    const int g = i / SSM_N;
    const float dt = expf(log_dt[g]);
    const float lr = lam_re[i], li = lam_im[i];
    const float mag = expf(lr * dt);
    float sn, cs; sincosf(li * dt, &sn, &cs);
    const float are = mag * cs, aim = mag * sn;
    const float den = lr * lr + li * li, nr = are - 1.0f;
    const float sre = (nr * lr + aim * li) / den, sim = (aim * lr - nr * li) / den;
    a_out[i * 2] = are; a_out[i * 2 + 1] = aim;
    for (int p = 0; p < SSM_P; ++p) {
        const float br = b_re[i * SSM_P + p], bi = b_im[i * SSM_P + p];
        bb_out[(i * SSM_P + p) * 2] = sre * br - sim * bi;
        bb_out[(i * SSM_P + p) * 2 + 1] = sre * bi + sim * br;
    }
}

__global__ __launch_bounds__(64) void ssm_scan_k(const float* proj, const float* a, const float* bb, const float* c_re, const float* c_im, const float* d_skip, float* y) {
    const int b = blockIdx.x / SSM_G, g = blockIdx.x % SSM_G, n = threadIdx.x;
    float bbr[SSM_P], bbi[SSM_P], cr[SSM_P], ci[SSM_P];
#pragma unroll
    for (int p = 0; p < SSM_P; ++p) {
        bbr[p] = bb[((g * SSM_N + n) * SSM_P + p) * 2]; bbi[p] = bb[((g * SSM_N + n) * SSM_P + p) * 2 + 1];
        cr[p] = c_re[(g * SSM_P + p) * SSM_N + n]; ci[p] = c_im[(g * SSM_P + p) * SSM_N + n];
    }
    const float ar = a[(g * SSM_N + n) * 2], ai = a[(g * SSM_N + n) * 2 + 1];
    const float dsk = d_skip[g * SSM_P + (n & 15)];
    float xr = 0.f, xi = 0.f;
    for (int t = 0; t < SEQ; ++t) {
        const float* up = proj + (size_t)(b * SEQ + t) * D_IN + g * SSM_P;
        float u[SSM_P];
#pragma unroll
        for (int p = 0; p < SSM_P; ++p) u[p] = up[p];
        float bur = 0.f, bui = 0.f;
#pragma unroll
        for (int p = 0; p < SSM_P; ++p) { bur = fmaf(bbr[p], u[p], bur); bui = fmaf(bbi[p], u[p], bui); }
        const float nxr = ar * xr - ai * xi + bur, nxi = ar * xi + ai * xr + bui;
        xr = nxr; xi = nxi;
        float mine = 0.f;
#pragma unroll
        for (int p = 0; p < SSM_P; ++p) {
            float v = cr[p] * xr - ci[p] * xi;
#pragma unroll
            for (int o = 1; o < 64; o <<= 1) v += __shfl_xor(v, o);
            if ((n & 15) == p) mine = v + dsk * u[p];
        }
        if (n < SSM_P) y[(size_t)(b * SEQ + t) * D_SSM + g * SSM_P + n] = mine;
    }
}

__device__ __forceinline__ float gelu_tanh(float x) {
    const float k = 0.7978845608028654f;
    const float inner = k * (x + 0.044715f * x * x * x);
    return 0.5f * x * (1.0f + tanhf(inner));
}
__global__ void gelu_k(float* y, size_t n) {
    const size_t i = (size_t)blockIdx.x * blockDim.x + threadIdx.x;
    if (i < n) y[i] = gelu_tanh(y[i]);
}
__global__ __launch_bounds__(256) void glu_norm_k(float* gbuf, const float* z, const float* glu_b, const float* gn) {
    const int row = blockIdx.x * 4 + (threadIdx.x >> 6), lane = threadIdx.x & 63;
    float* gr = gbuf + (size_t)row * D_SSM; const float* zr = z + (size_t)row * D_SSM;
    float o[8]; float ss = 0.f;
#pragma unroll
    for (int j = 0; j < 8; ++j) { const int c = lane + 64 * j; const float zz = zr[c] + glu_b[c]; const float s = 1.0f / (1.0f + expf(-zz)); o[j] = gr[c] * s; ss += o[j] * o[j]; }
#pragma unroll
    for (int of = 1; of < 64; of <<= 1) ss += __shfl_xor(ss, of);
    const float r = rsqrtf(ss / (float)D_SSM + EPS);
#pragma unroll
    for (int j = 0; j < 8; ++j) { const int c = lane + 64 * j; gr[c] = o[j] * r * gn[c]; }
}

__global__ __launch_bounds__(256) void csum_k(const float* proj, const float* fbias, float* csum) {
    __shared__ float tot[256];
    const int b = blockIdx.x / N_HEADS, h = blockIdx.x % N_HEADS, tid = threadIdx.x;
    const float bias = fbias[h];
    float v[16]; float run = 0.f;
#pragma unroll
    for (int i = 0; i < 16; ++i) {
        const int t = tid * 16 + i;
        const float f = proj[(size_t)(b * SEQ + t) * D_IN + 2048 + h] + bias;
        const float ls = (f >= 0.f) ? -log1pf(expf(-f)) : (f - log1pf(expf(f)));
        run += ls; v[i] = run;
    }
    tot[tid] = run;
    __syncthreads();
    if (tid == 0) { float s = 0.f; for (int i = 0; i < 256; ++i) { const float x = tot[i]; tot[i] = s; s += x; } }
    __syncthreads();
    const float off = tot[tid];
#pragma unroll
    for (int i = 0; i < 16; ++i) csum[(size_t)(b * N_HEADS + h) * SEQ + tid * 16 + i] = v[i] + off;
}

__global__ __launch_bounds__(64) void attn_naive_k(const float* proj, const float* csum, float* yatt) {
    __shared__ float Ks[64][64];
    __shared__ float Vs[64][64];
    __shared__ float Cs[64];
    const int qb = blockIdx.x % (SEQ / 64), h = (blockIdx.x / (SEQ / 64)) % N_HEADS, b = blockIdx.x / (SEQ / 64 * N_HEADS);
    const int lane = threadIdx.x, i = qb * 64 + lane;
    float q[64], o[64];
    {
        const float* qp = proj + (size_t)(b * SEQ + i) * D_IN + 512 + h * 64;
#pragma unroll
        for (int d = 0; d < 64; ++d) { q[d] = qp[d] * 0.125f; o[d] = 0.f; }
    }
    const float ci = csum[(size_t)(b * N_HEADS + h) * SEQ + i];
    float m = -INFINITY, l = 0.f;
    for (int kt = 0; kt <= qb; ++kt) {
        __syncthreads();
        for (int j = 0; j < 64; ++j) {
            const float* kp = proj + (size_t)(b * SEQ + kt * 64 + j) * D_IN + 1024 + h * 64;
            Ks[j][lane] = kp[lane]; Vs[j][lane] = kp[512 + lane];
        }
        Cs[lane] = csum[(size_t)(b * N_HEADS + h) * SEQ + kt * 64 + lane];
        __syncthreads();
        for (int j = 0; j < 64; ++j) {
            const int kj = kt * 64 + j;
            float s = 0.f;
#pragma unroll
            for (int d = 0; d < 64; ++d) s = fmaf(q[d], Ks[j][d], s);
            s += ci - Cs[j];
            if (kj <= i) {
                if (s > m) {
                    const float f = expf(m - s);
                    l *= f;
#pragma unroll
                    for (int d = 0; d < 64; ++d) o[d] *= f;
                    m = s;
                }
                const float p = expf(s - m);
                l += p;
#pragma unroll
                for (int d = 0; d < 64; ++d) o[d] = fmaf(p, Vs[j][d], o[d]);
            }
        }
    }
    const float inv = 1.0f / l;
    float* op = yatt + (size_t)(b * SEQ + i) * D_ATTN + h * 64;
#pragma unroll
    for (int d = 0; d < 64; ++d) op[d] = o[d] * inv;
}

static void gemm(int epi, const float* A, int lda, const float* B, int ldb, float* C, int ldc, const float* R, int ldr, int Mr, int N, int K, hipStream_t s) {
    dim3 grid((N + 127) / 128, Mr / 128), block(256);
    if (epi == 0) hipLaunchKernelGGL(gemm_f32<0>, grid, block, 0, s, A, lda, B, ldb, C, ldc, R, ldr, Mr, N, K);
    else if (epi == 1) hipLaunchKernelGGL(gemm_f32<1>, grid, block, 0, s, A, lda, B, ldb, C, ldc, R, ldr, Mr, N, K);
    else hipLaunchKernelGGL(gemm_f32<2>, grid, block, 0, s, A, lda, B, ldb, C, ldc, R, ldr, Mr, N, K);
}

extern "C" void kernel_launch(void* const* d_in, const int* in_sizes, int n_in, void* d_out, int out_size, void* d_ws, size_t ws_size, hipStream_t stream) {
    const float* x = (const float*)d_in[0];
    const float* ln1_g = (const float*)d_in[1];
    const float* w_in = (const float*)d_in[2];
    const float* ssm_log_dt = (const float*)d_in[3];
    const float* lam_re = (const float*)d_in[4];
    const float* lam_im = (const float*)d_in[5];
    const float* b_re = (const float*)d_in[6];
    const float* b_im = (const float*)d_in[7];
    const float* c_re = (const float*)d_in[8];
    const float* c_im = (const float*)d_in[9];
    const float* ssm_d = (const float*)d_in[10];
    const float* glu_w = (const float*)d_in[11];
    const float* glu_b = (const float*)d_in[12];
    const float* fgate_b = (const float*)d_in[13];
    const float* gn_ssm_g = (const float*)d_in[14];
    const float* gn_attn_g = (const float*)d_in[15];
    const float* w_out = (const float*)d_in[16];
    const float* ln2_g = (const float*)d_in[17];
    const float* w_up = (const float*)d_in[18];
    const float* w_down = (const float*)d_in[19];
    const float* final_g = (const float*)d_in[20];
    float* out = (float*)d_out;
    char* ws = (char*)d_ws;
    constexpr size_t MiB = 1u << 20;
    float* XN = (float*)(ws);
    float* PROJ = (float*)(ws + 64 * MiB);
    float* Y = (float*)(ws + 193 * MiB);
    float* PA = (float*)(ws + 225 * MiB);
    float* PBB = (float*)(ws + 226 * MiB);
    float* CS = (float*)(ws + 227 * MiB);
    float* h = out;

    hipMemcpyAsync(h, x, (size_t)M * D_MODEL * 4, hipMemcpyDeviceToDevice, stream);
    for (int l = 0; l < DEPTH; ++l) {
        hipLaunchKernelGGL(rmsnorm_k, dim3(M / 4), dim3(256), 0, stream, h, D_MODEL, ln1_g + l * D_MODEL, XN, D_MODEL, D_MODEL, M);
        gemm(0, XN, D_MODEL, w_in + (size_t)l * D_MODEL * D_IN, D_IN, PROJ, D_IN, nullptr, 0, M, D_IN, D_MODEL, stream);
        hipLaunchKernelGGL(ssm_params_k, dim3(8), dim3(256), 0, stream, ssm_log_dt + l * SSM_G, lam_re + l * SSM_G * SSM_N, lam_im + l * SSM_G * SSM_N,
                           b_re + (size_t)l * SSM_G * SSM_N * SSM_P, b_im + (size_t)l * SSM_G * SSM_N * SSM_P, PA, PBB);
        hipLaunchKernelGGL(ssm_scan_k, dim3(BATCH * SSM_G), dim3(64), 0, stream, PROJ, PA, PBB, c_re + (size_t)l * SSM_G * SSM_P * SSM_N, c_im + (size_t)l * SSM_G * SSM_P * SSM_N,
                           ssm_d + l * D_SSM, Y);
        hipLaunchKernelGGL(gelu_k, dim3((M * D_SSM) / 256), dim3(256), 0, stream, Y, (size_t)M * D_SSM);
        gemm(0, Y, D_SSM, glu_w + (size_t)l * D_SSM * D_SSM, D_SSM, XN, D_SSM, nullptr, 0, M, D_SSM, D_SSM, stream);
        hipLaunchKernelGGL(glu_norm_k, dim3(M / 4), dim3(256), 0, stream, Y, XN, glu_b + l * D_SSM, gn_ssm_g + l * D_SSM);
        hipLaunchKernelGGL(csum_k, dim3(BATCH * N_HEADS), dim3(256), 0, stream, PROJ, fgate_b + l * N_HEADS, CS);
        hipLaunchKernelGGL(attn_naive_k, dim3(BATCH * N_HEADS * (SEQ / 64)), dim3(64), 0, stream, PROJ, CS, XN);
        hipLaunchKernelGGL(rmsnorm_k, dim3(M / 4), dim3(256), 0, stream, XN, D_ATTN, gn_attn_g + l * D_ATTN, XN, D_ATTN, D_ATTN, M);
        gemm(1, Y, D_SSM, w_out + (size_t)l * D_MODEL * D_MODEL, D_MODEL, h, D_MODEL, h, D_MODEL, M, D_MODEL, D_SSM, stream);
        gemm(1, XN, D_ATTN, w_out + (size_t)l * D_MODEL * D_MODEL + (size_t)D_SSM * D_MODEL, D_MODEL, h, D_MODEL, h, D_MODEL, M, D_MODEL, D_ATTN, stream);
        hipLaunchKernelGGL(rmsnorm_k, dim3(M / 4), dim3(256), 0, stream, h, D_MODEL, ln2_g + l * D_MODEL, XN, D_MODEL, D_MODEL, M);
        for (int c = 0; c < 4; ++c) {
            const int r0 = c * 4096;
            gemm(2, XN + (size_t)r0 * D_MODEL, D_MODEL, w_up + (size_t)l * D_MODEL * D_FF, D_FF, PROJ, D_FF, nullptr, 0, 4096, D_FF, D_MODEL, stream);
            gemm(1, PROJ, D_FF, w_down + (size_t)l * D_FF * D_MODEL, D_MODEL, h + (size_t)r0 * D_MODEL, D_MODEL, h + (size_t)r0 * D_MODEL, D_MODEL, 4096, D_MODEL, D_FF, stream);
        }
    }
    hipLaunchKernelGGL(rmsnorm_k, dim3(M / 4), dim3(256), 0, stream, h, D_MODEL, final_g, h, D_MODEL, D_MODEL, M);
}
```

```cpp
#include <hip/hip_runtime.h>
#include <cstdio>
#include <cstdint>

constexpr int BATCH = 4, SEQ = 4096, DM = 1024, MROWS = BATCH * SEQ, DEPTH = 2;
constexpr int DSSM = 512, DATT = 512, NHEAD = 8, HDIM = 64, DFF = 4096, DIN = 2056;
constexpr int SG = 32, SP = 16, SN = 64;
constexpr float EPS = 1e-6f;
constexpr float LOG2E = 1.4426950408889634f;
constexpr float C2 = 0.125f * 1.4426950408889634f;
namespace pg8 {
#define PG8_LAS __attribute__((address_space(3)))
typedef unsigned short bf16_t;
typedef short bf16x8 __attribute__((ext_vector_type(8)));
typedef float f32x4 __attribute__((ext_vector_type(4)));
typedef unsigned u32x4 __attribute__((ext_vector_type(4)));
constexpr int BM = 256, BK = 64, HALF = 128, HTB = HALF * BK * 2  , STAGE_BYTES = 8 * HTB, NXCD = 8, WGM = 8;

__host__ __device__ __forceinline__ int lds_byte(int r, int c) { const int st = (r >> 4) * 2 + (c >> 5), rr = r & 15, cc = c & 31, ob = rr * 64 + cc * 2; return st * 1024 + (ob ^ (((ob >> 9) & 1) << 5)); }
__host__ __device__ __forceinline__ void stage_rc(int b, int& R, int& C) { const int st = b / 1024, sb = b % 1024, swz = sb ^ (((sb >> 9) & 1) << 5); R = (st >> 1) * 16 + swz / 64; C = (st & 1) * 32 + (swz % 64) / 2; }
__host__ __device__ __forceinline__ int perm32(int rho) { const int n = rho >> 4, i = rho & 15; return 8 * (i >> 2) + 4 * n + (i & 3); }

struct Unit { int pm, pn; };
struct Gemm { const bf16_t* A; const bf16_t* Bt; int M, N, K; };

struct StaticOrder {
    int nM, nN, nwg, G, c;
    __host__ __device__ void init(int M, int N, int G_, int c_) { nM = M / BM; nN = N / BM; nwg = nM * nN; G = G_; c = c_; }
    __host__ __device__ bool next(int i, Unit& u) const {
        const long L = (long)i * G + c; if (L >= nwg) return false;
        int wgid = (int)L; { const int q = nwg / NXCD, r = nwg % NXCD, xcd = wgid % NXCD, off = wgid / NXCD; wgid = (xcd < r ? xcd * (q + 1) : r * (q + 1) + (xcd - r) * q) + off; }
        const int nig = WGM * nN, gid = wgid / nig, fm = gid * WGM, gsz = (nM - fm) < WGM ? (nM - fm) : WGM;
        u.pm = fm + ((wgid % nig) % gsz); u.pn = (wgid % nig) / gsz; return true;
    }
    __device__ __forceinline__ void a_ready(const Unit&) const {}
    __device__ __forceinline__ void done(const Unit&) const {}
};


__device__ __forceinline__ unsigned cvt_pk_bf16(float lo, float hi) { unsigned r; asm volatile("v_cvt_pk_bf16_f32 %0, %1, %2" : "=v"(r) : "v"(lo), "v"(hi)); return r; }
__device__ __forceinline__ float bflo(unsigned w) { return __uint_as_float(w << 16); }
__device__ __forceinline__ float bfhi(unsigned w) { return __uint_as_float(w & 0xffff0000u); }
typedef unsigned u32x2 __attribute__((ext_vector_type(2)));
constexpr int EP_M = 16384;
typedef __attribute__((address_space(4))) const unsigned char* ep_kptr_t;
template <class T> __device__ __forceinline__ T* ep_karg(int i) { ep_kptr_t p = (ep_kptr_t)__builtin_amdgcn_kernarg_segment_ptr(); asm volatile("" : "+s"(p)); return *(T* const __attribute__((address_space(4)))*)(p + 8 * i); }
__device__ __forceinline__ float* ep_ss(int i) { return (float*)(ep_karg<unsigned char>(22) + (1u << 20)) + (size_t)i * EP_M; }
__device__ __forceinline__ float* ep_out() { return ep_karg<float>(21); }
__device__ __forceinline__ const float* ep_x() { return ep_karg<const float>(0); }
__device__ __forceinline__ bf16_t* ep_hb() { return (bf16_t*)(ep_karg<unsigned char>(22) + (66u << 20)); }

struct EpiProj {
    static constexpr bool PERM = true, AFTER_DRAIN = false, MIDK = false;
    bf16_t* O; size_t stride; const float* ss; float qscale; int midk_t;
    __device__ __forceinline__ void midk(f32x4 (&)[2][2][4][2], const Unit&, int, int, int, int) const {}
    __device__ __forceinline__ void operator()(const f32x4 (&acc)[2][2][4][2], const Unit& u, int wr, int wc, int fr, int fq) const {
        const int row0 = u.pm * BM + wr * 64 + fr; int colt = u.pn * BM; const int t = colt / 512; colt -= t * 512;
        bf16_t* base = O + (size_t)t * stride; const float sc = (t == 1) ? qscale : 1.0f;
        const int col0 = colt + wc * 32 + 8 * fq;
#pragma unroll
        for (int ai = 0; ai < 2; ++ai)
#pragma unroll
            for (int m = 0; m < 4; ++m) { const int row = row0 + ai * HALF + m * 16; const float rs = rsqrtf(ss[row] * (1.0f / 1024.0f) + 1e-6f) * sc;
                bf16_t* rowp = base + (size_t)row * 512 + col0;
#pragma unroll
                for (int bj = 0; bj < 2; ++bj) { const f32x4 v0 = acc[ai][bj][m][0] * rs, v1 = acc[ai][bj][m][1] * rs;
                    u32x4 w; w.x = cvt_pk_bf16(v0[0], v0[1]); w.y = cvt_pk_bf16(v0[2], v0[3]); w.z = cvt_pk_bf16(v1[0], v1[1]); w.w = cvt_pk_bf16(v1[2], v1[3]);
                    *(u32x4*)(rowp + bj * HALF) = w; } }
    }
};
struct EpiGlu {
    static constexpr bool PERM = true, AFTER_DRAIN = false, MIDK = false;
    const bf16_t* GB; bf16_t* MIX; const float* bias; float* ss; int midk_t;
    __device__ __forceinline__ void midk(f32x4 (&)[2][2][4][2], const Unit&, int, int, int, int) const {}
    __device__ __forceinline__ void operator()(const f32x4 (&acc)[2][2][4][2], const Unit& u, int wr, int wc, int fr, int fq) const {
        const int row0 = u.pm * BM + wr * 64 + fr, col0 = u.pn * BM + wc * 32 + 8 * fq;
        f32x4 bv[2][2];
#pragma unroll
        for (int bj = 0; bj < 2; ++bj)
#pragma unroll
            for (int n = 0; n < 2; ++n) bv[bj][n] = *(const f32x4*)(bias + col0 + bj * HALF + 4 * n);
#pragma unroll
        for (int ai = 0; ai < 2; ++ai)
#pragma unroll
            for (int m = 0; m < 4; ++m) { const int row = row0 + ai * HALF + m * 16; float part = 0.f;
#pragma unroll
                for (int bj = 0; bj < 2; ++bj) {
                    const u32x4 gw = *(const u32x4*)(GB + (size_t)row * 512 + col0 + bj * HALF);
                    const f32x4 z0 = acc[ai][bj][m][0] + bv[bj][0], z1 = acc[ai][bj][m][1] + bv[bj][1];
                    float g[8] = {bflo(gw.x), bfhi(gw.x), bflo(gw.y), bfhi(gw.y), bflo(gw.z), bfhi(gw.z), bflo(gw.w), bfhi(gw.w)};
                    float z[8] = {z0[0], z0[1], z0[2], z0[3], z1[0], z1[1], z1[2], z1[3]}; float o[8];
#pragma unroll
                    for (int e = 0; e < 8; ++e) { const float s = __builtin_amdgcn_rcpf(1.0f + __builtin_amdgcn_exp2f(-z[e] * 1.4426950408889634f)); o[e] = g[e] * s; part += o[e] * o[e]; }
                    u32x4 w; w.x = cvt_pk_bf16(o[0], o[1]); w.y = cvt_pk_bf16(o[2], o[3]); w.z = cvt_pk_bf16(o[4], o[5]); w.w = cvt_pk_bf16(o[6], o[7]);
                    *(u32x4*)(MIX + (size_t)row * 1024 + col0 + bj * HALF) = w; }
                part += __shfl_xor(part, 16); part += __shfl_xor(part, 32);
                if (fq == 0) atomicAdd(ss + row, part); }
    }
};
struct EpiOut {
    static constexpr bool PERM = false, AFTER_DRAIN = false, MIDK = true;
    int l; int midk_t;
    __device__ __forceinline__ void midk(f32x4 (&acc)[2][2][4][2], const Unit& u, int wr, int wc, int fr, int fq) const {
        const float* ss_ssm = ep_ss(4 * l + 1); const float* ss_att = ss_ssm + EP_M;
        const int row0 = u.pm * BM + wr * 64 + fr;
#pragma unroll
        for (int ai = 0; ai < 2; ++ai)
#pragma unroll
            for (int m = 0; m < 4; ++m) { const int row = row0 + ai * HALF + m * 16;
                const float ra = sqrtf((ss_att[row] * (1.0f / 512.0f) + 1e-6f) / (ss_ssm[row] * (1.0f / 512.0f) + 1e-6f));
#pragma unroll
                for (int bj = 0; bj < 2; ++bj)
#pragma unroll
                    for (int n = 0; n < 2; ++n) acc[ai][bj][m][n] *= ra; }
    }
    __device__ __forceinline__ void operator()(const f32x4 (&acc)[2][2][4][2], const Unit& u, int wr, int wc, int fr, int fq) const {
        const float* ss_att = ep_ss(4 * l + 2); float* ss2 = (float*)ss_att + EP_M; float* out = ep_out(); const float* base = (l == 0) ? ep_x() : (const float*)out; bf16_t* HB = ep_hb();
        const int row0 = u.pm * BM + wr * 64 + fr, col0 = u.pn * BM + wc * 32 + 4 * fq;
#pragma unroll
        for (int ai = 0; ai < 2; ++ai)
#pragma unroll
            for (int m = 0; m < 4; ++m) { const int row = row0 + ai * HALF + m * 16; const float r2 = rsqrtf(ss_att[row] * (1.0f / 512.0f) + 1e-6f); float part = 0.f;
                const size_t off = (size_t)row * 1024 + col0;
#pragma unroll
                for (int bj = 0; bj < 2; ++bj)
#pragma unroll
                    for (int n = 0; n < 2; ++n) { const f32x4 bs = *(const f32x4*)(base + off + bj * HALF + n * 16); const f32x4 o = bs + acc[ai][bj][m][n] * r2;
                        *(f32x4*)(out + off + bj * HALF + n * 16) = o; part += (o[0] * o[0] + o[1] * o[1]) + (o[2] * o[2] + o[3] * o[3]);
                        u32x2 w; w.x = cvt_pk_bf16(o[0], o[1]); w.y = cvt_pk_bf16(o[2], o[3]); *(u32x2*)(HB + off + bj * HALF + n * 16) = w; }
                part += __shfl_xor(part, 16); part += __shfl_xor(part, 32);
                if (fq == 0) atomicAdd(ss2 + row, part); }
    }
};
struct EpiUp {
    static constexpr bool PERM = true, AFTER_DRAIN = false, MIDK = false;
    bf16_t* O; const float* ss; int midk_t;
    __device__ __forceinline__ void midk(f32x4 (&)[2][2][4][2], const Unit&, int, int, int, int) const {}
    __device__ __forceinline__ void operator()(const f32x4 (&acc)[2][2][4][2], const Unit& u, int wr, int wc, int fr, int fq) const {
        const int row0 = u.pm * BM + wr * 64 + fr, col0 = u.pn * BM + wc * 32 + 8 * fq;
#pragma unroll
        for (int ai = 0; ai < 2; ++ai)
#pragma unroll
            for (int m = 0; m < 4; ++m) { const int row = row0 + ai * HALF + m * 16; const float rs = rsqrtf(ss[row] * (1.0f / 1024.0f) + 1e-6f);
                bf16_t* rowp = O + (size_t)row * 4096 + col0;
#pragma unroll
                for (int bj = 0; bj < 2; ++bj) { f32x4 v0 = acc[ai][bj][m][0] * rs, v1 = acc[ai][bj][m][1] * rs;
#pragma unroll
                    for (int e = 0; e < 4; ++e) { v0[e] = fmaxf(v0[e], 0.f); v0[e] *= v0[e]; v1[e] = fmaxf(v1[e], 0.f); v1[e] *= v1[e]; }
                    u32x4 w; w.x = cvt_pk_bf16(v0[0], v0[1]); w.y = cvt_pk_bf16(v0[2], v0[3]); w.z = cvt_pk_bf16(v1[0], v1[1]); w.w = cvt_pk_bf16(v1[2], v1[3]);
                    *(u32x4*)(rowp + bj * HALF) = w; } }
    }
};
struct EpiDown {
    static constexpr bool PERM = false, AFTER_DRAIN = false, MIDK = false;
    float* h; bf16_t* HB; float* ssn; int midk_t;
    __device__ __forceinline__ void midk(f32x4 (&)[2][2][4][2], const Unit&, int, int, int, int) const {}
    __device__ __forceinline__ void operator()(const f32x4 (&acc)[2][2][4][2], const Unit& u, int wr, int wc, int fr, int fq) const {
        const int row0 = u.pm * BM + wr * 64 + fr, col0 = u.pn * BM + wc * 32 + 4 * fq;
#pragma unroll
        for (int ai = 0; ai < 2; ++ai)
#pragma unroll
            for (int m = 0; m < 4; ++m) { const int row = row0 + ai * HALF + m * 16; float part = 0.f;
                const size_t off = (size_t)row * 1024 + col0;
#pragma unroll
                for (int bj = 0; bj < 2; ++bj)
#pragma unroll
                    for (int n = 0; n < 2; ++n) { const f32x4 bs = *(const f32x4*)(h + off + bj * HALF + n * 16); const f32x4 o = bs + acc[ai][bj][m][n];
                        *(f32x4*)(h + off + bj * HALF + n * 16) = o; part += (o[0] * o[0] + o[1] * o[1]) + (o[2] * o[2] + o[3] * o[3]);
                        u32x2 w; w.x = cvt_pk_bf16(o[0], o[1]); w.y = cvt_pk_bf16(o[2], o[3]); *(u32x2*)(HB + off + bj * HALF + n * 16) = w; }
                part += __shfl_xor(part, 16); part += __shfl_xor(part, 32);
                if (fq == 0) atomicAdd(ssn + row, part); }
    }
};
template <class Epi, class Sched, bool ALIGN_EPI = false, bool SP2 = false>
__device__ __forceinline__ void gemm_phase(PG8_LAS unsigned char* lds, const Gemm g, const Sched& S, const Epi& E) {
    int tid_ = threadIdx.x; asm volatile("" : "+v"(tid_));
    const int tid = tid_, wid = __builtin_amdgcn_readfirstlane(tid >> 6), lane = tid & 63, wr = wid >> 2, wc = wid & 3, fr = lane & 15, fq = lane >> 4;
    const int K = g.K, nt = K / BK;
    unsigned voffA[2], voffB[2];
#pragma unroll
    for (int i = 0; i < 2; ++i) { int R, C; stage_rc(tid * 16 + i * 8192, R, C); const int Rb = Epi::PERM ? ((R & ~31) + perm32(R & 31)) : R;
        voffA[i] = (unsigned)(R * K + C) * 2u; voffB[i] = (unsigned)(Rb * K + C) * 2u; }
    const size_t kstep = (size_t)(BK * 2);
    const size_t hstep = (size_t)HALF * K * 2;
    const size_t tstep = 2 * hstep;
    const unsigned ldsw = (unsigned)wid * 1024u;
    const int aoff = lds_byte(wr * 64 + fr, fq * 8), boff = lds_byte(wc * 32 + fr, fq * 8);
#define PG8_SA(b, h) (((b) * 2 + (h)) * HTB)
#define PG8_SB(b, h) ((4 + (b) * 2 + (h)) * HTB)
#define PG8_STAGE(bufoff, gbase, voff) do { _Pragma("unroll") for (int _i = 0; _i < 2; ++_i) \
        __builtin_amdgcn_global_load_lds((const unsigned*)((const char*)(gbase) + (voff)[_i]), (PG8_LAS unsigned*)(lds + (bufoff) + ldsw + _i * 8192), 16, 0, 0); } while (0)
#define PG8_LDA(dst, b, h) do { _Pragma("unroll") for (int m = 0; m < 4; ++m) _Pragma("unroll") for (int k = 0; k < 2; ++k) dst[m][k] = *(const PG8_LAS bf16x8*)(lds + PG8_SA(b, h) + aoff + m * 2048 + k * 1024); } while (0)
#define PG8_LDB(dst, b, h) do { _Pragma("unroll") for (int n = 0; n < 2; ++n) _Pragma("unroll") for (int k = 0; k < 2; ++k) dst[n][k] = *(const PG8_LAS bf16x8*)(lds + PG8_SB(b, h) + boff + n * 2048 + k * 1024); } while (0)
#define PG8_MMA(ai, bj, At, Bt) do { __builtin_amdgcn_s_setprio(1); _Pragma("unroll") for (int m = 0; m < 4; ++m) _Pragma("unroll") for (int n = 0; n < 2; ++n) _Pragma("unroll") for (int k = 0; k < 2; ++k) \
        acc[ai][bj][m][n] = __builtin_amdgcn_mfma_f32_16x16x32_bf16(Bt[n][k], At[m][k], acc[ai][bj][m][n], 0, 0, 0); __builtin_amdgcn_s_setprio(0); } while (0)
#define PG8_WAIT_V(n) asm volatile("s_waitcnt vmcnt(" #n ")" ::: "memory")
#define PG8_WAIT_L(n) asm volatile("s_waitcnt lgkmcnt(" #n ")" ::: "memory")
#define PG8_BAR __builtin_amdgcn_s_barrier()
#define PG8_SCHED __builtin_amdgcn_sched_barrier(0)
    Unit cur, nxt; int ui = 0;
    if (!S.next(0, cur)) return;
    f32x4 acc[2][2][4][2];
#pragma unroll
    for (int a = 0; a < 2; ++a)
#pragma unroll
        for (int b = 0; b < 2; ++b)
#pragma unroll
            for (int m = 0; m < 4; ++m)
#pragma unroll
                for (int n = 0; n < 2; ++n) acc[a][b][m][n] = (f32x4){0.f, 0.f, 0.f, 0.f};
    bf16x8 At[4][2], B0[2][2], B1[2][2];
    const char* cA = (const char*)g.A + (size_t)cur.pm * tstep; const char* cB = (const char*)g.Bt + (size_t)cur.pn * tstep;
    S.a_ready(cur);
    if constexpr (SP2) {
        PG8_STAGE(PG8_SB(0, 0), cB, voffB); PG8_STAGE(PG8_SB(0, 1), cB + hstep, voffB); PG8_STAGE(PG8_SA(0, 0), cA, voffA); PG8_STAGE(PG8_SA(0, 1), cA + hstep, voffA);
        if (wr == 1) PG8_BAR;
        PG8_WAIT_V(2); PG8_BAR;
        PG8_STAGE(PG8_SB(1, 0), cB + kstep, voffB); PG8_STAGE(PG8_SA(1, 0), cA + kstep, voffA); PG8_STAGE(PG8_SB(1, 1), cB + hstep + kstep, voffB);
        PG8_WAIT_V(6); PG8_BAR;
    } else {
        PG8_STAGE(PG8_SB(0, 0), cB, voffB); PG8_STAGE(PG8_SA(0, 0), cA, voffA); PG8_STAGE(PG8_SB(0, 1), cB + hstep, voffB); PG8_STAGE(PG8_SA(0, 1), cA + hstep, voffA);
        if (wr == 1) PG8_BAR;
        PG8_WAIT_V(4); PG8_BAR;
        PG8_STAGE(PG8_SB(1, 0), cB + kstep, voffB); PG8_STAGE(PG8_SA(1, 0), cA + kstep, voffA); PG8_STAGE(PG8_SB(1, 1), cB + hstep + kstep, voffB);
        PG8_WAIT_V(6); PG8_BAR;
    }
    for (;;) {
        const bool has_next = S.next(ui + 1, nxt);
        const char* nA = has_next ? (const char*)g.A + (size_t)nxt.pm * tstep : cA; const char* nB = has_next ? (const char*)g.Bt + (size_t)nxt.pn * tstep : cB;
        for (int t = 0; t < nt; t += 2) {
            if constexpr (Epi::MIDK) { if (t == E.midk_t) E.midk(acc, cur, wr, wc, fr, fq); }
            const bool last = (t == nt - 2);
            const char* a1 = cA + (size_t)(t + 1) * kstep;
            const char* a2 = last ? nA : cA + (size_t)(t + 2) * kstep; const char* b2 = last ? nB : cB + (size_t)(t + 2) * kstep;
            const char* a3 = a2 + kstep; const char* b3 = b2 + kstep;
            if (last && has_next) S.a_ready(nxt);
            if constexpr (SP2) {
            PG8_LDB(B0, 0, 0); PG8_LDB(B1, 0, 1); PG8_SCHED; PG8_LDA(At, 0, 0); PG8_STAGE(PG8_SA(1, 1), a1 + hstep, voffA);
            PG8_WAIT_V(8); PG8_WAIT_L(0); PG8_BAR; PG8_MMA(0, 0, At, B0); PG8_MMA(0, 1, At, B1); PG8_BAR; PG8_SCHED;
            PG8_LDA(At, 0, 1); PG8_STAGE(PG8_SB(0, 0), b2, voffB); PG8_STAGE(PG8_SB(0, 1), b2 + hstep, voffB); PG8_STAGE(PG8_SA(0, 0), a2, voffA);
            PG8_WAIT_V(8); PG8_WAIT_L(0); PG8_BAR; PG8_MMA(1, 0, At, B0); PG8_MMA(1, 1, At, B1); PG8_BAR; PG8_SCHED;
            PG8_LDB(B0, 1, 0); PG8_LDB(B1, 1, 1); PG8_SCHED; PG8_LDA(At, 1, 0); PG8_STAGE(PG8_SA(0, 1), a2 + hstep, voffA);
            PG8_WAIT_V(8); PG8_WAIT_L(0); PG8_BAR; PG8_MMA(0, 0, At, B0); PG8_MMA(0, 1, At, B1); PG8_BAR; PG8_SCHED;
            PG8_LDA(At, 1, 1); PG8_STAGE(PG8_SB(1, 0), b3, voffB); PG8_STAGE(PG8_SB(1, 1), b3 + hstep, voffB); PG8_STAGE(PG8_SA(1, 0), a3, voffA);
            PG8_WAIT_V(8); PG8_WAIT_L(0); PG8_BAR; PG8_MMA(1, 0, At, B0); PG8_MMA(1, 1, At, B1); PG8_BAR; PG8_SCHED;
            } else {
            PG8_LDB(B0, 0, 0); PG8_SCHED; PG8_LDA(At, 0, 0); PG8_STAGE(PG8_SA(1, 1), a1 + hstep, voffA);
            PG8_WAIT_L(8); PG8_BAR; PG8_WAIT_L(0); PG8_MMA(0, 0, At, B0); PG8_BAR; PG8_SCHED;
            PG8_LDB(B1, 0, 1); PG8_STAGE(PG8_SB(0, 0), b2, voffB);
            PG8_BAR; PG8_WAIT_L(0); PG8_MMA(0, 1, At, B1); PG8_BAR;
            PG8_LDA(At, 0, 1); PG8_STAGE(PG8_SA(0, 0), a2, voffA);
            PG8_BAR; PG8_WAIT_L(0); PG8_MMA(1, 0, At, B0); PG8_BAR; PG8_SCHED;
            PG8_STAGE(PG8_SB(0, 1), b2 + hstep, voffB);
            PG8_WAIT_V(6); PG8_BAR; PG8_MMA(1, 1, At, B1); PG8_BAR;
            PG8_LDB(B0, 1, 0); PG8_SCHED; PG8_LDA(At, 1, 0); PG8_STAGE(PG8_SA(0, 1), a2 + hstep, voffA);
            PG8_WAIT_L(8); PG8_BAR; PG8_WAIT_L(0); PG8_MMA(0, 0, At, B0); PG8_BAR; PG8_SCHED;
            PG8_LDB(B1, 1, 1); PG8_STAGE(PG8_SB(1, 0), b3, voffB);
            PG8_BAR; PG8_WAIT_L(0); PG8_MMA(0, 1, At, B1); PG8_BAR;
            PG8_LDA(At, 1, 1); PG8_STAGE(PG8_SA(1, 0), a3, voffA);
            PG8_BAR; PG8_WAIT_L(0); PG8_MMA(1, 0, At, B0); PG8_BAR; PG8_SCHED;
            PG8_STAGE(PG8_SB(1, 1), b3 + hstep, voffB);
            PG8_WAIT_V(6); PG8_BAR; PG8_MMA(1, 1, At, B1); PG8_BAR;
            }
        }
        if constexpr (ALIGN_EPI) { if (wr == 0) PG8_BAR; }
        if constexpr (!Epi::AFTER_DRAIN) { E(acc, cur, wr, wc, fr, fq); S.done(cur); }
        if (!has_next) break;
#pragma unroll
        for (int a = 0; a < 2; ++a)
#pragma unroll
            for (int b = 0; b < 2; ++b)
#pragma unroll
                for (int m = 0; m < 4; ++m)
#pragma unroll
                    for (int n = 0; n < 2; ++n) acc[a][b][m][n] = (f32x4){0.f, 0.f, 0.f, 0.f};
        cur = nxt; cA = nA; cB = nB; ++ui;
        if constexpr (ALIGN_EPI) { if (wr == 1) PG8_BAR; }
    }
    PG8_WAIT_V(0);
    if constexpr (!ALIGN_EPI) { if (wr == 0) PG8_BAR; }
    PG8_BAR;
    if constexpr (Epi::AFTER_DRAIN) { E.fused(acc, cur, wr, wc, fr, fq, lds, wid, lane); S.done(cur); }
#undef PG8_SA
#undef PG8_SB
#undef PG8_STAGE
#undef PG8_LDA
#undef PG8_LDB
#undef PG8_MMA
#undef PG8_WAIT_V
#undef PG8_WAIT_L
#undef PG8_BAR
#undef PG8_SCHED
}
}

#define GAS __attribute__((address_space(1)))
#define LAS __attribute__((address_space(3)))
typedef unsigned short bf16;
typedef unsigned v4u __attribute__((ext_vector_type(4)));
typedef float f32x4 __attribute__((ext_vector_type(4)));
typedef short bf16x8 __attribute__((ext_vector_type(8)));
typedef GAS unsigned gu32;
typedef GAS unsigned long long gu64;
#define RLX_AGENT __ATOMIC_RELAXED, __HIP_MEMORY_SCOPE_AGENT
#define LDS_WAIT() asm volatile("s_waitcnt lgkmcnt(0)" ::: "memory")
#define VM_WAIT() asm volatile("s_waitcnt vmcnt(0)" ::: "memory")
__device__ __forceinline__ unsigned long long rt() { return __builtin_amdgcn_s_memrealtime(); }
__device__ __forceinline__ unsigned f2bf(float f) { unsigned u = __builtin_bit_cast(unsigned, f); return (u + 0x7fffu + ((u >> 16) & 1u)) >> 16; }
__device__ __forceinline__ unsigned pk2(float lo, float hi) { return f2bf(lo) | (f2bf(hi) << 16); }
#define XB_TMO      128
#define XB_XCNT(j)  (256  + 64 * (j))
#define XB_XSUB(j)  (1280 + 64 * (j))
#define XB_XGEN(j)  (2304 + 64 * (j))
#define XB_TOP      3328
#define XB_TOPGEN   3392
#define XCD_BAR_WORDS 3456
#define XB_SPIN_CAP (1u << 18)

__device__ __forceinline__ unsigned xb_ld(unsigned* p)              { return __hip_atomic_load(p, __ATOMIC_RELAXED, __HIP_MEMORY_SCOPE_AGENT); }
__device__ __forceinline__ unsigned xb_add(unsigned* p, unsigned v) { return __hip_atomic_fetch_add(p, v, __ATOMIC_RELAXED, __HIP_MEMORY_SCOPE_AGENT); }
__device__ __forceinline__ unsigned xb_xcc_id() { return (unsigned)__builtin_amdgcn_s_getreg((3 << 11) | 20) & 0xFu; }
#define XB_SPIN(cond, bar) do { unsigned _sp = 0; while (cond) { __builtin_amdgcn_s_sleep(1); \
    if ((++_sp & 255u) == 0u) { if (xb_ld(&(bar)[XB_TMO])) break; if (_sp > XB_SPIN_CAP) { atomicAdd(&(bar)[XB_TMO], 1u); break; } } } } while (0)

struct XcdBarrier {
    unsigned* bar; unsigned x;
    volatile LAS unsigned* st;
};

__device__ __forceinline__ XcdBarrier xcd_barrier_post(unsigned* bar, volatile LAS unsigned* st) {
    XcdBarrier b; b.bar = bar; b.x = xb_xcc_id(); b.st = st;
    if (threadIdx.x == 0) (void)xb_add(&bar[XB_XCNT(b.x)], 1u);
    return b;
}
__device__ __forceinline__ void xcd_barrier_complete(unsigned* bar, unsigned x, unsigned& nloc, unsigned& nx) {
    const unsigned G = gridDim.x * gridDim.y * gridDim.z;
    unsigned sum, cnt, mine, sp = 0u;
    for (;;) {
        sum = 0u; cnt = 0u; mine = 0u;
#pragma unroll
        for (unsigned j = 0; j < 16; ++j) { const unsigned c = xb_ld(&bar[XB_XCNT(j)]); sum += c; cnt += (c > 0u) ? 1u : 0u; mine = (j == x) ? c : mine; }
        if (sum == G) break;
        __builtin_amdgcn_s_sleep(1);
        if ((++sp & 255u) == 0u) { if (xb_ld(&bar[XB_TMO])) break; if (sp > XB_SPIN_CAP) { atomicAdd(&bar[XB_TMO], 1u); break; } }
    }
    nloc = mine > 0u ? mine : 1u; nx = cnt > 0u ? cnt : 1u;
}

__device__ __forceinline__ void xcd_barrier(const XcdBarrier& b) {
    asm volatile("s_waitcnt vmcnt(0)" ::: "memory");
    __syncthreads();
    if (threadIdx.x == 0) {
        unsigned* bar = b.bar; unsigned bx = b.x; asm volatile("" : "+s"(bar), "+s"(bx));
        __builtin_amdgcn_s_waitcnt(0);
        unsigned nloc = b.st[0], nx = b.st[1];
        if (nloc == 0u) { xcd_barrier_complete(bar, bx, nloc, nx); b.st[0] = nloc; b.st[1] = nx; }
        const unsigned old = xb_add(&bar[XB_XSUB(bx)], 1u);
        const unsigned gen = old / nloc;
        if (old + 1u == (gen + 1u) * nloc) {
            __builtin_amdgcn_fence(__ATOMIC_RELEASE, "agent");
            asm volatile("s_waitcnt vmcnt(0)" ::: "memory");
            const unsigned og = xb_add(&bar[XB_TOP], 1u);
            const unsigned tg = og / nx;
            if (og + 1u == (tg + 1u) * nx) xb_add(&bar[XB_TOPGEN], 1u);
            else XB_SPIN(xb_ld(&bar[XB_TOPGEN]) == tg, bar);
            __builtin_amdgcn_fence(__ATOMIC_ACQUIRE, "agent");
            xb_add(&bar[XB_XGEN(bx)], 1u);
            asm volatile("s_waitcnt vmcnt(0)" ::: "memory");
        } else {
            XB_SPIN(xb_ld(&bar[XB_XGEN(bx)]) == gen, bar);
            __builtin_amdgcn_fence(__ATOMIC_ACQUIRE, "agent");
            asm volatile("s_waitcnt vmcnt(0)" ::: "memory");
        }
    }
    __syncthreads();
}

constexpr size_t MiB = 1u << 20;
constexpr size_t WS_CTL = 0, CTL_ZERO_BYTES = 256 * 1024;
constexpr size_t WS_SS = 1 * MiB;
constexpr size_t WS_CST = 1 * MiB + 640 * 1024;
constexpr size_t WS_CSL = 2 * MiB;
constexpr size_t WS_WF = 3 * MiB;
constexpr size_t WS_SPA = 3 * MiB + 64 * 1024;
constexpr size_t WS_SPB = 3 * MiB + 128 * 1024;
constexpr size_t WS_WIN = 4 * MiB, WS_WOUT = 12 * MiB, WS_WUP = 16 * MiB, WS_WDN = 32 * MiB, WS_WGLU = 48 * MiB;
constexpr size_t WS_SSMM = 49 * MiB;
constexpr size_t WS_HB = 66 * MiB;
constexpr size_t WS_U = 98 * MiB, WS_Q = 114 * MiB, WS_K = 130 * MiB, WS_V = 146 * MiB;
constexpr size_t WS_MIX = 162 * MiB;
constexpr size_t WS_GB = 194 * MiB;
constexpr size_t WS_ST = 210 * MiB;
constexpr size_t WS_HID = 98 * MiB;
constexpr size_t WS_END = 226 * MiB;
static_assert(WS_SS == (1u << 20) && WS_HB == (66u << 20) && MROWS == pg8::EP_M, "epilogue helper constants");
constexpr int CW_BAR = 4096;

constexpr int RING_OFF = 0, RING_BYTES = 131072;
constexpr int LDSCTL_OFF = RING_BYTES, MISC_OFF = LDSCTL_OFF + 320;
constexpr int LDS_BYTES = 147456;
constexpr int NWAVES = 8;
#ifndef DBG_STOP_V
#define DBG_STOP_V 99
#endif
constexpr int DBG_STOP = DBG_STOP_V;

struct Frame {
    LAS unsigned char* lds;
    volatile LAS unsigned* MISC;
    int tid, lane, wave, vcu, G;
};
typedef __attribute__((address_space(4))) const unsigned char* kptr_t;
template <class T> __device__ __forceinline__ T* karg(int i) {
    kptr_t p = (kptr_t)__builtin_amdgcn_kernarg_segment_ptr(); asm volatile("" : "+s"(p));
    return *(T* const __attribute__((address_space(4)))*)(p + 8 * i);
}
__device__ __forceinline__ int opaque_s(int x) { asm volatile("" : "+s"(x)); return x; }
__device__ __forceinline__ int opaque_v(int x) { asm volatile("" : "+v"(x)); return x; }
#define KIN(i) karg<const float>(i)
#define KOUT() karg<float>(21)
#define KWS() karg<unsigned char>(22)
extern __shared__ __attribute__((aligned(16))) unsigned char g_lds[];
__device__ __forceinline__ Frame mk_frame() {
    Frame F;
    F.lds = (LAS unsigned char*)g_lds; F.MISC = (volatile LAS unsigned*)(F.lds + MISC_OFF);
    F.tid = opaque_v((int)threadIdx.x); F.lane = F.tid & 63; F.wave = __builtin_amdgcn_readfirstlane(F.tid >> 6);
    F.G = opaque_s((int)gridDim.x); { const int bx = opaque_s((int)blockIdx.x); F.vcu = (F.G % 8 == 0) ? (bx % 8) * (F.G / 8) + bx / 8 : bx; }
    return F;
}
__device__ __forceinline__ float* ss_arr(unsigned char* ws, int i) { return (float*)(ws + WS_SS) + (size_t)i * MROWS; }

__device__ __forceinline__ float wave_sum(float v) {
#pragma unroll
    for (int o = 1; o < 64; o <<= 1) v += __shfl_xor(v, o);
    return v;
}
__device__ __forceinline__ void p0_transpose_item(const float* W, int K, int N, int ldw, const float* gain, bf16* WT, LAS float* scr, int item, int lane) {
    const int nblk = N / 32, kb = item / nblk, nb = item % nblk, k0 = 64 * kb, n0 = 32 * nb;
#pragma unroll 8
    for (int i = 0; i < 32; ++i) { const int kk = 2 * i + (lane >> 5); const float g = gain ? gain[k0 + kk] : 1.0f; scr[kk * 33 + (lane & 31)] = W[(size_t)(k0 + kk) * ldw + n0 + (lane & 31)] * g; }
    LDS_WAIT(); asm volatile("" ::: "memory");
    const int c = lane & 7;
#pragma unroll
    for (int j = 0; j < 4; ++j) { const int n = (lane >> 3) + 8 * j; const LAS float* s = scr + (8 * c) * 33 + n;
        v4u o; o.x = pk2(s[0 * 33], s[1 * 33]); o.y = pk2(s[2 * 33], s[3 * 33]); o.z = pk2(s[4 * 33], s[5 * 33]); o.w = pk2(s[6 * 33], s[7 * 33]);
        *(GAS v4u*)(WT + (size_t)(n0 + n) * K + k0 + 8 * c) = o; }
    LDS_WAIT(); asm volatile("" ::: "memory");
}

struct Inputs {
    const float *x, *ln1_g, *w_in, *log_dt, *lam_re, *lam_im, *b_re, *b_im, *c_re, *c_im, *ssm_d, *glu_w, *glu_b, *fgate_b, *gn_ssm_g, *gn_attn_g, *w_out, *ln2_g, *w_up, *w_down, *final_g;
};

__device__ __forceinline__ Inputs load_inputs() {
    Inputs I;
    I.x = KIN(0); I.ln1_g = KIN(1); I.w_in = KIN(2); I.log_dt = KIN(3); I.lam_re = KIN(4); I.lam_im = KIN(5); I.b_re = KIN(6); I.b_im = KIN(7);
    I.c_re = KIN(8); I.c_im = KIN(9); I.ssm_d = KIN(10); I.glu_w = KIN(11); I.glu_b = KIN(12); I.fgate_b = KIN(13); I.gn_ssm_g = KIN(14); I.gn_attn_g = KIN(15);
    I.w_out = KIN(16); I.ln2_g = KIN(17); I.w_up = KIN(18); I.w_down = KIN(19); I.final_g = KIN(20);
    return I;
}
__device__ __forceinline__ void p0_prologue() {
    Frame F = mk_frame();
    const Inputs I = load_inputs();
    LAS float* scr = (LAS float*)(F.lds + RING_OFF + F.wave * 16384);
    const int gw = opaque_s(F.vcu) * NWAVES + opaque_s(F.wave), NGW = opaque_s(F.G) * NWAVES;
    unsigned char* ws = KWS();
    constexpr int I_IN = (DM / 64) * (2048 / 32), I_OUT = (DM / 64) * (DM / 32), I_UP = (DM / 64) * (DFF / 32), I_DN = (DFF / 64) * (DM / 32), I_GLU = (DSSM / 64) * (DSSM / 32);
    constexpr int PER_L = I_IN + I_OUT + I_UP + I_DN + I_GLU;
    for (int it = gw; it < DEPTH * PER_L; it += NGW) {
        const int l = it / PER_L; int r = it % PER_L;
        if (r < I_IN) { p0_transpose_item(I.w_in + (size_t)l * DM * DIN, DM, 2048, DIN, I.ln1_g + l * DM, (bf16*)(ws + WS_WIN) + (size_t)l * 2048 * DM, scr, r, F.lane); continue; } r -= I_IN;
        if (r < I_OUT) {
            const int kb = r / (DM / 32); const float* gain = (kb < 8) ? (I.gn_ssm_g + l * DSSM) : (I.gn_attn_g + l * DATT - 512);
            p0_transpose_item(I.w_out + (size_t)l * DM * DM, DM, DM, DM, gain, (bf16*)(ws + WS_WOUT) + (size_t)l * DM * DM, scr, r, F.lane); continue; } r -= I_OUT;
        if (r < I_UP) { p0_transpose_item(I.w_up + (size_t)l * DM * DFF, DM, DFF, DFF, I.ln2_g + l * DM, (bf16*)(ws + WS_WUP) + (size_t)l * DFF * DM, scr, r, F.lane); continue; } r -= I_UP;
        if (r < I_DN) { p0_transpose_item(I.w_down + (size_t)l * DFF * DM, DFF, DM, DM, nullptr, (bf16*)(ws + WS_WDN) + (size_t)l * DM * DFF, scr, r, F.lane); continue; } r -= I_DN;
        p0_transpose_item(I.glu_w + (size_t)l * DSSM * DSSM, DSSM, DSSM, DSSM, nullptr, (bf16*)(ws + WS_WGLU) + (size_t)l * DSSM * DSSM, scr, r, F.lane);
    }
    for (int i = gw * 64 + F.lane; i < DEPTH * 8 * DM; i += NGW * 64) { const int l = i / (8 * DM), h = (i / DM) % 8, k = i % DM;
        ((float*)(ws + WS_WF))[i] = I.w_in[(size_t)l * DM * DIN + (size_t)k * DIN + 2048 + h] * I.ln1_g[l * DM + k]; }
    for (int i = gw * 64 + F.lane; i < DEPTH * SG * SN; i += NGW * 64) {
        const int l = i / (SG * SN), gn = i % (SG * SN), g = gn / SN;
        const float dt = expf(I.log_dt[l * SG + g]);
        const float lr = I.lam_re[i], li = I.lam_im[i];
        const float mag = expf(lr * dt); float sn, cs; sincosf(li * dt, &sn, &cs);
        const float are = mag * cs, aim = mag * sn, den = lr * lr + li * li, nr = are - 1.0f;
        const float sre = (nr * lr + aim * li) / den, sim = (aim * lr - nr * li) / den;
        float* pa = (float*)(ws + WS_SPA) + (size_t)i * 2; pa[0] = are; pa[1] = aim;
        float* pb = (float*)(ws + WS_SPB) + (size_t)i * SP * 2;
        for (int p = 0; p < SP; ++p) { const float br = I.b_re[(size_t)i * SP + p], bi = I.b_im[(size_t)i * SP + p]; pb[p * 2] = sre * br - sim * bi; pb[p * 2 + 1] = sre * bi + sim * br; }
    }
    { f32x4* z = (f32x4*)ss_arr(ws, 1); for (int i = gw * 64 + F.lane; i < 8 * MROWS / 4; i += NGW * 64) z[i] = (f32x4){0.f, 0.f, 0.f, 0.f}; }
    for (int m = gw; m < MROWS; m += NGW) {
        const GAS f32x4* xr = (const GAS f32x4*)(I.x + (size_t)m * DM) + F.lane;
        GAS unsigned long long* o8 = (GAS unsigned long long*)((bf16*)(ws + WS_HB) + (size_t)m * DM) + F.lane;
        float s = 0.f;
#pragma unroll
        for (int j = 0; j < 4; ++j) { const f32x4 v = xr[64 * j]; s += (v.x * v.x + v.y * v.y) + (v.z * v.z + v.w * v.w);
            o8[64 * j] = (unsigned long long)pk2(v.x, v.y) | ((unsigned long long)pk2(v.z, v.w) << 32); }
        s = wave_sum(s);
        if (F.lane == 0) ss_arr(ws, 0)[m] = s;
    }
}

__device__ __forceinline__ void csum_items(int l) {
    Frame F = mk_frame();
    LAS float* wfl = (LAS float*)(F.lds); LAS float* Fs = (LAS float*)(F.lds + 32768);
    unsigned char* ws = KWS(); const float* fbias = KIN(13) + l * NHEAD; const float* ss1 = ss_arr(ws, 4 * l);
    const float* wf = (const float*)(ws + WS_WF) + (size_t)l * 8 * DM;
    for (int i = F.tid; i < 8 * DM; i += 512) wfl[i] = wf[i];
    __syncthreads();
    const bf16* HB = (const bf16*)(ws + WS_HB);
    float* CSL = (float*)(ws + WS_CSL); float* CST = (float*)(ws + WS_CST);
    for (int chunk = F.vcu; chunk < MROWS / 64; chunk += F.G) {
        for (int rr = 0; rr < 8; ++rr) {
            const int row = chunk * 64 + F.wave * 8 + rr;
            const v4u x0 = *(const v4u*)(HB + (size_t)row * DM + F.lane * 8), x1 = *(const v4u*)(HB + (size_t)row * DM + 512 + F.lane * 8);
            float xv[16] = {pg8::bflo(x0.x), pg8::bfhi(x0.x), pg8::bflo(x0.y), pg8::bfhi(x0.y), pg8::bflo(x0.z), pg8::bfhi(x0.z), pg8::bflo(x0.w), pg8::bfhi(x0.w),
                            pg8::bflo(x1.x), pg8::bfhi(x1.x), pg8::bflo(x1.y), pg8::bfhi(x1.y), pg8::bflo(x1.z), pg8::bfhi(x1.z), pg8::bflo(x1.w), pg8::bfhi(x1.w)};
            float mine = 0.f;
#pragma unroll
            for (int h = 0; h < 8; ++h) {
                const LAS f32x4* w = (const LAS f32x4*)(wfl + h * DM + F.lane * 8);
                const f32x4 w0 = w[0], w1 = w[1], w2 = w[128], w3 = w[129];
                float a = 0.f;
#pragma unroll
                for (int e = 0; e < 4; ++e) { a = fmaf(xv[e], w0[e], a); a = fmaf(xv[4 + e], w1[e], a); a = fmaf(xv[8 + e], w2[e], a); a = fmaf(xv[12 + e], w3[e], a); }
                a = wave_sum(a);
                if (F.lane == h) mine = a;
            }
            if (F.lane < 8) {
                const float f = mine * rsqrtf(ss1[row] * (1.0f / 1024.0f) + EPS) + fbias[F.lane];
                const float ls = (f >= 0.f) ? -log1pf(expf(-f)) : (f - log1pf(expf(f)));
                Fs[(F.wave * 8 + rr) * 8 + F.lane] = ls * LOG2E;
            }
        }
        __syncthreads();
        {
            float v = Fs[F.lane * 8 + F.wave];
#pragma unroll
            for (int o = 1; o < 64; o <<= 1) { const float t = __shfl_up(v, o); if (F.lane >= o) v += t; }
            const int row = chunk * 64 + F.lane, b = row / SEQ, t = row % SEQ;
            CSL[((size_t)b * NHEAD + F.wave) * SEQ + t] = v;
            if (F.lane == 63) CST[((size_t)b * NHEAD + F.wave) * 64 + t / 64] = v;
        }
        __syncthreads();
    }
}

__device__ __forceinline__ float gelu_tanh(float x) {
    const float k = 0.7978845608028654f;
    const float inner = k * (x + 0.044715f * x * x * x);
    const float e = __builtin_amdgcn_exp2f(inner * (2.0f * LOG2E));
    const float th = 1.0f - 2.0f * __builtin_amdgcn_rcpf(e + 1.0f);
    return 0.5f * x * (1.0f + th);
}

__device__ __forceinline__ void ssm_naive_phase(int l) {
    Frame F = mk_frame();
    unsigned char* ws = KWS(); Inputs I; I.c_re = KIN(8); I.c_im = KIN(9); I.ssm_d = KIN(10);
    const int gw = opaque_s(F.vcu) * NWAVES + opaque_s(F.wave), NGW = opaque_s(F.G) * NWAVES;
    const bf16* U = (const bf16*)(ws + WS_U); bf16* GB = (bf16*)(ws + WS_GB);
    for (int it = gw; it < BATCH * SG; it += NGW) {
        const int b = it / SG, g = it % SG, n = F.lane;
        const float* bb = (const float*)(ws + WS_SPB) + ((size_t)(l * SG + g) * SN + n) * SP * 2;
        const float* pa = (const float*)(ws + WS_SPA) + ((size_t)(l * SG + g) * SN + n) * 2;
        const float* cre = I.c_re + (size_t)(l * SG + g) * SP * SN; const float* cim = I.c_im + (size_t)(l * SG + g) * SP * SN;
        float bbr[SP], bbi[SP], cr[SP], ci[SP];
#pragma unroll
        for (int p = 0; p < SP; ++p) { bbr[p] = bb[p * 2]; bbi[p] = bb[p * 2 + 1]; cr[p] = cre[p * SN + n]; ci[p] = cim[p * SN + n]; }
        const float ar = pa[0], ai = pa[1];
        const float dsk = I.ssm_d[l * DSSM + g * SP + (n & 15)];
        float xr = 0.f, xi = 0.f;
        for (int t = 0; t < SEQ; ++t) {
            const size_t row = (size_t)b * SEQ + t;
            const v4u u0 = *(const v4u*)(U + row * 512 + g * SP), u1 = *(const v4u*)(U + row * 512 + g * SP + 8);
            float u[16] = {pg8::bflo(u0.x), pg8::bfhi(u0.x), pg8::bflo(u0.y), pg8::bfhi(u0.y), pg8::bflo(u0.z), pg8::bfhi(u0.z), pg8::bflo(u0.w), pg8::bfhi(u0.w),
                           pg8::bflo(u1.x), pg8::bfhi(u1.x), pg8::bflo(u1.y), pg8::bfhi(u1.y), pg8::bflo(u1.z), pg8::bfhi(u1.z), pg8::bflo(u1.w), pg8::bfhi(u1.w)};
            float bur = 0.f, bui = 0.f;
#pragma unroll
            for (int p = 0; p < SP; ++p) { bur = fmaf(bbr[p], u[p], bur); bui = fmaf(bbi[p], u[p], bui); }
            const float nxr = ar * xr - ai * xi + bur, nxi = ar * xi + ai * xr + bui;
            xr = nxr; xi = nxi;
            float mine = 0.f;
#pragma unroll
            for (int p = 0; p < SP; ++p) { const float v = wave_sum(cr[p] * xr - ci[p] * xi); if ((n & 15) == p) mine = v + dsk * u[p]; }
            if (n < SP) GB[row * 512 + g * SP + n] = (bf16)f2bf(gelu_tanh(mine));
        }
    }
}

__device__ __forceinline__ void attn_naive_phase(int l) {
    Frame F = mk_frame();
    unsigned char* ws = KWS(); float* ss_att = ss_arr(ws, 4 * l + 2);
    const int gw = opaque_s(F.vcu) * NWAVES + opaque_s(F.wave), NGW = opaque_s(F.G) * NWAVES;
    const bf16* Q = (const bf16*)(ws + WS_Q); const bf16* K = (const bf16*)(ws + WS_K); const bf16* V = (const bf16*)(ws + WS_V); bf16* MIX = (bf16*)(ws + WS_MIX);
    const float* CSL = (const float*)(ws + WS_CSL); const float* CST = (const float*)(ws + WS_CST);
    LAS unsigned char* wl = F.lds + F.wave * 8448;
    LAS v4u* Kt = (LAS v4u*)wl; LAS v4u* Vt = (LAS v4u*)(wl + 4096); LAS float* Cs = (LAS float*)(wl + 8192);
    for (int it = gw; it < BATCH * NHEAD * 64; it += NGW) {
        const int qb = 63 - it / 32, bh = it % 32, b = bh / NHEAD, h = bh % NHEAD;
        const int i = qb * 64 + F.lane; const size_t qrow = (size_t)b * SEQ + i;
        float q[64], o[64];
#pragma unroll
        for (int c = 0; c < 8; ++c) { const v4u w = *(const v4u*)(Q + qrow * 512 + h * 64 + c * 8);
            q[c * 8 + 0] = pg8::bflo(w.x); q[c * 8 + 1] = pg8::bfhi(w.x); q[c * 8 + 2] = pg8::bflo(w.y); q[c * 8 + 3] = pg8::bfhi(w.y);
            q[c * 8 + 4] = pg8::bflo(w.z); q[c * 8 + 5] = pg8::bfhi(w.z); q[c * 8 + 6] = pg8::bflo(w.w); q[c * 8 + 7] = pg8::bfhi(w.w); }
#pragma unroll
        for (int d = 0; d < 64; ++d) o[d] = 0.f;
        const float* cst = CST + (size_t)bh * 64; const float* csl = CSL + (size_t)bh * SEQ;
        float offq = 0.f; for (int c = 0; c < qb; ++c) offq += cst[c];
        const float ci = csl[i] + offq;
        float offk = 0.f, m = -INFINITY, lsum = 0.f;
        for (int kt = 0; kt < 2 * qb + 2; ++kt) {
            if (kt > 0 && (kt & 1) == 0) offk += cst[kt / 2 - 1];
            asm volatile("s_waitcnt lgkmcnt(0)" ::: "memory");
#pragma unroll
            for (int r = 0; r < 4; ++r) { const int idx = r * 64 + F.lane, key = idx >> 3, ch = idx & 7; const size_t krow = (size_t)b * SEQ + kt * 32 + key;
                Kt[idx] = *(const v4u*)(K + krow * 512 + h * 64 + ch * 8); Vt[idx] = *(const v4u*)(V + krow * 512 + h * 64 + ch * 8); }
            if (F.lane < 32) Cs[F.lane] = csl[kt * 32 + F.lane] + offk;
            asm volatile("s_waitcnt vmcnt(0) lgkmcnt(0)" ::: "memory");
            for (int j = 0; j < 32; ++j) {
                const int kj = kt * 32 + j;
                float s = 0.f;
#pragma unroll
                for (int c = 0; c < 8; ++c) { const v4u w = Kt[j * 8 + c];
                    s = fmaf(q[c * 8 + 0], pg8::bflo(w.x), s); s = fmaf(q[c * 8 + 1], pg8::bfhi(w.x), s); s = fmaf(q[c * 8 + 2], pg8::bflo(w.y), s); s = fmaf(q[c * 8 + 3], pg8::bfhi(w.y), s);
                    s = fmaf(q[c * 8 + 4], pg8::bflo(w.z), s); s = fmaf(q[c * 8 + 5], pg8::bfhi(w.z), s); s = fmaf(q[c * 8 + 6], pg8::bflo(w.w), s); s = fmaf(q[c * 8 + 7], pg8::bfhi(w.w), s); }
                s += ci - Cs[j];
                if (kj <= i) {
                    if (s > m) { const float f = __builtin_amdgcn_exp2f(m - s); lsum *= f;
#pragma unroll
                        for (int d = 0; d < 64; ++d) o[d] *= f;
                        m = s; }
                    const float p = __builtin_amdgcn_exp2f(s - m); lsum += p;
#pragma unroll
                    for (int c = 0; c < 8; ++c) { const v4u w = Vt[j * 8 + c];
                        o[c * 8 + 0] = fmaf(p, pg8::bflo(w.x), o[c * 8 + 0]); o[c * 8 + 1] = fmaf(p, pg8::bfhi(w.x), o[c * 8 + 1]); o[c * 8 + 2] = fmaf(p, pg8::bflo(w.y), o[c * 8 + 2]); o[c * 8 + 3] = fmaf(p, pg8::bfhi(w.y), o[c * 8 + 3]);
                        o[c * 8 + 4] = fmaf(p, pg8::bflo(w.z), o[c * 8 + 4]); o[c * 8 + 5] = fmaf(p, pg8::bfhi(w.z), o[c * 8 + 5]); o[c * 8 + 6] = fmaf(p, pg8::bflo(w.w), o[c * 8 + 6]); o[c * 8 + 7] = fmaf(p, pg8::bfhi(w.w), o[c * 8 + 7]); }
                }
            }
        }
        const float inv = 1.0f / lsum; float part = 0.f;
#pragma unroll
        for (int c = 0; c < 8; ++c) { float e[8];
#pragma unroll
            for (int d = 0; d < 8; ++d) { e[d] = o[c * 8 + d] * inv; part += e[d] * e[d]; }
            v4u w; w.x = pk2(e[0], e[1]); w.y = pk2(e[2], e[3]); w.z = pk2(e[4], e[5]); w.w = pk2(e[6], e[7]);
            *(v4u*)(MIX + qrow * 1024 + 512 + h * 64 + c * 8) = w; }
        atomicAdd(ss_att + qrow, part);
    }
}

__device__ __forceinline__ void final_norm_phase() {
    Frame F = mk_frame();
    float* out = KOUT(); const float* ssf = ss_arr(KWS(), 8); const float* g = KIN(20);
    const int gw = opaque_s(F.vcu) * NWAVES + opaque_s(F.wave), NGW = opaque_s(F.G) * NWAVES;
    for (int m = gw; m < MROWS; m += NGW) {
        GAS f32x4* xr = (GAS f32x4*)(out + (size_t)m * DM) + F.lane; const f32x4* gr = (const f32x4*)g + F.lane;
        const float r = rsqrtf(ssf[m] * (1.0f / 1024.0f) + EPS);
#pragma unroll
        for (int j = 0; j < 4; ++j) { const f32x4 v = xr[64 * j]; const f32x4 gg = gr[64 * j]; xr[64 * j] = v * r * gg; }
    }
}

struct Args { const float* in[21]; float* out; unsigned char* ws; int pad0, pad1; };
__global__ void __launch_bounds__(NWAVES * 64, 2) fwd_megakernel(Args args) {
    if (DBG_STOP == -4) return;
    {
        Frame F = mk_frame();
        for (int u = F.tid; u < (LDS_BYTES - LDSCTL_OFF) / 4; u += NWAVES * 64) ((LAS unsigned*)(F.lds + LDSCTL_OFF))[u] = 0u;
        __syncthreads();
    }
    if (DBG_STOP == -5) return;
    XcdBarrier bar = xcd_barrier_post((unsigned*)(KWS() + WS_CTL) + CW_BAR, (volatile LAS unsigned*)((LAS unsigned char*)g_lds + MISC_OFF) + 8);
#define GRID_BAR() xcd_barrier(bar)
#define LDSRING ((LAS unsigned char*)g_lds + RING_OFF)
#define GRIDG opaque_s((int)gridDim.x)
#define BLK opaque_s((int)blockIdx.x)

    if (DBG_STOP == -2) return;
    if (DBG_STOP != -3) p0_prologue();
    GRID_BAR();
    if (DBG_STOP == 0 || DBG_STOP == -3) return;

    for (int l = 0; l < DEPTH; ++l) {
        csum_items(l);
        {
            unsigned char* ws = KWS();
            pg8::Gemm g{(const bf16*)(ws + WS_HB), (const bf16*)(ws + WS_WIN) + (size_t)l * 2048 * DM, MROWS, 2048, DM}; pg8::StaticOrder S; S.init(MROWS, 2048, GRIDG, BLK);
            pg8::EpiProj E{(bf16*)(ws + WS_U), (size_t)(WS_Q - WS_U) / 2, ss_arr(ws, 4 * l), C2, 0};
            pg8::gemm_phase<pg8::EpiProj, pg8::StaticOrder, true, true>(LDSRING, g, S, E);
        }
        GRID_BAR();
        if (DBG_STOP == 1) return;
        ssm_naive_phase(l);
        attn_naive_phase(l);
        GRID_BAR();
        if (DBG_STOP == 2) return;
        {
            unsigned char* ws = KWS();
            pg8::Gemm g{(const bf16*)(ws + WS_GB), (const bf16*)(ws + WS_WGLU) + (size_t)l * DSSM * DSSM, MROWS, DSSM, DSSM}; pg8::StaticOrder S; S.init(MROWS, DSSM, GRIDG, BLK);
            pg8::EpiGlu E{(const bf16*)(ws + WS_GB), (bf16*)(ws + WS_MIX), KIN(12) + l * DSSM, ss_arr(ws, 4 * l + 1), 0};
            pg8::gemm_phase<pg8::EpiGlu, pg8::StaticOrder, true, true>(LDSRING, g, S, E);
        }
        GRID_BAR();
        {
            unsigned char* ws = KWS(); float* out = KOUT();
            pg8::Gemm g{(const bf16*)(ws + WS_MIX), (const bf16*)(ws + WS_WOUT) + (size_t)l * DM * DM, MROWS, DM, DM}; pg8::StaticOrder S; S.init(MROWS, DM, GRIDG, BLK);
            pg8::EpiOut E{l, 8};
            pg8::gemm_phase<pg8::EpiOut, pg8::StaticOrder, true, true>(LDSRING, g, S, E);
        }
        GRID_BAR();
        {
            unsigned char* ws = KWS();
            pg8::Gemm g{(const bf16*)(ws + WS_HB), (const bf16*)(ws + WS_WUP) + (size_t)l * DFF * DM, MROWS, DFF, DM}; pg8::StaticOrder S; S.init(MROWS, DFF, GRIDG, BLK);
            pg8::EpiUp E{(bf16*)(ws + WS_HID), ss_arr(ws, 4 * l + 3), 0};
            pg8::gemm_phase<pg8::EpiUp, pg8::StaticOrder, true, true>(LDSRING, g, S, E);
        }
        GRID_BAR();
        {
            unsigned char* ws = KWS(); float* out = KOUT();
            pg8::Gemm g{(const bf16*)(ws + WS_HID), (const bf16*)(ws + WS_WDN) + (size_t)l * DM * DFF, MROWS, DM, DFF}; pg8::StaticOrder S; S.init(MROWS, DM, GRIDG, BLK);
            pg8::EpiDown E{out, (bf16*)(ws + WS_HB), ss_arr(ws, 4 * l + 4), 0};
            pg8::gemm_phase<pg8::EpiDown, pg8::StaticOrder, true, true>(LDSRING, g, S, E);
        }
        GRID_BAR();
    }
    final_norm_phase();
}

extern "C" void kernel_launch(void* const* d_in, const int* in_sizes, int n_in, void* d_out, int out_size, void* d_ws, size_t ws_size, hipStream_t stream) {
    static int grid = 0;
    if (grid == 0) {
        if (n_in != 21 || out_size != MROWS * DM || ws_size < WS_END) { fprintf(stderr, "kernel_launch: unexpected shapes (n_in %d, out %d, ws %zu)\n", n_in, out_size, ws_size); grid = -1; return; }
        int dev = 0, cus = 0, per_cu = 0;
        if (hipGetDevice(&dev) != hipSuccess || hipDeviceGetAttribute(&cus, hipDeviceAttributeMultiprocessorCount, dev) != hipSuccess) { grid = -1; return; }
        if (hipFuncSetAttribute((const void*)fwd_megakernel, hipFuncAttributeMaxDynamicSharedMemorySize, LDS_BYTES) != hipSuccess) { fprintf(stderr, "kernel_launch: hipFuncSetAttribute failed\n"); grid = -1; return; }
        if (hipOccupancyMaxActiveBlocksPerMultiprocessor(&per_cu, (const void*)fwd_megakernel, NWAVES * 64, LDS_BYTES) != hipSuccess || per_cu < 1) { fprintf(stderr, "kernel_launch: occupancy query says %d blocks per CU\n", per_cu); }
        (void)hipGetLastError();
        grid = cus;
    }
    if (grid < 0) return;
    if (hipMemsetAsync((char*)d_ws + WS_CTL, 0, CTL_ZERO_BYTES, stream) != hipSuccess) { fprintf(stderr, "kernel_launch: memset failed\n"); return; }
    Args a{};
    for (int i = 0; i < 21; ++i) a.in[i] = (const float*)d_in[i];
    a.out = (float*)d_out; a.ws = (unsigned char*)d_ws;
    hipLaunchKernelGGL(fwd_megakernel, dim3(grid), dim3(NWAVES * 64), LDS_BYTES, stream, a);
    const hipError_t le = hipPeekAtLastError();
    if (le != hipSuccess) fprintf(stderr, "kernel_launch: launch failed: %s\n", hipGetErrorName(le));
}
```

```cpp
#include <hip/hip_runtime.h>
#include <cstdio>
#include <cstdint>

constexpr int BATCH = 4, SEQ = 4096, DM = 1024, MROWS = BATCH * SEQ, DEPTH = 2;
constexpr int DSSM = 512, DATT = 512, NHEAD = 8, HDIM = 64, DFF = 4096, DIN = 2056;
constexpr int SG = 32, SP = 16, SN = 64;
constexpr float EPS = 1e-6f;
constexpr float LOG2E = 1.4426950408889634f;
constexpr float C2 = 0.125f * 1.4426950408889634f;
namespace pg8 {
#define PG8_LAS __attribute__((address_space(3)))
typedef unsigned short bf16_t;
typedef short bf16x8 __attribute__((ext_vector_type(8)));
typedef float f32x4 __attribute__((ext_vector_type(4)));
typedef unsigned u32x4 __attribute__((ext_vector_type(4)));
constexpr int BM = 256, BK = 64, HALF = 128, HTB = HALF * BK * 2  , STAGE_BYTES = 8 * HTB, NXCD = 8, WGM = 8;

__host__ __device__ __forceinline__ int lds_byte(int r, int c) { const int st = (r >> 4) * 2 + (c >> 5), rr = r & 15, cc = c & 31, ob = rr * 64 + cc * 2; return st * 1024 + (ob ^ (((ob >> 9) & 1) << 5)); }
__host__ __device__ __forceinline__ void stage_rc(int b, int& R, int& C) { const int st = b / 1024, sb = b % 1024, swz = sb ^ (((sb >> 9) & 1) << 5); R = (st >> 1) * 16 + swz / 64; C = (st & 1) * 32 + (swz % 64) / 2; }
__host__ __device__ __forceinline__ int perm32(int rho) { const int n = rho >> 4, i = rho & 15; return 8 * (i >> 2) + 4 * n + (i & 3); }

struct Unit { int pm, pn; };
struct Gemm { const bf16_t* A; const bf16_t* Bt; int M, N, K; };

struct StaticOrder {
    int nM, nN, nwg, G, c;
    __host__ __device__ void init(int M, int N, int G_, int c_) { nM = M / BM; nN = N / BM; nwg = nM * nN; G = G_; c = c_; }
    __host__ __device__ bool next(int i, Unit& u) const {
        const long L = (long)i * G + c; if (L >= nwg) return false;
        int wgid = (int)L; { const int q = nwg / NXCD, r = nwg % NXCD, xcd = wgid % NXCD, off = wgid / NXCD; wgid = (xcd < r ? xcd * (q + 1) : r * (q + 1) + (xcd - r) * q) + off; }
        const int nig = WGM * nN, gid = wgid / nig, fm = gid * WGM, gsz = (nM - fm) < WGM ? (nM - fm) : WGM;
        u.pm = fm + ((wgid % nig) % gsz); u.pn = (wgid % nig) / gsz; return true;
    }
    __device__ __forceinline__ void a_ready(const Unit&) const {}
    __device__ __forceinline__ void done(const Unit&) const {}
};


__device__ __forceinline__ unsigned cvt_pk_bf16(float lo, float hi) { unsigned r; asm volatile("v_cvt_pk_bf16_f32 %0, %1, %2" : "=v"(r) : "v"(lo), "v"(hi)); return r; }
__device__ __forceinline__ float bflo(unsigned w) { return __uint_as_float(w << 16); }
__device__ __forceinline__ float bfhi(unsigned w) { return __uint_as_float(w & 0xffff0000u); }
typedef unsigned u32x2 __attribute__((ext_vector_type(2)));
constexpr int EP_M = 16384;
typedef __attribute__((address_space(4))) const unsigned char* ep_kptr_t;
template <class T> __device__ __forceinline__ T* ep_karg(int i) { ep_kptr_t p = (ep_kptr_t)__builtin_amdgcn_kernarg_segment_ptr(); asm volatile("" : "+s"(p)); return *(T* const __attribute__((address_space(4)))*)(p + 8 * i); }
__device__ __forceinline__ float* ep_ss(int i) { return (float*)(ep_karg<unsigned char>(22) + (1u << 20)) + (size_t)i * EP_M; }
__device__ __forceinline__ float* ep_out() { return ep_karg<float>(21); }
__device__ __forceinline__ const float* ep_x() { return ep_karg<const float>(0); }
__device__ __forceinline__ bf16_t* ep_hb() { return (bf16_t*)(ep_karg<unsigned char>(22) + (66u << 20)); }

struct EpiProj {
    static constexpr bool PERM = true, AFTER_DRAIN = false, MIDK = false;
    bf16_t* O; size_t stride; const float* ss; float qscale; int midk_t;
    __device__ __forceinline__ void midk(f32x4 (&)[2][2][4][2], const Unit&, int, int, int, int) const {}
    __device__ __forceinline__ void operator()(const f32x4 (&acc)[2][2][4][2], const Unit& u, int wr, int wc, int fr, int fq) const {
        const int row0 = u.pm * BM + wr * 64 + fr; int colt = u.pn * BM; const int t = colt / 512; colt -= t * 512;
        bf16_t* base = O + (size_t)t * stride; const float sc = (t == 1) ? qscale : 1.0f;
        const int col0 = colt + wc * 32 + 8 * fq;
#pragma unroll
        for (int ai = 0; ai < 2; ++ai)
#pragma unroll
            for (int m = 0; m < 4; ++m) { const int row = row0 + ai * HALF + m * 16; const float rs = rsqrtf(ss[row] * (1.0f / 1024.0f) + 1e-6f) * sc;
                bf16_t* rowp = (t == 0) ? base + ((size_t)(col0 >> 4) * EP_M + row) * 16 + (col0 & 15) : base + (size_t)row * 512 + col0;
#pragma unroll
                for (int bj = 0; bj < 2; ++bj) { const f32x4 v0 = acc[ai][bj][m][0] * rs, v1 = acc[ai][bj][m][1] * rs;
                    u32x4 w; w.x = cvt_pk_bf16(v0[0], v0[1]); w.y = cvt_pk_bf16(v0[2], v0[3]); w.z = cvt_pk_bf16(v1[0], v1[1]); w.w = cvt_pk_bf16(v1[2], v1[3]);
                    *(u32x4*)(rowp + (t == 0 ? (size_t)bj * 8 * EP_M * 16 : (size_t)bj * HALF)) = w; } }
    }
};
struct EpiGlu {
    static constexpr bool PERM = true, AFTER_DRAIN = false, MIDK = false;
    const bf16_t* GB; bf16_t* MIX; const float* bias; float* ss; int midk_t;
    __device__ __forceinline__ void midk(f32x4 (&)[2][2][4][2], const Unit&, int, int, int, int) const {}
    __device__ __forceinline__ void operator()(const f32x4 (&acc)[2][2][4][2], const Unit& u, int wr, int wc, int fr, int fq) const {
        const int row0 = u.pm * BM + wr * 64 + fr, col0 = u.pn * BM + wc * 32 + 8 * fq;
        f32x4 bv[2][2];
#pragma unroll
        for (int bj = 0; bj < 2; ++bj)
#pragma unroll
            for (int n = 0; n < 2; ++n) bv[bj][n] = *(const f32x4*)(bias + col0 + bj * HALF + 4 * n);
#pragma unroll
        for (int ai = 0; ai < 2; ++ai)
#pragma unroll
            for (int m = 0; m < 4; ++m) { const int row = row0 + ai * HALF + m * 16; float part = 0.f;
#pragma unroll
                for (int bj = 0; bj < 2; ++bj) {
                    const u32x4 gw = *(const u32x4*)(GB + (size_t)row * 512 + col0 + bj * HALF);
                    const f32x4 z0 = acc[ai][bj][m][0] + bv[bj][0], z1 = acc[ai][bj][m][1] + bv[bj][1];
                    float g[8] = {bflo(gw.x), bfhi(gw.x), bflo(gw.y), bfhi(gw.y), bflo(gw.z), bfhi(gw.z), bflo(gw.w), bfhi(gw.w)};
                    float z[8] = {z0[0], z0[1], z0[2], z0[3], z1[0], z1[1], z1[2], z1[3]}; float o[8];
#pragma unroll
                    for (int e = 0; e < 8; ++e) { const float s = __builtin_amdgcn_rcpf(1.0f + __builtin_amdgcn_exp2f(-z[e] * 1.4426950408889634f)); o[e] = g[e] * s; part += o[e] * o[e]; }
                    u32x4 w; w.x = cvt_pk_bf16(o[0], o[1]); w.y = cvt_pk_bf16(o[2], o[3]); w.z = cvt_pk_bf16(o[4], o[5]); w.w = cvt_pk_bf16(o[6], o[7]);
                    *(u32x4*)(MIX + (size_t)row * 1024 + col0 + bj * HALF) = w; }
                part += __shfl_xor(part, 16); part += __shfl_xor(part, 32);
                if (fq == 0) atomicAdd(ss + row, part); }
    }
};
struct EpiOut {
    static constexpr bool PERM = false, AFTER_DRAIN = false, MIDK = true;
    int l; int midk_t;
    __device__ __forceinline__ void midk(f32x4 (&acc)[2][2][4][2], const Unit& u, int wr, int wc, int fr, int fq) const {
        const float* ss_ssm = ep_ss(4 * l + 1); const float* ss_att = ss_ssm + EP_M;
        const int row0 = u.pm * BM + wr * 64 + fr;
#pragma unroll
        for (int ai = 0; ai < 2; ++ai)
#pragma unroll
            for (int m = 0; m < 4; ++m) { const int row = row0 + ai * HALF + m * 16;
                const float ra = sqrtf((ss_att[row] * (1.0f / 512.0f) + 1e-6f) / (ss_ssm[row] * (1.0f / 512.0f) + 1e-6f));
#pragma unroll
                for (int bj = 0; bj < 2; ++bj)
#pragma unroll
                    for (int n = 0; n < 2; ++n) acc[ai][bj][m][n] *= ra; }
    }
    __device__ __forceinline__ void operator()(const f32x4 (&acc)[2][2][4][2], const Unit& u, int wr, int wc, int fr, int fq) const {
        const float* ss_att = ep_ss(4 * l + 2); float* ss2 = (float*)ss_att + EP_M; float* out = ep_out(); const float* base = (l == 0) ? ep_x() : (const float*)out; bf16_t* HB = ep_hb();
        const int row0 = u.pm * BM + wr * 64 + fr, col0 = u.pn * BM + wc * 32 + 4 * fq;
#pragma unroll
        for (int ai = 0; ai < 2; ++ai)
#pragma unroll
            for (int m = 0; m < 4; ++m) { const int row = row0 + ai * HALF + m * 16; const float r2 = rsqrtf(ss_att[row] * (1.0f / 512.0f) + 1e-6f); float part = 0.f;
                const size_t off = (size_t)row * 1024 + col0;
#pragma unroll
                for (int bj = 0; bj < 2; ++bj)
#pragma unroll
                    for (int n = 0; n < 2; ++n) { const f32x4 bs = *(const f32x4*)(base + off + bj * HALF + n * 16); const f32x4 o = bs + acc[ai][bj][m][n] * r2;
                        *(f32x4*)(out + off + bj * HALF + n * 16) = o; part += (o[0] * o[0] + o[1] * o[1]) + (o[2] * o[2] + o[3] * o[3]);
                        u32x2 w; w.x = cvt_pk_bf16(o[0], o[1]); w.y = cvt_pk_bf16(o[2], o[3]); *(u32x2*)(HB + off + bj * HALF + n * 16) = w; }
                part += __shfl_xor(part, 16); part += __shfl_xor(part, 32);
                if (fq == 0) atomicAdd(ss2 + row, part); }
    }
};
struct EpiUp {
    static constexpr bool PERM = true, AFTER_DRAIN = false, MIDK = false;
    bf16_t* O; const float* ss; int midk_t;
    __device__ __forceinline__ void midk(f32x4 (&)[2][2][4][2], const Unit&, int, int, int, int) const {}
    __device__ __forceinline__ void operator()(const f32x4 (&acc)[2][2][4][2], const Unit& u, int wr, int wc, int fr, int fq) const {
        const int row0 = u.pm * BM + wr * 64 + fr, col0 = u.pn * BM + wc * 32 + 8 * fq;
#pragma unroll
        for (int ai = 0; ai < 2; ++ai)
#pragma unroll
            for (int m = 0; m < 4; ++m) { const int row = row0 + ai * HALF + m * 16; const float rs = rsqrtf(ss[row] * (1.0f / 1024.0f) + 1e-6f);
                bf16_t* rowp = O + (size_t)row * 4096 + col0;
#pragma unroll
                for (int bj = 0; bj < 2; ++bj) { f32x4 v0 = acc[ai][bj][m][0] * rs, v1 = acc[ai][bj][m][1] * rs;
#pragma unroll
                    for (int e = 0; e < 4; ++e) { v0[e] = fmaxf(v0[e], 0.f); v0[e] *= v0[e]; v1[e] = fmaxf(v1[e], 0.f); v1[e] *= v1[e]; }
                    u32x4 w; w.x = cvt_pk_bf16(v0[0], v0[1]); w.y = cvt_pk_bf16(v0[2], v0[3]); w.z = cvt_pk_bf16(v1[0], v1[1]); w.w = cvt_pk_bf16(v1[2], v1[3]);
                    *(u32x4*)(rowp + bj * HALF) = w; } }
    }
};
struct EpiDown {
    static constexpr bool PERM = false, AFTER_DRAIN = false, MIDK = false;
    float* h; bf16_t* HB; float* ssn; int midk_t;
    __device__ __forceinline__ void midk(f32x4 (&)[2][2][4][2], const Unit&, int, int, int, int) const {}
    __device__ __forceinline__ void operator()(const f32x4 (&acc)[2][2][4][2], const Unit& u, int wr, int wc, int fr, int fq) const {
        const int row0 = u.pm * BM + wr * 64 + fr, col0 = u.pn * BM + wc * 32 + 4 * fq;
#pragma unroll
        for (int ai = 0; ai < 2; ++ai)
#pragma unroll
            for (int m = 0; m < 4; ++m) { const int row = row0 + ai * HALF + m * 16; float part = 0.f;
                const size_t off = (size_t)row * 1024 + col0;
#pragma unroll
                for (int bj = 0; bj < 2; ++bj)
#pragma unroll
                    for (int n = 0; n < 2; ++n) { const f32x4 bs = *(const f32x4*)(h + off + bj * HALF + n * 16); const f32x4 o = bs + acc[ai][bj][m][n];
                        *(f32x4*)(h + off + bj * HALF + n * 16) = o; part += (o[0] * o[0] + o[1] * o[1]) + (o[2] * o[2] + o[3] * o[3]);
                        u32x2 w; w.x = cvt_pk_bf16(o[0], o[1]); w.y = cvt_pk_bf16(o[2], o[3]); *(u32x2*)(HB + off + bj * HALF + n * 16) = w; }
                part += __shfl_xor(part, 16); part += __shfl_xor(part, 32);
                if (fq == 0) atomicAdd(ssn + row, part); }
    }
};
template <class Epi, class Sched, bool ALIGN_EPI = false, bool SP2 = false>
__device__ __forceinline__ void gemm_phase(PG8_LAS unsigned char* lds, const Gemm g, const Sched& S, const Epi& E) {
    int tid_ = threadIdx.x; asm volatile("" : "+v"(tid_));
    const int tid = tid_, wid = __builtin_amdgcn_readfirstlane(tid >> 6), lane = tid & 63, wr = wid >> 2, wc = wid & 3, fr = lane & 15, fq = lane >> 4;
    const int K = g.K, nt = K / BK;
    unsigned voffA[2], voffB[2];
#pragma unroll
    for (int i = 0; i < 2; ++i) { int R, C; stage_rc(tid * 16 + i * 8192, R, C); const int Rb = Epi::PERM ? ((R & ~31) + perm32(R & 31)) : R;
        voffA[i] = (unsigned)(R * K + C) * 2u; voffB[i] = (unsigned)(Rb * K + C) * 2u; }
    const size_t kstep = (size_t)(BK * 2);
    const size_t hstep = (size_t)HALF * K * 2;
    const size_t tstep = 2 * hstep;
    const unsigned ldsw = (unsigned)wid * 1024u;
    const int aoff = lds_byte(wr * 64 + fr, fq * 8), boff = lds_byte(wc * 32 + fr, fq * 8);
#define PG8_SA(b, h) (((b) * 2 + (h)) * HTB)
#define PG8_SB(b, h) ((4 + (b) * 2 + (h)) * HTB)
#define PG8_STAGE(bufoff, gbase, voff) do { _Pragma("unroll") for (int _i = 0; _i < 2; ++_i) \
        __builtin_amdgcn_global_load_lds((const unsigned*)((const char*)(gbase) + (voff)[_i]), (PG8_LAS unsigned*)(lds + (bufoff) + ldsw + _i * 8192), 16, 0, 0); } while (0)
#define PG8_LDA(dst, b, h) do { _Pragma("unroll") for (int m = 0; m < 4; ++m) _Pragma("unroll") for (int k = 0; k < 2; ++k) dst[m][k] = *(const PG8_LAS bf16x8*)(lds + PG8_SA(b, h) + aoff + m * 2048 + k * 1024); } while (0)
#define PG8_LDB(dst, b, h) do { _Pragma("unroll") for (int n = 0; n < 2; ++n) _Pragma("unroll") for (int k = 0; k < 2; ++k) dst[n][k] = *(const PG8_LAS bf16x8*)(lds + PG8_SB(b, h) + boff + n * 2048 + k * 1024); } while (0)
#define PG8_MMA(ai, bj, At, Bt) do { __builtin_amdgcn_s_setprio(1); _Pragma("unroll") for (int m = 0; m < 4; ++m) _Pragma("unroll") for (int n = 0; n < 2; ++n) _Pragma("unroll") for (int k = 0; k < 2; ++k) \
        acc[ai][bj][m][n] = __builtin_amdgcn_mfma_f32_16x16x32_bf16(Bt[n][k], At[m][k], acc[ai][bj][m][n], 0, 0, 0); __builtin_amdgcn_s_setprio(0); } while (0)
#define PG8_WAIT_V(n) asm volatile("s_waitcnt vmcnt(" #n ")" ::: "memory")
#define PG8_WAIT_L(n) asm volatile("s_waitcnt lgkmcnt(" #n ")" ::: "memory")
#define PG8_BAR __builtin_amdgcn_s_barrier()
#define PG8_SCHED __builtin_amdgcn_sched_barrier(0)
    Unit cur, nxt; int ui = 0;
    if (!S.next(0, cur)) return;
    f32x4 acc[2][2][4][2];
#pragma unroll
    for (int a = 0; a < 2; ++a)
#pragma unroll
        for (int b = 0; b < 2; ++b)
#pragma unroll
            for (int m = 0; m < 4; ++m)
#pragma unroll
                for (int n = 0; n < 2; ++n) acc[a][b][m][n] = (f32x4){0.f, 0.f, 0.f, 0.f};
    bf16x8 At[4][2], B0[2][2], B1[2][2];
    const char* cA = (const char*)g.A + (size_t)cur.pm * tstep; const char* cB = (const char*)g.Bt + (size_t)cur.pn * tstep;
    S.a_ready(cur);
    if constexpr (SP2) {
        PG8_STAGE(PG8_SB(0, 0), cB, voffB); PG8_STAGE(PG8_SB(0, 1), cB + hstep, voffB); PG8_STAGE(PG8_SA(0, 0), cA, voffA); PG8_STAGE(PG8_SA(0, 1), cA + hstep, voffA);
        if (wr == 1) PG8_BAR;
        PG8_WAIT_V(2); PG8_BAR;
        PG8_STAGE(PG8_SB(1, 0), cB + kstep, voffB); PG8_STAGE(PG8_SA(1, 0), cA + kstep, voffA); PG8_STAGE(PG8_SB(1, 1), cB + hstep + kstep, voffB);
        PG8_WAIT_V(6); PG8_BAR;
    } else {
        PG8_STAGE(PG8_SB(0, 0), cB, voffB); PG8_STAGE(PG8_SA(0, 0), cA, voffA); PG8_STAGE(PG8_SB(0, 1), cB + hstep, voffB); PG8_STAGE(PG8_SA(0, 1), cA + hstep, voffA);
        if (wr == 1) PG8_BAR;
        PG8_WAIT_V(4); PG8_BAR;
        PG8_STAGE(PG8_SB(1, 0), cB + kstep, voffB); PG8_STAGE(PG8_SA(1, 0), cA + kstep, voffA); PG8_STAGE(PG8_SB(1, 1), cB + hstep + kstep, voffB);
        PG8_WAIT_V(6); PG8_BAR;
    }
    for (;;) {
        const bool has_next = S.next(ui + 1, nxt);
        const char* nA = has_next ? (const char*)g.A + (size_t)nxt.pm * tstep : cA; const char* nB = has_next ? (const char*)g.Bt + (size_t)nxt.pn * tstep : cB;
        for (int t = 0; t < nt; t += 2) {
            if constexpr (Epi::MIDK) { if (t == E.midk_t) E.midk(acc, cur, wr, wc, fr, fq); }
            const bool last = (t == nt - 2);
            const char* a1 = cA + (size_t)(t + 1) * kstep;
            const char* a2 = last ? nA : cA + (size_t)(t + 2) * kstep; const char* b2 = last ? nB : cB + (size_t)(t + 2) * kstep;
            const char* a3 = a2 + kstep; const char* b3 = b2 + kstep;
            if (last && has_next) S.a_ready(nxt);
            if constexpr (SP2) {
            PG8_LDB(B0, 0, 0); PG8_LDB(B1, 0, 1); PG8_SCHED; PG8_LDA(At, 0, 0); PG8_STAGE(PG8_SA(1, 1), a1 + hstep, voffA);
            PG8_WAIT_V(8); PG8_WAIT_L(0); PG8_BAR; PG8_MMA(0, 0, At, B0); PG8_MMA(0, 1, At, B1); PG8_BAR; PG8_SCHED;
            PG8_LDA(At, 0, 1); PG8_STAGE(PG8_SB(0, 0), b2, voffB); PG8_STAGE(PG8_SB(0, 1), b2 + hstep, voffB); PG8_STAGE(PG8_SA(0, 0), a2, voffA);
            PG8_WAIT_V(8); PG8_WAIT_L(0); PG8_BAR; PG8_MMA(1, 0, At, B0); PG8_MMA(1, 1, At, B1); PG8_BAR; PG8_SCHED;
            PG8_LDB(B0, 1, 0); PG8_LDB(B1, 1, 1); PG8_SCHED; PG8_LDA(At, 1, 0); PG8_STAGE(PG8_SA(0, 1), a2 + hstep, voffA);
            PG8_WAIT_V(8); PG8_WAIT_L(0); PG8_BAR; PG8_MMA(0, 0, At, B0); PG8_MMA(0, 1, At, B1); PG8_BAR; PG8_SCHED;
            PG8_LDA(At, 1, 1); PG8_STAGE(PG8_SB(1, 0), b3, voffB); PG8_STAGE(PG8_SB(1, 1), b3 + hstep, voffB); PG8_STAGE(PG8_SA(1, 0), a3, voffA);
            PG8_WAIT_V(8); PG8_WAIT_L(0); PG8_BAR; PG8_MMA(1, 0, At, B0); PG8_MMA(1, 1, At, B1); PG8_BAR; PG8_SCHED;
            } else {
            PG8_LDB(B0, 0, 0); PG8_SCHED; PG8_LDA(At, 0, 0); PG8_STAGE(PG8_SA(1, 1), a1 + hstep, voffA);
            PG8_WAIT_L(8); PG8_BAR; PG8_WAIT_L(0); PG8_MMA(0, 0, At, B0); PG8_BAR; PG8_SCHED;
            PG8_LDB(B1, 0, 1); PG8_STAGE(PG8_SB(0, 0), b2, voffB);
            PG8_BAR; PG8_WAIT_L(0); PG8_MMA(0, 1, At, B1); PG8_BAR;
            PG8_LDA(At, 0, 1); PG8_STAGE(PG8_SA(0, 0), a2, voffA);
            PG8_BAR; PG8_WAIT_L(0); PG8_MMA(1, 0, At, B0); PG8_BAR; PG8_SCHED;
            PG8_STAGE(PG8_SB(0, 1), b2 + hstep, voffB);
            PG8_WAIT_V(6); PG8_BAR; PG8_MMA(1, 1, At, B1); PG8_BAR;
            PG8_LDB(B0, 1, 0); PG8_SCHED; PG8_LDA(At, 1, 0); PG8_STAGE(PG8_SA(0, 1), a2 + hstep, voffA);
            PG8_WAIT_L(8); PG8_BAR; PG8_WAIT_L(0); PG8_MMA(0, 0, At, B0); PG8_BAR; PG8_SCHED;
            PG8_LDB(B1, 1, 1); PG8_STAGE(PG8_SB(1, 0), b3, voffB);
            PG8_BAR; PG8_WAIT_L(0); PG8_MMA(0, 1, At, B1); PG8_BAR;
            PG8_LDA(At, 1, 1); PG8_STAGE(PG8_SA(1, 0), a3, voffA);
            PG8_BAR; PG8_WAIT_L(0); PG8_MMA(1, 0, At, B0); PG8_BAR; PG8_SCHED;
            PG8_STAGE(PG8_SB(1, 1), b3 + hstep, voffB);
            PG8_WAIT_V(6); PG8_BAR; PG8_MMA(1, 1, At, B1); PG8_BAR;
            }
        }
        if constexpr (ALIGN_EPI) { if (wr == 0) PG8_BAR; }
        if constexpr (!Epi::AFTER_DRAIN) { E(acc, cur, wr, wc, fr, fq); S.done(cur); }
        if (!has_next) break;
#pragma unroll
        for (int a = 0; a < 2; ++a)
#pragma unroll
            for (int b = 0; b < 2; ++b)
#pragma unroll
                for (int m = 0; m < 4; ++m)
#pragma unroll
                    for (int n = 0; n < 2; ++n) acc[a][b][m][n] = (f32x4){0.f, 0.f, 0.f, 0.f};
        cur = nxt; cA = nA; cB = nB; ++ui;
        if constexpr (ALIGN_EPI) { if (wr == 1) PG8_BAR; }
    }
    PG8_WAIT_V(0);
    if constexpr (!ALIGN_EPI) { if (wr == 0) PG8_BAR; }
    PG8_BAR;
    if constexpr (Epi::AFTER_DRAIN) { E.fused(acc, cur, wr, wc, fr, fq, lds, wid, lane); S.done(cur); }
#undef PG8_SA
#undef PG8_SB
#undef PG8_STAGE
#undef PG8_LDA
#undef PG8_LDB
#undef PG8_MMA
#undef PG8_WAIT_V
#undef PG8_WAIT_L
#undef PG8_BAR
#undef PG8_SCHED
}
}

#define GAS __attribute__((address_space(1)))
#define LAS __attribute__((address_space(3)))
typedef unsigned short bf16;
typedef unsigned v4u __attribute__((ext_vector_type(4)));
typedef float f32x4 __attribute__((ext_vector_type(4)));
typedef short bf16x8 __attribute__((ext_vector_type(8)));
typedef GAS unsigned gu32;
typedef GAS unsigned long long gu64;
#define RLX_AGENT __ATOMIC_RELAXED, __HIP_MEMORY_SCOPE_AGENT
#define LDS_WAIT() asm volatile("s_waitcnt lgkmcnt(0)" ::: "memory")
#define VM_WAIT() asm volatile("s_waitcnt vmcnt(0)" ::: "memory")
__device__ __forceinline__ unsigned long long rt() { return __builtin_amdgcn_s_memrealtime(); }
__device__ __forceinline__ unsigned f2bf(float f) { unsigned u = __builtin_bit_cast(unsigned, f); return (u + 0x7fffu + ((u >> 16) & 1u)) >> 16; }
__device__ __forceinline__ unsigned pk2(float lo, float hi) { return f2bf(lo) | (f2bf(hi) << 16); }
#define XB_TMO      128
#define XB_XCNT(j)  (256  + 64 * (j))
#define XB_XSUB(j)  (1280 + 64 * (j))
#define XB_XGEN(j)  (2304 + 64 * (j))
#define XB_TOP      3328
#define XB_TOPGEN   3392
#define XCD_BAR_WORDS 3456
#define XB_SPIN_CAP (1u << 18)

__device__ __forceinline__ unsigned xb_ld(unsigned* p)              { return __hip_atomic_load(p, __ATOMIC_RELAXED, __HIP_MEMORY_SCOPE_AGENT); }
__device__ __forceinline__ unsigned xb_add(unsigned* p, unsigned v) { return __hip_atomic_fetch_add(p, v, __ATOMIC_RELAXED, __HIP_MEMORY_SCOPE_AGENT); }
__device__ __forceinline__ unsigned xb_xcc_id() { return (unsigned)__builtin_amdgcn_s_getreg((3 << 11) | 20) & 0xFu; }
#define XB_SPIN(cond, bar) do { unsigned _sp = 0; while (cond) { __builtin_amdgcn_s_sleep(1); \
    if ((++_sp & 255u) == 0u) { if (xb_ld(&(bar)[XB_TMO])) break; if (_sp > XB_SPIN_CAP) { atomicAdd(&(bar)[XB_TMO], 1u); break; } } } } while (0)

struct XcdBarrier {
    unsigned* bar; unsigned x;
    volatile LAS unsigned* st;
};

__device__ __forceinline__ XcdBarrier xcd_barrier_post(unsigned* bar, volatile LAS unsigned* st) {
    XcdBarrier b; b.bar = bar; b.x = xb_xcc_id(); b.st = st;
    if (threadIdx.x == 0) (void)xb_add(&bar[XB_XCNT(b.x)], 1u);
    return b;
}
__device__ __forceinline__ void xcd_barrier_complete(unsigned* bar, unsigned x, unsigned& nloc, unsigned& nx) {
    const unsigned G = gridDim.x * gridDim.y * gridDim.z;
    unsigned sum, cnt, mine, sp = 0u;
    for (;;) {
        sum = 0u; cnt = 0u; mine = 0u;
#pragma unroll
        for (unsigned j = 0; j < 16; ++j) { const unsigned c = xb_ld(&bar[XB_XCNT(j)]); sum += c; cnt += (c > 0u) ? 1u : 0u; mine = (j == x) ? c : mine; }
        if (sum == G) break;
        __builtin_amdgcn_s_sleep(1);
        if ((++sp & 255u) == 0u) { if (xb_ld(&bar[XB_TMO])) break; if (sp > XB_SPIN_CAP) { atomicAdd(&bar[XB_TMO], 1u); break; } }
    }
    nloc = mine > 0u ? mine : 1u; nx = cnt > 0u ? cnt : 1u;
}

__device__ __forceinline__ void xcd_barrier(const XcdBarrier& b) {
    asm volatile("s_waitcnt vmcnt(0)" ::: "memory");
    __syncthreads();
    if (threadIdx.x == 0) {
        unsigned* bar = b.bar; unsigned bx = b.x; asm volatile("" : "+s"(bar), "+s"(bx));
        __builtin_amdgcn_s_waitcnt(0);
        unsigned nloc = b.st[0], nx = b.st[1];
        if (nloc == 0u) { xcd_barrier_complete(bar, bx, nloc, nx); b.st[0] = nloc; b.st[1] = nx; }
        const unsigned old = xb_add(&bar[XB_XSUB(bx)], 1u);
        const unsigned gen = old / nloc;
        if (old + 1u == (gen + 1u) * nloc) {
            __builtin_amdgcn_fence(__ATOMIC_RELEASE, "agent");
            asm volatile("s_waitcnt vmcnt(0)" ::: "memory");
            const unsigned og = xb_add(&bar[XB_TOP], 1u);
            const unsigned tg = og / nx;
            if (og + 1u == (tg + 1u) * nx) xb_add(&bar[XB_TOPGEN], 1u);
            else XB_SPIN(xb_ld(&bar[XB_TOPGEN]) == tg, bar);
            __builtin_amdgcn_fence(__ATOMIC_ACQUIRE, "agent");
            xb_add(&bar[XB_XGEN(bx)], 1u);
            asm volatile("s_waitcnt vmcnt(0)" ::: "memory");
        } else {
            XB_SPIN(xb_ld(&bar[XB_XGEN(bx)]) == gen, bar);
            __builtin_amdgcn_fence(__ATOMIC_ACQUIRE, "agent");
            asm volatile("s_waitcnt vmcnt(0)" ::: "memory");
        }
    }
    __syncthreads();
}
#include <hip/hip_bf16.h>
#include <cmath>
namespace attn_body {
using bf16=__hip_bfloat16;
using bf16x8=__attribute__((ext_vector_type(8)))short;
using s16x4=__attribute__((ext_vector_type(4)))short;
using f32x16=__attribute__((ext_vector_type(16)))float;
using u32x4=__attribute__((ext_vector_type(4)))unsigned;
constexpr int BATCH=4,NHEAD=8,SEQ=4096,D=64,DM=NHEAD*D,OPITCH=1024;
constexpr int NW=8,QBLK=32,QB=QBLK*NW,KVBLK=64,NQB=SEQ/QB;
constexpr int ATTN_PITCH=DM, ATTN_UNIT_ROWS=QB;
__device__ __forceinline__ int crow(int r,int hi){return (r&3)+8*(r>>2)+4*hi;}
#define SBAR() __builtin_amdgcn_sched_barrier(0)
__device__ __forceinline__ void cmask(f32x16&p0,f32x16&p1,int jb,int qrel,int hi){
  const float NEG=-INFINITY; int kb=64*jb+4*hi;
  #pragma unroll
  for(int r=0;r<16;++r){int kv=kb+(r&3)+8*(r>>2); if(kv>qrel)p0[r]=NEG; if(kv+32>qrel)p1[r]=NEG;}
}

constexpr int NSLOT=3, SLOTB=9216;
constexpr int LDS_K=0, LDS_V=NSLOT*SLOTB, LDS_WS=2*NSLOT*SLOTB, LDS_OST=LDS_WS+NW*64*4, LDS_OFFT=LDS_OST+NW*4096, LDS_BYTES=LDS_OFFT+256;
constexpr float C2=0.125f*1.4426950408889634f;
__device__ __forceinline__ void glds16(const void*gsrc,unsigned lds_dst){unsigned keep;
  asm volatile("s_mov_b32 %0, m0\n\ts_mov_b32 m0, %2\n\ts_nop 0\n\tglobal_load_lds_dwordx4 %1, off\n\ts_mov_b32 m0, %0":"=&s"(keep):"v"(gsrc),"s"(lds_dst):"memory");}
__device__ __forceinline__ float max3f(float a,float b,float c){float r;asm("v_max3_f32 %0, %1, %2, %3":"=v"(r):"v"(a),"v"(b),"v"(c));return r;}
__device__ __forceinline__ float max2f(float a,float b){float r;asm("v_max_f32_e32 %0, %1, %2":"=v"(r):"v"(a),"v"(b));return r;}
__device__ __forceinline__ float fadd_s(float a,float b){float r;asm("v_add_f32_e32 %0, %1, %2":"=v"(r):"v"(a),"v"(b));return r;}
__device__ __forceinline__ float fsub_s(float a,float b){float r;asm("v_sub_f32_e32 %0, %1, %2":"=v"(r):"v"(a),"v"(b));return r;}
typedef float f32x2_t __attribute__((ext_vector_type(2))); typedef __bf16 bf16x2_t __attribute__((ext_vector_type(2)));
__device__ __forceinline__ unsigned cvtpk_s(float lo,float hi){f32x2_t v={lo,hi};bf16x2_t b=__builtin_convertvector(v,bf16x2_t);return __builtin_bit_cast(unsigned,b);}
#define WAIT_BAR_(N) asm volatile("s_waitcnt vmcnt(" #N ") lgkmcnt(0)\n\ts_barrier":::"memory")
#define WAIT_BAR(N,N0) do{ if(wid==0){WAIT_BAR_(N0);}else{WAIT_BAR_(N);} }while(0)
__device__ __forceinline__ bf16x8 mk_qaug(float x,unsigned himask){
  const unsigned w1=cvtpk_s(1.0f,x); const float r1=x-__uint_as_float(w1&0xffff0000u);
  const unsigned t=cvtpk_s(r1,0.f); const float r2=r1-__uint_as_float(t<<16); const unsigned w2=cvtpk_s(r1,r2);
  u32x4 w; w.x=0x3F803F80u&himask; w.y=w1&himask; w.z=w2&himask; w.w=0u; return __builtin_bit_cast(bf16x8,w);}

__device__ __forceinline__ void qkt(f32x16&p0,f32x16&p1,const char*Kslot,const bf16x8*qr,bf16x8 qa,int r32,int hi){
  const char*kb=Kslot+hi*1024+r32*16; const char*ka=Kslot+8192+r32*16;
  { const bf16x8 a0=*reinterpret_cast<const bf16x8*>(ka), a1=*reinterpret_cast<const bf16x8*>(ka+512); const f32x16 z=f32x16{};
    p0=__builtin_amdgcn_mfma_f32_32x32x16_bf16(a0,qa,z,0,0,0); p1=__builtin_amdgcn_mfma_f32_32x32x16_bf16(a1,qa,z,0,0,0); }
  #pragma unroll
  for(int d0=0;d0<4;++d0){
    const bf16x8 b0=*reinterpret_cast<const bf16x8*>(kb+d0*2048);
    const bf16x8 b1=*reinterpret_cast<const bf16x8*>(kb+d0*2048+512);
    {p0=__builtin_amdgcn_mfma_f32_32x32x16_bf16(b0,qr[d0],p0,0,0,0);p1=__builtin_amdgcn_mfma_f32_32x32x16_bf16(b1,qr[d0],p1,0,0,0);}}
}
typedef __attribute__((address_space(3))) const char* lds_cptr;
typedef short v4i16_t __attribute__((ext_vector_type(4)));
__device__ __forceinline__ void kload8(bf16x8*kf,lds_cptr kp){
  kf[0]=*(const __attribute__((address_space(3))) bf16x8*)(kp);      kf[1]=*(const __attribute__((address_space(3))) bf16x8*)(kp+512);
  kf[2]=*(const __attribute__((address_space(3))) bf16x8*)(kp+2048); kf[3]=*(const __attribute__((address_space(3))) bf16x8*)(kp+2560);
  kf[4]=*(const __attribute__((address_space(3))) bf16x8*)(kp+4096); kf[5]=*(const __attribute__((address_space(3))) bf16x8*)(kp+4608);
  kf[6]=*(const __attribute__((address_space(3))) bf16x8*)(kp+6144); kf[7]=*(const __attribute__((address_space(3))) bf16x8*)(kp+6656);
}
__device__ __forceinline__ void kloada(bf16x8*kf,lds_cptr kpa){ kf[8]=*(const __attribute__((address_space(3))) bf16x8*)(kpa); kf[9]=*(const __attribute__((address_space(3))) bf16x8*)(kpa+512); }
__device__ __forceinline__ void kload2(bf16x8*kf,lds_cptr kp,int j){ kf[2*j]=*(const __attribute__((address_space(3))) bf16x8*)(kp+j*2048); kf[2*j+1]=*(const __attribute__((address_space(3))) bf16x8*)(kp+j*2048+512); }
__device__ __forceinline__ s16x4 vtr(lds_cptr p){ return __builtin_bit_cast(s16x4,__builtin_amdgcn_ds_read_tr16_b64_v4i16((__attribute__((address_space(3))) v4i16_t*)p)); }
__device__ __forceinline__ float rowmax(const f32x16&p0,const f32x16&p1){
  float a=max3f(p0[0],p0[1],p1[0]),b=max3f(p0[2],p0[3],p1[1]);a=max3f(a,p1[2],p1[3]);
  #pragma unroll
  for(int r=4;r<16;r+=4){a=max3f(a,p0[r],p0[r+1]);b=max3f(b,p0[r+2],p0[r+3]);a=max3f(a,p1[r],p1[r+1]);b=max3f(b,p1[r+2],p1[r+3]);}
  const float m=max2f(a,b);
  auto rr=__builtin_amdgcn_permlane32_swap(__float_as_uint(m),__float_as_uint(m),false,false);
  return max2f(__uint_as_float(rr[0]),__uint_as_float(rr[1]));
}
__device__ __forceinline__ void pv(f32x16*o,int vb,bf16x8 pa0,bf16x8 pa1,bf16x8 pa2,bf16x8 pa3){
  #pragma unroll
  for(int d0=0;d0<2;++d0){s16x4 lo[4],hi[4];
    #pragma unroll
    for(int ks=0;ks<4;++ks){
      asm volatile("ds_read_b64_tr_b16 %0,%1 offset:%c2":"=&v"(lo[ks]):"v"(vb),"i"(d0*4096+ks*1024):"memory");
      asm volatile("ds_read_b64_tr_b16 %0,%1 offset:%c2":"=&v"(hi[ks]):"v"(vb),"i"(d0*4096+ks*1024+512):"memory");}
    asm volatile("s_waitcnt lgkmcnt(0)":::"memory");SBAR();
    #define PK(k) (bf16x8){lo[k][0],lo[k][1],lo[k][2],lo[k][3],hi[k][0],hi[k][1],hi[k][2],hi[k][3]}
    o[d0]=__builtin_amdgcn_mfma_f32_32x32x16_bf16(pa0,PK(0),o[d0],0,0,0);
    o[d0]=__builtin_amdgcn_mfma_f32_32x32x16_bf16(pa1,PK(1),o[d0],0,0,0);
    o[d0]=__builtin_amdgcn_mfma_f32_32x32x16_bf16(pa2,PK(2),o[d0],0,0,0);
    o[d0]=__builtin_amdgcn_mfma_f32_32x32x16_bf16(pa3,PK(3),o[d0],0,0,0);
    #undef PK
  }
}

#ifndef ATTN_STORE16
#define ATTN_STORE16(p,v) (*(u32x4*)(p)=(v))
#endif
template<int THRL> __device__ __forceinline__ void attn_unit(int b,int h,int qb,const bf16*Q,const bf16*__restrict__ K,const bf16*__restrict__ V,const bf16*__restrict__ KAUG,const float*CSL,const float*CST,bf16*O,float*ssq,char*shm){
  int tid_=threadIdx.x; asm volatile("":"+v"(tid_));
  const int tid=tid_,lane=tid&63,r32=lane&31,hi=lane>>5; const int wid=__builtin_amdgcn_readfirstlane(tid>>6);
  const long rowbase=(long)b*SEQ; const int q0=qb*QB; const int bh=b*NHEAD+h;
  const bf16*Qw=Q+(rowbase+q0+wid*QBLK)*DM+h*D;
  const bf16*Kh=K+rowbase*DM+h*D,*Vh=V+rowbase*DM+h*D;
  const unsigned lds0=(unsigned)(uintptr_t)shm;
  float*wsf=(float*)(shm+LDS_WS)+wid*64;
  const bf16*ksrc=Kh+(long)lane*DM+wid*8;
  const bf16*vsrc=Vh+(long)(16*(wid&3)+(lane>>2))*DM+(wid>>2)*32+(lane&3)*8;
  const unsigned kdst=lds0+LDS_K+wid*1024, vdst=lds0+LDS_V+wid*1024, kadst=lds0+LDS_K+8192;
  const bf16*kasrc=KAUG+((long)bh*SEQ+lane)*8;
  __attribute__((address_space(3))) float*offt=(__attribute__((address_space(3))) float*)((__attribute__((address_space(3))) char*)shm+LDS_OFFT);
  if(wid==0){ const float v=CST[(long)bh*64+lane]; float inc=v;
    _Pragma("unroll") for(int o_=1;o_<64;o_<<=1){ const float t_=__shfl_up(inc,o_); if(lane>=o_)inc+=t_; }
    offt[lane]=inc-v; }
  const unsigned himask=hi?0u:0xffffffffu;
  #define DMA_K(t,slot) do{ glds16(ksrc+(long)(t)*KVBLK*DM,(unsigned)__builtin_amdgcn_readfirstlane(kdst+(slot))); if(wid==0)glds16(kasrc+(long)(t)*KVBLK*8,(unsigned)__builtin_amdgcn_readfirstlane(kadst+(slot))); }while(0)
  #define DMA_V(t,slot) glds16(vsrc+(long)(t)*KVBLK*DM,(unsigned)__builtin_amdgcn_readfirstlane(vdst+(slot)))
  const int vb0=(int)(lds0+LDS_V)+((lane>>4)&1)*32+(lane&3)*8+(4*hi+((lane&15)>>2))*64;
  const char*Kbase=shm+LDS_K; bf16x8 kf[10];
  const lds_cptr shm3=(lds_cptr)shm; const lds_cptr kp0=shm3+LDS_K+hi*1024+r32*16; const lds_cptr kpa=shm3+LDS_K+8192+r32*16; const lds_cptr vp0=shm3+LDS_V+((lane>>4)&1)*32+(lane&3)*8+(4*hi+((lane&15)>>2))*64;
  const int NT=(q0+QB)/KVBLK;
  DMA_K(0,0);DMA_V(0,0);DMA_K(1,SLOTB);
  bf16x8 qr[4];
  #pragma unroll
  for(int d0=0;d0<4;++d0)qr[d0]=*reinterpret_cast<const bf16x8*>(&Qw[(long)r32*DM+d0*16+hi*8]);
  const float csl_i=CSL[(long)bh*SEQ+q0+wid*QBLK+r32];
  float cm=0.f,l_reg=0.f;f32x16 o[2];o[0]=f32x16{};o[1]=f32x16{};
  const int qrel=wid*QBLK+r32;
  #define CMASK(P0,P1,t) do{int jb_=(t)-(NT-4); if(jb_>=0)cmask(P0,P1,jb_,qrel,hi);}while(0)
  bool resc=false;
  #define START(P0,P1) do{ const float rm=rowmax(P0,P1); resc=false; \
    { const float dl=rm; cm=fsub_s(cm,dl); \
      _Pragma("unroll") for(int r=0;r<16;++r){P0[r]=fsub_s(P0[r],dl);P1[r]=fsub_s(P1[r],dl);} } \
    _Pragma("unroll") for(int r=0;r<16;++r)P0[r]=__builtin_amdgcn_exp2f(P0[r]); }while(0)
  #define RESC() do{ if(resc){ asm volatile("s_waitcnt lgkmcnt(0)":::"memory"); \
      _Pragma("unroll") for(int d_=0;d_<2;++d_) _Pragma("unroll") for(int r=0;r<16;++r)o[d_][r]*=wsf[crow(r,hi)]; } }while(0)
  f32x16 pA0,pA1,pB0,pB1;
  int sl_prev=0,sl_cur=0,sl_next=SLOTB;
  #define ROT() do{sl_prev=sl_cur;sl_cur=sl_next;sl_next=(sl_next==(NSLOT-1)*SLOTB)?0:sl_next+SLOTB;}while(0)
  DMA_K(2,2*SLOTB);
  WAIT_BAR(3,5);
  cm=csl_i+offt[(q0+wid*QBLK)>>6];
  qkt(pA0,pA1,Kbase,qr,mk_qaug(cm,himask),r32,hi);asm volatile("s_nop 15\n\ts_nop 7":"+v"(pA0),"+v"(pA1));CMASK(pA0,pA1,0);
  START(pA0,pA1);
  _Pragma("unroll") for(int r=0;r<16;++r)pA1[r]=__builtin_amdgcn_exp2f(pA1[r]);
  WAIT_BAR(0,0);
  DMA_K(3,0);DMA_V(1,SLOTB);
  ROT();
  kload8(kf,kp0+sl_cur); kloada(kf,kpa+sl_cur);
  WAIT_BAR(2,3);
  s16x4 vlo[8],vhi[8]; u32x4 pw0,pw1,pw2,pw3;
  #define PKW(P,B) cvtpk_s(P[B],P[B+1])
  #define PAF(k) __builtin_bit_cast(bf16x8,pw##k)
  #define VFR(i) (bf16x8){vlo[i][0],vlo[i][1],vlo[i][2],vlo[i][3],vhi[i][0],vhi[i][1],vhi[i][2],vhi[i][3]}
  #define PIN(x) asm volatile("":"+v"(x))
  #define MX3(a,b,c) __builtin_fmaxf(__builtin_fmaxf((a),(b)),(c))
  #define GAPA(MF,A0,A1,A2,A3,W0,W1,PW) do{ MF; sacc+=A0; sacc+=A1; sacc+=A2; sacc+=A3; PIN(sacc); W0; W1; PIN(PW); SBAR(); }while(0)
  #define EX(v) __builtin_amdgcn_exp2f(v)
  #define GAPB(MF,X,B) do{ MF; X[B]=EX(X[B]); X[B+1]=EX(X[B+1]); X[B+2]=EX(X[B+2]); X[B+3]=EX(X[B+3]); PIN(X); SBAR(); }while(0)
  #define VRD(i) do{ vlo[i]=vtr(vp_+(((i)>>2)*4096+((i)&3)*1024)); vhi[i]=vtr(vp_+(((i)>>2)*4096+((i)&3)*1024+512)); }while(0)
  #define KRD(G,j) do{ if(G){ kload2(kf,kp0+sl_next,j); SBAR(); } }while(0)
  #define KRDA(G) do{ if(G){ kloada(kf,kpa+sl_next); SBAR(); } }while(0)
  #define STEP(C0,C1,P0,P1,t,GK,GV,GL) do{ SBAR(); \
    const lds_cptr vp_=vp0+sl_prev; \
    { const bf16x8 qa_=mk_qaug(cm-offt[t],himask); const f32x16 z_=f32x16{}; SBAR(); \
      C0=__builtin_amdgcn_mfma_f32_32x32x16_bf16(kf[8],qa_,z_,0,0,0); SBAR(); C1=__builtin_amdgcn_mfma_f32_32x32x16_bf16(kf[9],qa_,z_,0,0,0); SBAR(); } \
    VRD(0); SBAR(); float sacc=(P0[0]+P0[1]); \
    GAPA(C0=__builtin_amdgcn_mfma_f32_32x32x16_bf16(kf[0],qr[0],C0,0,0,0), P0[2],P0[3],P0[4],P0[5],     pw0[0]=PKW(P0,0), pw0[1]=PKW(P0,2), pw0); \
    VRD(4); SBAR(); GAPA(C1=__builtin_amdgcn_mfma_f32_32x32x16_bf16(kf[1],qr[0],C1,0,0,0), P0[6],P0[7],P0[8],P0[9],     pw0[2]=PKW(P0,4), pw0[3]=PKW(P0,6), pw0); \
    VRD(1); SBAR(); GAPA(C0=__builtin_amdgcn_mfma_f32_32x32x16_bf16(kf[2],qr[1],C0,0,0,0),   P0[10],P0[11],P0[12],P0[13], pw1[0]=PKW(P0,8), pw1[1]=PKW(P0,10), pw1); \
    VRD(5); SBAR(); GAPA(C1=__builtin_amdgcn_mfma_f32_32x32x16_bf16(kf[3],qr[1],C1,0,0,0),   P0[14],P0[15],P1[0],P1[1],   pw1[2]=PKW(P0,12),pw1[3]=PKW(P0,14), pw1); \
    VRD(2); SBAR(); GAPA(C0=__builtin_amdgcn_mfma_f32_32x32x16_bf16(kf[4],qr[2],C0,0,0,0),   P1[2],P1[3],P1[4],P1[5],     pw2[0]=PKW(P1,0), pw2[1]=PKW(P1,2), pw2); \
    VRD(6); SBAR(); GAPA(C1=__builtin_amdgcn_mfma_f32_32x32x16_bf16(kf[5],qr[2],C1,0,0,0),   P1[6],P1[7],P1[8],P1[9],     pw2[2]=PKW(P1,4), pw2[3]=PKW(P1,6), pw2); \
    VRD(3); SBAR(); GAPA(C0=__builtin_amdgcn_mfma_f32_32x32x16_bf16(kf[6],qr[3],C0,0,0,0),   P1[10],P1[11],P1[12],P1[13], pw3[0]=PKW(P1,8), pw3[1]=PKW(P1,10), pw3); \
    VRD(7); SBAR(); GAPA(C1=__builtin_amdgcn_mfma_f32_32x32x16_bf16(kf[7],qr[3],C1,0,0,0),   P1[14],P1[15],0.f,0.f,       pw3[2]=PKW(P1,12),pw3[3]=PKW(P1,14), pw3); \
    l_reg+=sacc; \
    if(GK){DMA_K((t)+3,sl_cur);} if(GV){DMA_V((t)+1,sl_next);} \
    CMASK(C0,C1,t); \
    { float a=MX3(C0[0],C0[1],C1[0]),b=MX3(C0[2],C0[3],C1[1]); a=MX3(a,C1[2],C1[3]); \
      _Pragma("unroll") for(int r=4;r<16;r+=4){a=MX3(a,C0[r],C0[r+1]);b=MX3(b,C0[r+2],C0[r+3]);a=MX3(a,C1[r],C1[r+1]);b=MX3(b,C1[r+2],C1[r+3]);} \
      float rm=__builtin_fmaxf(a,b); { auto rr=__builtin_amdgcn_permlane32_swap(__float_as_uint(rm),__float_as_uint(rm),false,false); rm=__builtin_fmaxf(__uint_as_float(rr[0]),__uint_as_float(rr[1])); } \
      resc=false; \
      if(__builtin_expect(__any(rm>(float)THRL),0)){ const float dl=__builtin_fmaxf(rm,0.f); cm-=dl; \
        _Pragma("unroll") for(int r=0;r<16;++r){C0[r]-=dl;C1[r]-=dl;} \
        const float f=__builtin_amdgcn_exp2f(-dl); l_reg*=f; if(hi==0)wsf[r32]=f; resc=true; } } \
    SBAR(); \
    GAPB(o[0]=__builtin_amdgcn_mfma_f32_32x32x16_bf16(PAF(0),VFR(0),o[0],0,0,0), C0,0); \
    GAPB(o[1]=__builtin_amdgcn_mfma_f32_32x32x16_bf16(PAF(0),VFR(4),o[1],0,0,0), C0,4); \
    KRD(GL,0); GAPB(o[0]=__builtin_amdgcn_mfma_f32_32x32x16_bf16(PAF(1),VFR(1),o[0],0,0,0), C0,8); \
    KRD(GL,1); GAPB(o[1]=__builtin_amdgcn_mfma_f32_32x32x16_bf16(PAF(1),VFR(5),o[1],0,0,0), C0,12); \
    KRD(GL,2); GAPB(o[0]=__builtin_amdgcn_mfma_f32_32x32x16_bf16(PAF(2),VFR(2),o[0],0,0,0), C1,0); \
    KRD(GL,3); GAPB(o[1]=__builtin_amdgcn_mfma_f32_32x32x16_bf16(PAF(2),VFR(6),o[1],0,0,0), C1,4); \
    KRDA(GL); GAPB(o[0]=__builtin_amdgcn_mfma_f32_32x32x16_bf16(PAF(3),VFR(3),o[0],0,0,0), C1,8); \
    GAPB(o[1]=__builtin_amdgcn_mfma_f32_32x32x16_bf16(PAF(3),VFR(7),o[1],0,0,0), C1,12); \
    }while(0)
  int t=1;
  #undef CMASK
  #define CMASK(P0,P1,t) do{}while(0)
  for(;t+5<NT;t+=2){
    STEP(pB0,pB1,pA0,pA1,t,true,true,true);     WAIT_BAR(2,3); RESC(); ROT();
    STEP(pA0,pA1,pB0,pB1,t+1,true,true,true);   WAIT_BAR(2,3); RESC(); ROT();
  }
  #undef CMASK
  #define CMASK(P0,P1,t) do{int jb_=(t)-(NT-4); if(jb_>=0)cmask(P0,P1,jb_,qrel,hi);}while(0)
  #define ENDW(tt) do{ if((tt)+3<NT){WAIT_BAR(2,3);} else if((tt)+2<NT){WAIT_BAR(1,1);} else {WAIT_BAR(0,0);} }while(0)
  for(;t+1<NT;t+=2){
    STEP(pB0,pB1,pA0,pA1,t,(t+3<NT),(t+1<NT),(t+1<NT));       ENDW(t);   RESC(); ROT();
    STEP(pA0,pA1,pB0,pB1,t+1,(t+4<NT),(t+2<NT),(t+2<NT));     ENDW(t+1); RESC(); ROT();
  }
  STEP(pB0,pB1,pA0,pA1,NT-1,false,false,false); RESC();
  { float sacc=pB0[0]+pB0[1]; _Pragma("unroll") for(int r=2;r<16;++r)sacc+=pB0[r]; _Pragma("unroll") for(int r=0;r<16;++r)sacc+=pB1[r]; l_reg+=sacc;
    pw0=(u32x4){PKW(pB0,0),PKW(pB0,2),PKW(pB0,4),PKW(pB0,6)};pw1=(u32x4){PKW(pB0,8),PKW(pB0,10),PKW(pB0,12),PKW(pB0,14)};pw2=(u32x4){PKW(pB1,0),PKW(pB1,2),PKW(pB1,4),PKW(pB1,6)};pw3=(u32x4){PKW(pB1,8),PKW(pB1,10),PKW(pB1,12),PKW(pB1,14)};
    SBAR(); pv(o,vb0+sl_cur,PAF(0),PAF(1),PAF(2),PAF(3)); }
  #undef PKW
  #undef PAF
  #undef VFR
  #undef PIN
  #undef MX3
  #undef GAPA
  #undef GAPB
  #undef EX
  #undef VRD
  #undef KRD
  #undef KRDA
  #undef STEP
  #undef ENDW
  {auto rr=__builtin_amdgcn_permlane32_swap(__float_as_uint(l_reg),__float_as_uint(l_reg),false,false);l_reg=__uint_as_float(rr[0])+__uint_as_float(rr[1]);}
  if(hi==0)wsf[32+r32]=l_reg;asm volatile("s_waitcnt lgkmcnt(0)":::"memory");
  float rli[16];
  #pragma unroll
  for(int r=0;r<16;++r)rli[r]=__builtin_amdgcn_rcpf(wsf[32+crow(r,hi)]);
  bf16*Ow=O+(rowbase+q0+wid*QBLK)*OPITCH+h*D; float*ssw=ssq+rowbase+q0+wid*QBLK;
  { bf16*stg=(bf16*)(shm+LDS_OST)+wid*2048;
    #pragma unroll
    for(int r=0;r<16;++r){const int orow=crow(r,hi);
      #pragma unroll
      for(int d0=0;d0<2;++d0)stg[orow*64+d0*32+r32]=__float2bfloat16(o[d0][r]*rli[r]);}
    asm volatile("s_waitcnt lgkmcnt(0)":::"memory");
    #pragma unroll
    for(int i=0;i<4;++i){const int row=i*8+(lane>>3),ch=lane&7; const u32x4 v=*(const u32x4*)(stg+row*64+ch*8); ATTN_STORE16(Ow+(long)row*OPITCH+ch*8,v);
      float sq=0.f;
      _Pragma("unroll") for(int e=0;e<4;++e){ const float a_=__uint_as_float(v[e]<<16), b_=__uint_as_float(v[e]&0xffff0000u); sq+=a_*a_+b_*b_; }
      sq+=__shfl_xor(sq,1); sq+=__shfl_xor(sq,2); sq+=__shfl_xor(sq,4); if(ch==0)atomicAdd(ssw+row,sq); } }
  asm volatile("s_waitcnt lgkmcnt(0)\n\ts_barrier":::"memory");
  #undef DMA_K
  #undef DMA_V
  #undef CMASK
  #undef START
  #undef RESC
  #undef ROT
}
constexpr int ATTN_LDS_BYTES=LDS_BYTES;
struct AttnTensors { const bf16* Q; const bf16* K; const bf16* V; const bf16* KAUG; const float* CSL; const float* CST; bf16* O; float* ssq; };
struct AttnUnit { int bh; int qb; };
struct StaticOrder {
  int vcu, G;
  __device__ __forceinline__ explicit StaticOrder(int grid,int block):vcu((grid%8==0)?(block%8)*(grid/8)+block/8:block),G(grid){}
  __device__ __forceinline__ bool next(int i,AttnUnit&u)const{ const int j=vcu+i*G; if(j>=512)return false; const int s=j&7; u.bh=(j&255)>>3; u.qb=(j<256)?15-s:s; return true; }
  __device__ __forceinline__ void a_ready(const AttnUnit&)const{}
  __device__ __forceinline__ void done(const AttnUnit&)const{}
};
template<class Sched,int THRL=16> __device__ __forceinline__ void attn_phase(char*lds,const AttnTensors&T,const Sched&S){
  AttnUnit u;
  for(int i=0;S.next(i,u);++i){ S.a_ready(u); attn_unit<THRL>(u.bh/NHEAD,u.bh%NHEAD,u.qb,T.Q,T.K,T.V,T.KAUG,T.CSL,T.CST,T.O,T.ssq,lds); S.done(u); }
}
#undef SBAR
#undef WAIT_BAR
#undef WAIT_BAR_
}

constexpr size_t MiB = 1u << 20;
constexpr size_t WS_CTL = 0, CTL_ZERO_BYTES = 256 * 1024;
constexpr size_t WS_SS = 1 * MiB;
constexpr size_t WS_CST = 1 * MiB + 640 * 1024;
constexpr size_t WS_CSL = 2 * MiB;
constexpr size_t WS_WF = 3 * MiB;
constexpr size_t WS_SPA = 3 * MiB + 64 * 1024;
constexpr size_t WS_SPB = 3 * MiB + 128 * 1024;
constexpr size_t WS_SA16 = 3 * MiB + 704 * 1024;
constexpr size_t WS_WIN = 4 * MiB, WS_WOUT = 12 * MiB, WS_WUP = 16 * MiB, WS_WDN = 32 * MiB, WS_WGLU = 48 * MiB;
constexpr size_t WS_SSMM = 49 * MiB;
constexpr size_t WS_HB = 66 * MiB;
constexpr size_t WS_U = 98 * MiB, WS_Q = 114 * MiB, WS_K = 130 * MiB, WS_V = 146 * MiB;
constexpr size_t WS_MIX = 162 * MiB;
constexpr size_t WS_GB = 194 * MiB;
constexpr size_t WS_ST = 210 * MiB;
constexpr size_t WS_HID = 98 * MiB;
constexpr size_t WS_KAUG = 226 * MiB;
constexpr size_t WS_END = 228 * MiB;
static_assert(WS_SS == (1u << 20) && WS_HB == (66u << 20) && MROWS == pg8::EP_M, "epilogue helper constants");
constexpr int CW_BAR = 4096;

constexpr int RING_OFF = 0, RING_BYTES = 131072;
constexpr int LDSCTL_OFF = RING_BYTES, MISC_OFF = LDSCTL_OFF + 320;
constexpr int LDS_BYTES = 147456;
constexpr int NWAVES = 8;
constexpr bool USE_NAIVE_ATTN = false, USE_NAIVE_SSM = false;
static_assert(attn_body::LDS_BYTES <= RING_BYTES, "attention LDS");
#ifndef DBG_STOP_V
#define DBG_STOP_V 99
#endif
constexpr int DBG_STOP = DBG_STOP_V;

struct Frame {
    LAS unsigned char* lds;
    volatile LAS unsigned* MISC;
    int tid, lane, wave, vcu, G;
};
typedef __attribute__((address_space(4))) const unsigned char* kptr_t;
template <class T> __device__ __forceinline__ T* karg(int i) {
    kptr_t p = (kptr_t)__builtin_amdgcn_kernarg_segment_ptr(); asm volatile("" : "+s"(p));
    return *(T* const __attribute__((address_space(4)))*)(p + 8 * i);
}
__device__ __forceinline__ int opaque_s(int x) { asm volatile("" : "+s"(x)); return x; }
__device__ __forceinline__ int opaque_v(int x) { asm volatile("" : "+v"(x)); return x; }
__device__ __forceinline__ int GRIDG_() { return opaque_s((int)gridDim.x); }
__device__ __forceinline__ int BLK_() { return opaque_s((int)blockIdx.x); }
#define KIN(i) karg<const float>(i)
#define KOUT() karg<float>(21)
#define KWS() karg<unsigned char>(22)
extern __shared__ __attribute__((aligned(16))) unsigned char g_lds[];
__device__ __forceinline__ Frame mk_frame() {
    Frame F;
    F.lds = (LAS unsigned char*)g_lds; F.MISC = (volatile LAS unsigned*)(F.lds + MISC_OFF);
    F.tid = opaque_v((int)threadIdx.x); F.lane = F.tid & 63; F.wave = __builtin_amdgcn_readfirstlane(F.tid >> 6);
    F.G = opaque_s((int)gridDim.x); { const int bx = opaque_s((int)blockIdx.x); F.vcu = (F.G % 8 == 0) ? (bx % 8) * (F.G / 8) + bx / 8 : bx; }
    return F;
}
__device__ __forceinline__ float* ss_arr(unsigned char* ws, int i) { return (float*)(ws + WS_SS) + (size_t)i * MROWS; }

__device__ __forceinline__ float wave_sum(float v) {
#pragma unroll
    for (int o = 1; o < 64; o <<= 1) v += __shfl_xor(v, o);
    return v;
}
__device__ __forceinline__ void p0_transpose_item(const float* W, int K, int N, int ldw, const float* gain, bf16* WT, LAS float* scr, int item, int lane) {
    const int nblk = N / 32, kb = item / nblk, nb = item % nblk, k0 = 64 * kb, n0 = 32 * nb;
#pragma unroll 8
    for (int i = 0; i < 32; ++i) { const int kk = 2 * i + (lane >> 5); const float g = gain ? gain[k0 + kk] : 1.0f; scr[kk * 33 + (lane & 31)] = W[(size_t)(k0 + kk) * ldw + n0 + (lane & 31)] * g; }
    LDS_WAIT(); asm volatile("" ::: "memory");
    const int c = lane & 7;
#pragma unroll
    for (int j = 0; j < 4; ++j) { const int n = (lane >> 3) + 8 * j; const LAS float* s = scr + (8 * c) * 33 + n;
        v4u o; o.x = pk2(s[0 * 33], s[1 * 33]); o.y = pk2(s[2 * 33], s[3 * 33]); o.z = pk2(s[4 * 33], s[5 * 33]); o.w = pk2(s[6 * 33], s[7 * 33]);
        *(GAS v4u*)(WT + (size_t)(n0 + n) * K + k0 + 8 * c) = o; }
    LDS_WAIT(); asm volatile("" ::: "memory");
}

struct Inputs {
    const float *x, *ln1_g, *w_in, *log_dt, *lam_re, *lam_im, *b_re, *b_im, *c_re, *c_im, *ssm_d, *glu_w, *glu_b, *fgate_b, *gn_ssm_g, *gn_attn_g, *w_out, *ln2_g, *w_up, *w_down, *final_g;
};

__device__ __forceinline__ float gelu_tanh(float x) {
    const float k = 0.7978845608028654f;
    const float inner = k * (x + 0.044715f * x * x * x);
    const float e = __builtin_amdgcn_exp2f(inner * (2.0f * LOG2E));
    const float th = 1.0f - 2.0f * __builtin_amdgcn_rcpf(e + 1.0f);
    return 0.5f * x * (1.0f + th);
}

typedef float f32x2f __attribute__((ext_vector_type(2)));
constexpr int SSM_MAT_ELEMS = 131072;
__device__ __forceinline__ void ssm_mats_item(Frame& F, const Inputs& I, unsigned char* ws, int l, int g) {
    LAS f32x2f* AP = (LAS f32x2f*)(F.lds);
    LAS f32x2f* BB = (LAS f32x2f*)(F.lds + 8704);
    LAS f32x2f* CC = (LAS f32x2f*)(F.lds + 16896);
    LAS float* KT = (LAS float*)(F.lds + 25088);
    LAS float* DSK = (LAS float*)(F.lds + 41472);
    const int lg = l * SG + g, tid = F.tid;
    const float dt = expf(I.log_dt[lg]);
    for (int i = tid; i < 17 * 64; i += 512) { const int j = i >> 6, n = i & 63; const float lr = I.lam_re[lg * SN + n], li = I.lam_im[lg * SN + n];
        const float mag = expf(lr * dt * (float)j); float sn, cs; sincosf(li * dt * (float)j, &sn, &cs); AP[i] = (f32x2f){mag * cs, mag * sn}; }
    for (int i = tid; i < 64 * 16; i += 512) { const int n = i >> 4; const float lr = I.lam_re[lg * SN + n], li = I.lam_im[lg * SN + n];
        const float mag = expf(lr * dt); float sn, cs; sincosf(li * dt, &sn, &cs);
        const float are = mag * cs, aim = mag * sn, den = lr * lr + li * li, nr = are - 1.0f;
        const float sre = (nr * lr + aim * li) / den, sim = (aim * lr - nr * li) / den;
        const float br = I.b_re[(size_t)lg * SN * SP + i], bi = I.b_im[(size_t)lg * SN * SP + i];
        BB[i] = (f32x2f){sre * br - sim * bi, sre * bi + sim * br}; }
    for (int i = tid; i < 16 * 64; i += 512) CC[i] = (f32x2f){I.c_re[(size_t)lg * SP * SN + i], I.c_im[(size_t)lg * SP * SN + i]};
    if (tid < 16) DSK[tid] = I.ssm_d[l * DSSM + g * SP + tid];
    __syncthreads();
    for (int e = tid; e < 4096; e += 512) { const int j = e >> 8, p = (e >> 4) & 15, q = e & 15; float acc = 0.f;
        for (int n = 0; n < 64; ++n) { const f32x2f a = AP[j * 64 + n], b = BB[n * 16 + q], c = CC[p * 64 + n];
            const float pr = a.x * b.x - a.y * b.y, pi = a.x * b.y + a.y * b.x; acc += c.x * pr - c.y * pi; }
        KT[e] = acc; }
    __syncthreads();
    bf16* base = (bf16*)(ws + WS_SSMM) + (size_t)lg * SSM_MAT_ELEMS;
    for (int i = 0; i < 8; ++i) {
        const int li_ = tid + 512 * i, frg = li_ >> 6, ln = li_ & 63, rt = frg >> 3, ks = frg & 7, row = 16 * rt + (ln & 15), n = row & 63, isim = row >> 6;
        const int k0 = 32 * ks + 8 * (ln >> 4), s = k0 >> 4, q0 = k0 & 15; const f32x2f a = AP[(15 - s) * 64 + n]; float v[8];
#pragma unroll
        for (int j8 = 0; j8 < 8; ++j8) { const f32x2f b = BB[n * 16 + q0 + j8]; v[j8] = isim ? (a.x * b.y + a.y * b.x) : (a.x * b.x - a.y * b.y); }
        v4u w; w.x = pk2(v[0], v[1]); w.y = pk2(v[2], v[3]); w.z = pk2(v[4], v[5]); w.w = pk2(v[6], v[7]);
        *(GAS v4u*)(base + (size_t)li_ * 8) = w; }
    for (int i = 0; i < 24; ++i) {
        const int li_ = tid + 512 * i, frg = li_ >> 6, ln = li_ & 63, t = frg / 12, ks = frg % 12, p = ln & 15, k0 = 32 * ks + 8 * (ln >> 4); float v[8];
        if (k0 < 256) { const int s = k0 >> 4, q0 = k0 & 15;
#pragma unroll
            for (int j8 = 0; j8 < 8; ++j8) { const int q = q0 + j8; float x = 0.f; if (s <= t) { x = KT[((t - s) * 16 + p) * 16 + q]; if (s == t && p == q) x += DSK[p]; } v[j8] = x; }
        } else { const bool im = k0 >= 320; const int n0 = k0 - (im ? 320 : 256);
#pragma unroll
            for (int j8 = 0; j8 < 8; ++j8) { const f32x2f a = AP[(t + 1) * 64 + n0 + j8], c = CC[p * 64 + n0 + j8]; v[j8] = im ? -(c.x * a.y + c.y * a.x) : (c.x * a.x - c.y * a.y); }
        }
        v4u w; w.x = pk2(v[0], v[1]); w.y = pk2(v[2], v[3]); w.z = pk2(v[4], v[5]); w.w = pk2(v[6], v[7]);
        *(GAS v4u*)(base + (size_t)(4096 + li_) * 8) = w; }
    if (tid < 64) ((f32x2f*)(ws + WS_SA16))[lg * SN + tid] = AP[16 * 64 + tid];
    __syncthreads();
}

constexpr int SSM_UT = 8448, SSM_XROW = 272;
__device__ __forceinline__ void ssm_mfma_phase(int l) {
    Frame F = mk_frame(); unsigned char* ws = KWS();
    LAS unsigned char* UT = F.lds; LAS unsigned char* XB = F.lds + 2 * SSM_UT; LAS f32x2f* EX = (LAS f32x2f*)(F.lds + 2 * SSM_UT + 256 * SSM_XROW);
    const int lane = F.lane, wave = F.wave, tid = F.tid, fr = lane & 15, fq = lane >> 4;
    const int uoff = tid * 16 + (tid >> 5) * 16;
    const int boff = fr * 528 + (lane >> 5) * 32 + ((lane >> 4) & 1) * 16;
    for (int item = F.vcu; item < BATCH * SG; item += F.G) {
        const int b = item >> 5, g = item & 31, lg = l * SG + g;
        const unsigned char* Ug = (const unsigned char*)((const bf16*)(ws + WS_U) + ((size_t)g * MROWS + (size_t)b * SEQ) * 16);
        const bf16* MAT = (const bf16*)(ws + WS_SSMM) + (size_t)lg * SSM_MAT_ELEMS;
        float* SL = (float*)(ws + WS_ST) + (size_t)item * 256 * 128;
        {
            bf16x8 wa[8];
#pragma unroll
            for (int ks = 0; ks < 8; ++ks) wa[ks] = *(const bf16x8*)(MAT + (size_t)((wave * 8 + ks) * 64 + lane) * 8);
            v4u ureg = *(const v4u*)(Ug + tid * 16);
            __syncthreads();
            *(LAS v4u*)(UT + uoff) = ureg;
            for (int j = 0; j < 16; ++j) {
                __syncthreads();
                if (j + 1 < 16) ureg = *(const v4u*)(Ug + (size_t)(j + 1) * 8192 + tid * 16);
                const LAS unsigned char* ut = UT + (j & 1) * SSM_UT + boff;
                f32x4 acc = (f32x4){0.f, 0.f, 0.f, 0.f};
#pragma unroll
                for (int ks = 0; ks < 8; ++ks) acc = __builtin_amdgcn_mfma_f32_16x16x32_bf16(wa[ks], *(const LAS bf16x8*)(ut + ks * 64), acc, 0, 0, 0);
                *(f32x4*)(SL + (size_t)(16 * j + fr) * 128 + 16 * wave + 4 * fq) = acc;
                if (j + 1 < 16) *(LAS v4u*)(UT + ((j + 1) & 1) * SSM_UT + uoff) = ureg;
            }
        }
        asm volatile("s_waitcnt vmcnt(0)" ::: "memory");
        __syncthreads();
        {
            const f32x2f a16 = ((const f32x2f*)(ws + WS_SA16))[lg * SN + lane];
            float pr = a16.x, pi = a16.y;
#pragma unroll
            for (int i = 0; i < 5; ++i) { const float nr = pr * pr - pi * pi, ni = 2.0f * pr * pi; pr = nr; pi = ni; }
            float sr[32], si[32];
#pragma unroll
            for (int i = 0; i < 32; ++i) { sr[i] = SL[(size_t)(32 * wave + i) * 128 + lane]; si[i] = SL[(size_t)(32 * wave + i) * 128 + 64 + lane]; }
            float xr = 0.f, xi = 0.f;
#pragma unroll
            for (int i = 0; i < 32; ++i) { const float nr = a16.x * xr - a16.y * xi + sr[i], ni = a16.x * xi + a16.y * xr + si[i]; xr = nr; xi = ni; }
            EX[wave * 64 + lane] = (f32x2f){xr, xi};
            __syncthreads();
            xr = 0.f; xi = 0.f;
            for (int w2 = 0; w2 < wave; ++w2) { const f32x2f e = EX[w2 * 64 + lane]; const float nr = pr * xr - pi * xi + e.x, ni = pr * xi + pi * xr + e.y; xr = nr; xi = ni; }
#pragma unroll
            for (int i = 0; i < 32; ++i) {
                LAS unsigned short* xrow = (LAS unsigned short*)(XB + (32 * wave + i) * SSM_XROW);
                xrow[lane] = (unsigned short)f2bf(xr); xrow[64 + lane] = (unsigned short)f2bf(xi);
                const float nr = a16.x * xr - a16.y * xi + sr[i], ni = a16.x * xi + a16.y * xr + si[i]; xr = nr; xi = ni; }
        }
        __syncthreads();
        {
            const int t0 = wave, t1 = 15 - wave;
            bf16x8 wc0[12], wc1[12];
#pragma unroll
            for (int ks = 0; ks < 12; ++ks) { wc0[ks] = *(const bf16x8*)(MAT + (size_t)(4096 + (t0 * 12 + ks) * 64 + lane) * 8); wc1[ks] = *(const bf16x8*)(MAT + (size_t)(4096 + (t1 * 12 + ks) * 64 + lane) * 8); }
            bf16* GB = (bf16*)(ws + WS_GB);
            v4u ureg = *(const v4u*)(Ug + tid * 16);
            *(LAS v4u*)(UT + uoff) = ureg;
            for (int j = 0; j < 16; ++j) {
                __syncthreads();
                if (j + 1 < 16) ureg = *(const v4u*)(Ug + (size_t)(j + 1) * 8192 + tid * 16);
                const LAS unsigned char* ut = UT + (j & 1) * SSM_UT + boff;
                const LAS unsigned char* xb = XB + (16 * j + fr) * SSM_XROW + fq * 16;
                f32x4 acc0 = (f32x4){0.f, 0.f, 0.f, 0.f}, acc1 = (f32x4){0.f, 0.f, 0.f, 0.f};
#pragma unroll
                for (int ks = 0; ks < 8; ++ks) { const bf16x8 ub = *(const LAS bf16x8*)(ut + ks * 64);
                    if (ks <= (t0 >> 1)) acc0 = __builtin_amdgcn_mfma_f32_16x16x32_bf16(wc0[ks], ub, acc0, 0, 0, 0);
                    if (ks <= (t1 >> 1)) acc1 = __builtin_amdgcn_mfma_f32_16x16x32_bf16(wc1[ks], ub, acc1, 0, 0, 0); }
#pragma unroll
                for (int kp = 0; kp < 4; ++kp) { const bf16x8 xf = *(const LAS bf16x8*)(xb + kp * 64);
                    acc0 = __builtin_amdgcn_mfma_f32_16x16x32_bf16(wc0[8 + kp], xf, acc0, 0, 0, 0);
                    acc1 = __builtin_amdgcn_mfma_f32_16x16x32_bf16(wc1[8 + kp], xf, acc1, 0, 0, 0); }
                const size_t row0 = (size_t)b * SEQ + 16 * (16 * j + fr);
                { pg8::u32x2 w; w.x = pk2(gelu_tanh(acc0[0]), gelu_tanh(acc0[1])); w.y = pk2(gelu_tanh(acc0[2]), gelu_tanh(acc0[3])); *(pg8::u32x2*)(GB + (row0 + t0) * 512 + g * SP + 4 * fq) = w; }
                { pg8::u32x2 w; w.x = pk2(gelu_tanh(acc1[0]), gelu_tanh(acc1[1])); w.y = pk2(gelu_tanh(acc1[2]), gelu_tanh(acc1[3])); *(pg8::u32x2*)(GB + (row0 + t1) * 512 + g * SP + 4 * fq) = w; }
                if (j + 1 < 16) *(LAS v4u*)(UT + ((j + 1) & 1) * SSM_UT + uoff) = ureg;
            }
        }
        __syncthreads();
    }
}


__device__ __forceinline__ Inputs load_inputs() {
    Inputs I;
    I.x = KIN(0); I.ln1_g = KIN(1); I.w_in = KIN(2); I.log_dt = KIN(3); I.lam_re = KIN(4); I.lam_im = KIN(5); I.b_re = KIN(6); I.b_im = KIN(7);
    I.c_re = KIN(8); I.c_im = KIN(9); I.ssm_d = KIN(10); I.glu_w = KIN(11); I.glu_b = KIN(12); I.fgate_b = KIN(13); I.gn_ssm_g = KIN(14); I.gn_attn_g = KIN(15);
    I.w_out = KIN(16); I.ln2_g = KIN(17); I.w_up = KIN(18); I.w_down = KIN(19); I.final_g = KIN(20);
    return I;
}
__device__ __forceinline__ void p0_prologue() {
    Frame F = mk_frame();
    const Inputs I = load_inputs();
    LAS float* scr = (LAS float*)(F.lds + RING_OFF + F.wave * 16384);
    const int gw = opaque_s(F.vcu) * NWAVES + opaque_s(F.wave), NGW = opaque_s(F.G) * NWAVES;
    unsigned char* ws = KWS();
    for (int it = F.vcu; it < DEPTH * SG; it += F.G) ssm_mats_item(F, I, ws, it / SG, it % SG);
    constexpr int I_IN = (DM / 64) * (2048 / 32), I_OUT = (DM / 64) * (DM / 32), I_UP = (DM / 64) * (DFF / 32), I_DN = (DFF / 64) * (DM / 32), I_GLU = (DSSM / 64) * (DSSM / 32);
    constexpr int PER_L = I_IN + I_OUT + I_UP + I_DN + I_GLU;
    for (int it = gw; it < DEPTH * PER_L; it += NGW) {
        const int l = it / PER_L; int r = it % PER_L;
        if (r < I_IN) { p0_transpose_item(I.w_in + (size_t)l * DM * DIN, DM, 2048, DIN, I.ln1_g + l * DM, (bf16*)(ws + WS_WIN) + (size_t)l * 2048 * DM, scr, r, F.lane); continue; } r -= I_IN;
        if (r < I_OUT) {
            const int kb = r / (DM / 32); const float* gain = (kb < 8) ? (I.gn_ssm_g + l * DSSM) : (I.gn_attn_g + l * DATT - 512);
            p0_transpose_item(I.w_out + (size_t)l * DM * DM, DM, DM, DM, gain, (bf16*)(ws + WS_WOUT) + (size_t)l * DM * DM, scr, r, F.lane); continue; } r -= I_OUT;
        if (r < I_UP) { p0_transpose_item(I.w_up + (size_t)l * DM * DFF, DM, DFF, DFF, I.ln2_g + l * DM, (bf16*)(ws + WS_WUP) + (size_t)l * DFF * DM, scr, r, F.lane); continue; } r -= I_UP;
        if (r < I_DN) { p0_transpose_item(I.w_down + (size_t)l * DFF * DM, DFF, DM, DM, nullptr, (bf16*)(ws + WS_WDN) + (size_t)l * DM * DFF, scr, r, F.lane); continue; } r -= I_DN;
        p0_transpose_item(I.glu_w + (size_t)l * DSSM * DSSM, DSSM, DSSM, DSSM, nullptr, (bf16*)(ws + WS_WGLU) + (size_t)l * DSSM * DSSM, scr, r, F.lane);
    }
    for (int i = gw * 64 + F.lane; i < DEPTH * 8 * DM; i += NGW * 64) { const int l = i / (8 * DM), h = (i / DM) % 8, k = i % DM;
        ((float*)(ws + WS_WF))[i] = I.w_in[(size_t)l * DM * DIN + (size_t)k * DIN + 2048 + h] * I.ln1_g[l * DM + k]; }
    for (int i = gw * 64 + F.lane; i < DEPTH * SG * SN; i += NGW * 64) {
        const int l = i / (SG * SN), gn = i % (SG * SN), g = gn / SN;
        const float dt = expf(I.log_dt[l * SG + g]);
        const float lr = I.lam_re[i], li = I.lam_im[i];
        const float mag = expf(lr * dt); float sn, cs; sincosf(li * dt, &sn, &cs);
        const float are = mag * cs, aim = mag * sn, den = lr * lr + li * li, nr = are - 1.0f;
        const float sre = (nr * lr + aim * li) / den, sim = (aim * lr - nr * li) / den;
        float* pa = (float*)(ws + WS_SPA) + (size_t)i * 2; pa[0] = are; pa[1] = aim;
        float* pb = (float*)(ws + WS_SPB) + (size_t)i * SP * 2;
        for (int p = 0; p < SP; ++p) { const float br = I.b_re[(size_t)i * SP + p], bi = I.b_im[(size_t)i * SP + p]; pb[p * 2] = sre * br - sim * bi; pb[p * 2 + 1] = sre * bi + sim * br; }
    }
    { f32x4* z = (f32x4*)ss_arr(ws, 1); for (int i = gw * 64 + F.lane; i < 8 * MROWS / 4; i += NGW * 64) z[i] = (f32x4){0.f, 0.f, 0.f, 0.f}; }
    for (int m = gw; m < MROWS; m += NGW) {
        const GAS f32x4* xr = (const GAS f32x4*)(I.x + (size_t)m * DM) + F.lane;
        GAS unsigned long long* o8 = (GAS unsigned long long*)((bf16*)(ws + WS_HB) + (size_t)m * DM) + F.lane;
        float s = 0.f;
#pragma unroll
        for (int j = 0; j < 4; ++j) { const f32x4 v = xr[64 * j]; s += (v.x * v.x + v.y * v.y) + (v.z * v.z + v.w * v.w);
            o8[64 * j] = (unsigned long long)pk2(v.x, v.y) | ((unsigned long long)pk2(v.z, v.w) << 32); }
        s = wave_sum(s);
        if (F.lane == 0) ss_arr(ws, 0)[m] = s;
    }
}

__device__ __forceinline__ void csum_items(int l) {
    Frame F = mk_frame();
    LAS float* wfl = (LAS float*)(F.lds); LAS float* Fs = (LAS float*)(F.lds + 32768);
    unsigned char* ws = KWS(); const float* fbias = KIN(13) + l * NHEAD; const float* ss1 = ss_arr(ws, 4 * l);
    const float* wf = (const float*)(ws + WS_WF) + (size_t)l * 8 * DM;
    for (int i = F.tid; i < 8 * DM; i += 512) wfl[i] = wf[i];
    __syncthreads();
    const bf16* HB = (const bf16*)(ws + WS_HB);
    float* CSL = (float*)(ws + WS_CSL); float* CST = (float*)(ws + WS_CST);
    for (int chunk = F.vcu; chunk < MROWS / 64; chunk += F.G) {
        for (int rr = 0; rr < 8; ++rr) {
            const int row = chunk * 64 + F.wave * 8 + rr;
            const v4u x0 = *(const v4u*)(HB + (size_t)row * DM + F.lane * 8), x1 = *(const v4u*)(HB + (size_t)row * DM + 512 + F.lane * 8);
            float xv[16] = {pg8::bflo(x0.x), pg8::bfhi(x0.x), pg8::bflo(x0.y), pg8::bfhi(x0.y), pg8::bflo(x0.z), pg8::bfhi(x0.z), pg8::bflo(x0.w), pg8::bfhi(x0.w),
                            pg8::bflo(x1.x), pg8::bfhi(x1.x), pg8::bflo(x1.y), pg8::bfhi(x1.y), pg8::bflo(x1.z), pg8::bfhi(x1.z), pg8::bflo(x1.w), pg8::bfhi(x1.w)};
            float mine = 0.f;
#pragma unroll
            for (int h = 0; h < 8; ++h) {
                const LAS f32x4* w = (const LAS f32x4*)(wfl + h * DM + F.lane * 8);
                const f32x4 w0 = w[0], w1 = w[1], w2 = w[128], w3 = w[129];
                float a = 0.f;
#pragma unroll
                for (int e = 0; e < 4; ++e) { a = fmaf(xv[e], w0[e], a); a = fmaf(xv[4 + e], w1[e], a); a = fmaf(xv[8 + e], w2[e], a); a = fmaf(xv[12 + e], w3[e], a); }
                a = wave_sum(a);
                if (F.lane == h) mine = a;
            }
            if (F.lane < 8) {
                const float f = mine * rsqrtf(ss1[row] * (1.0f / 1024.0f) + EPS) + fbias[F.lane];
                const float ls = (f >= 0.f) ? -log1pf(expf(-f)) : (f - log1pf(expf(f)));
                Fs[(F.wave * 8 + rr) * 8 + F.lane] = ls * LOG2E;
            }
        }
        __syncthreads();
        {
            float v = Fs[F.lane * 8 + F.wave];
#pragma unroll
            for (int o = 1; o < 64; o <<= 1) { const float t = __shfl_up(v, o); if (F.lane >= o) v += t; }
            const int row = chunk * 64 + F.lane, b = row / SEQ, t = row % SEQ;
            CSL[((size_t)b * NHEAD + F.wave) * SEQ + t] = v;
            { const float nv = -v; const unsigned h1 = f2bf(nv); const float r1 = nv - __uint_as_float(h1 << 16); const unsigned h2 = f2bf(r1); const float r2 = r1 - __uint_as_float(h2 << 16); const unsigned h3 = f2bf(r2);
              v4u w; w.x = h1 | (h2 << 16); w.y = h3 | 0x3F800000u; w.z = 0x3F803F80u; w.w = 0u;
              *(v4u*)((bf16*)(ws + WS_KAUG) + (((size_t)b * NHEAD + F.wave) * SEQ + t) * 8) = w; }
            if (F.lane == 63) CST[((size_t)b * NHEAD + F.wave) * 64 + t / 64] = v;
        }
        __syncthreads();
    }
}


__device__ __forceinline__ void ssm_naive_phase(int l) {
    Frame F = mk_frame();
    unsigned char* ws = KWS(); Inputs I; I.c_re = KIN(8); I.c_im = KIN(9); I.ssm_d = KIN(10);
    const int gw = opaque_s(F.vcu) * NWAVES + opaque_s(F.wave), NGW = opaque_s(F.G) * NWAVES;
    const bf16* U = (const bf16*)(ws + WS_U); bf16* GB = (bf16*)(ws + WS_GB);
    for (int it = gw; it < BATCH * SG; it += NGW) {
        const int b = it / SG, g = it % SG, n = F.lane;
        const float* bb = (const float*)(ws + WS_SPB) + ((size_t)(l * SG + g) * SN + n) * SP * 2;
        const float* pa = (const float*)(ws + WS_SPA) + ((size_t)(l * SG + g) * SN + n) * 2;
        const float* cre = I.c_re + (size_t)(l * SG + g) * SP * SN; const float* cim = I.c_im + (size_t)(l * SG + g) * SP * SN;
        float bbr[SP], bbi[SP], cr[SP], ci[SP];
#pragma unroll
        for (int p = 0; p < SP; ++p) { bbr[p] = bb[p * 2]; bbi[p] = bb[p * 2 + 1]; cr[p] = cre[p * SN + n]; ci[p] = cim[p * SN + n]; }
        const float ar = pa[0], ai = pa[1];
        const float dsk = I.ssm_d[l * DSSM + g * SP + (n & 15)];
        float xr = 0.f, xi = 0.f;
        for (int t = 0; t < SEQ; ++t) {
            const size_t row = (size_t)b * SEQ + t;
            const v4u u0 = *(const v4u*)(U + ((size_t)g * MROWS + row) * 16), u1 = *(const v4u*)(U + ((size_t)g * MROWS + row) * 16 + 8);
            float u[16] = {pg8::bflo(u0.x), pg8::bfhi(u0.x), pg8::bflo(u0.y), pg8::bfhi(u0.y), pg8::bflo(u0.z), pg8::bfhi(u0.z), pg8::bflo(u0.w), pg8::bfhi(u0.w),
                           pg8::bflo(u1.x), pg8::bfhi(u1.x), pg8::bflo(u1.y), pg8::bfhi(u1.y), pg8::bflo(u1.z), pg8::bfhi(u1.z), pg8::bflo(u1.w), pg8::bfhi(u1.w)};
            float bur = 0.f, bui = 0.f;
#pragma unroll
            for (int p = 0; p < SP; ++p) { bur = fmaf(bbr[p], u[p], bur); bui = fmaf(bbi[p], u[p], bui); }
            const float nxr = ar * xr - ai * xi + bur, nxi = ar * xi + ai * xr + bui;
            xr = nxr; xi = nxi;
            float mine = 0.f;
#pragma unroll
            for (int p = 0; p < SP; ++p) { const float v = wave_sum(cr[p] * xr - ci[p] * xi); if ((n & 15) == p) mine = v + dsk * u[p]; }
            if (n < SP) GB[row * 512 + g * SP + n] = (bf16)f2bf(gelu_tanh(mine));
        }
    }
}

__device__ __forceinline__ void attn_naive_phase(int l) {
    Frame F = mk_frame();
    unsigned char* ws = KWS(); float* ss_att = ss_arr(ws, 4 * l + 2);
    const int gw = opaque_s(F.vcu) * NWAVES + opaque_s(F.wave), NGW = opaque_s(F.G) * NWAVES;
    const bf16* Q = (const bf16*)(ws + WS_Q); const bf16* K = (const bf16*)(ws + WS_K); const bf16* V = (const bf16*)(ws + WS_V); bf16* MIX = (bf16*)(ws + WS_MIX);
    const float* CSL = (const float*)(ws + WS_CSL); const float* CST = (const float*)(ws + WS_CST);
    LAS unsigned char* wl = F.lds + F.wave * 8448;
    LAS v4u* Kt = (LAS v4u*)wl; LAS v4u* Vt = (LAS v4u*)(wl + 4096); LAS float* Cs = (LAS float*)(wl + 8192);
    for (int it = gw; it < BATCH * NHEAD * 64; it += NGW) {
        const int qb = 63 - it / 32, bh = it % 32, b = bh / NHEAD, h = bh % NHEAD;
        const int i = qb * 64 + F.lane; const size_t qrow = (size_t)b * SEQ + i;
        float q[64], o[64];
#pragma unroll
        for (int c = 0; c < 8; ++c) { const v4u w = *(const v4u*)(Q + qrow * 512 + h * 64 + c * 8);
            q[c * 8 + 0] = pg8::bflo(w.x); q[c * 8 + 1] = pg8::bfhi(w.x); q[c * 8 + 2] = pg8::bflo(w.y); q[c * 8 + 3] = pg8::bfhi(w.y);
            q[c * 8 + 4] = pg8::bflo(w.z); q[c * 8 + 5] = pg8::bfhi(w.z); q[c * 8 + 6] = pg8::bflo(w.w); q[c * 8 + 7] = pg8::bfhi(w.w); }
#pragma unroll
        for (int d = 0; d < 64; ++d) o[d] = 0.f;
        const float* cst = CST + (size_t)bh * 64; const float* csl = CSL + (size_t)bh * SEQ;
        float offq = 0.f; for (int c = 0; c < qb; ++c) offq += cst[c];
        const float ci = csl[i] + offq;
        float offk = 0.f, m = -INFINITY, lsum = 0.f;
        for (int kt = 0; kt < 2 * qb + 2; ++kt) {
            if (kt > 0 && (kt & 1) == 0) offk += cst[kt / 2 - 1];
            asm volatile("s_waitcnt lgkmcnt(0)" ::: "memory");
#pragma unroll
            for (int r = 0; r < 4; ++r) { const int idx = r * 64 + F.lane, key = idx >> 3, ch = idx & 7; const size_t krow = (size_t)b * SEQ + kt * 32 + key;
                Kt[idx] = *(const v4u*)(K + krow * 512 + h * 64 + ch * 8); Vt[idx] = *(const v4u*)(V + krow * 512 + h * 64 + ch * 8); }
            if (F.lane < 32) Cs[F.lane] = csl[kt * 32 + F.lane] + offk;
            asm volatile("s_waitcnt vmcnt(0) lgkmcnt(0)" ::: "memory");
            for (int j = 0; j < 32; ++j) {
                const int kj = kt * 32 + j;
                float s = 0.f;
#pragma unroll
                for (int c = 0; c < 8; ++c) { const v4u w = Kt[j * 8 + c];
                    s = fmaf(q[c * 8 + 0], pg8::bflo(w.x), s); s = fmaf(q[c * 8 + 1], pg8::bfhi(w.x), s); s = fmaf(q[c * 8 + 2], pg8::bflo(w.y), s); s = fmaf(q[c * 8 + 3], pg8::bfhi(w.y), s);
                    s = fmaf(q[c * 8 + 4], pg8::bflo(w.z), s); s = fmaf(q[c * 8 + 5], pg8::bfhi(w.z), s); s = fmaf(q[c * 8 + 6], pg8::bflo(w.w), s); s = fmaf(q[c * 8 + 7], pg8::bfhi(w.w), s); }
                s += ci - Cs[j];
                if (kj <= i) {
                    if (s > m) { const float f = __builtin_amdgcn_exp2f(m - s); lsum *= f;
#pragma unroll
                        for (int d = 0; d < 64; ++d) o[d] *= f;
                        m = s; }
                    const float p = __builtin_amdgcn_exp2f(s - m); lsum += p;
#pragma unroll
                    for (int c = 0; c < 8; ++c) { const v4u w = Vt[j * 8 + c];
                        o[c * 8 + 0] = fmaf(p, pg8::bflo(w.x), o[c * 8 + 0]); o[c * 8 + 1] = fmaf(p, pg8::bfhi(w.x), o[c * 8 + 1]); o[c * 8 + 2] = fmaf(p, pg8::bflo(w.y), o[c * 8 + 2]); o[c * 8 + 3] = fmaf(p, pg8::bfhi(w.y), o[c * 8 + 3]);
                        o[c * 8 + 4] = fmaf(p, pg8::bflo(w.z), o[c * 8 + 4]); o[c * 8 + 5] = fmaf(p, pg8::bfhi(w.z), o[c * 8 + 5]); o[c * 8 + 6] = fmaf(p, pg8::bflo(w.w), o[c * 8 + 6]); o[c * 8 + 7] = fmaf(p, pg8::bfhi(w.w), o[c * 8 + 7]); }
                }
            }
        }
        const float inv = 1.0f / lsum; float part = 0.f;
#pragma unroll
        for (int c = 0; c < 8; ++c) { float e[8];
#pragma unroll
            for (int d = 0; d < 8; ++d) { e[d] = o[c * 8 + d] * inv; part += e[d] * e[d]; }
            v4u w; w.x = pk2(e[0], e[1]); w.y = pk2(e[2], e[3]); w.z = pk2(e[4], e[5]); w.w = pk2(e[6], e[7]);
            *(v4u*)(MIX + qrow * 1024 + 512 + h * 64 + c * 8) = w; }
        atomicAdd(ss_att + qrow, part);
    }
}

__device__ __forceinline__ void attn_fox_phase(int l) {
    unsigned char* ws = KWS();
    const attn_body::AttnTensors AT{(const attn_body::bf16*)(ws + WS_Q), (const attn_body::bf16*)(ws + WS_K), (const attn_body::bf16*)(ws + WS_V), (const attn_body::bf16*)(ws + WS_KAUG),
                                    (const float*)(ws + WS_CSL), (const float*)(ws + WS_CST), (attn_body::bf16*)(ws + WS_MIX) + 512, ss_arr(ws, 4 * l + 2)};
    const attn_body::StaticOrder S(GRIDG_(), BLK_());
    attn_body::attn_phase<attn_body::StaticOrder>((char*)g_lds + RING_OFF, AT, S);
}

__device__ __forceinline__ void final_norm_phase() {
    Frame F = mk_frame();
    float* out = KOUT(); const float* ssf = ss_arr(KWS(), 8); const float* g = KIN(20);
    const int gw = opaque_s(F.vcu) * NWAVES + opaque_s(F.wave), NGW = opaque_s(F.G) * NWAVES;
    for (int m = gw; m < MROWS; m += NGW) {
        GAS f32x4* xr = (GAS f32x4*)(out + (size_t)m * DM) + F.lane; const f32x4* gr = (const f32x4*)g + F.lane;
        const float r = rsqrtf(ssf[m] * (1.0f / 1024.0f) + EPS);
#pragma unroll
        for (int j = 0; j < 4; ++j) { const f32x4 v = xr[64 * j]; const f32x4 gg = gr[64 * j]; xr[64 * j] = v * r * gg; }
    }
}

struct Args { const float* in[21]; float* out; unsigned char* ws; int pad0, pad1; };
__global__ void __launch_bounds__(NWAVES * 64, 2) fwd_megakernel(Args args) {
    if (DBG_STOP == -4) return;
    {
        Frame F = mk_frame();
        for (int u = F.tid; u < (LDS_BYTES - LDSCTL_OFF) / 4; u += NWAVES * 64) ((LAS unsigned*)(F.lds + LDSCTL_OFF))[u] = 0u;
        __syncthreads();
    }
    if (DBG_STOP == -5) return;
    XcdBarrier bar = xcd_barrier_post((unsigned*)(KWS() + WS_CTL) + CW_BAR, (volatile LAS unsigned*)((LAS unsigned char*)g_lds + MISC_OFF) + 8);
#define GRID_BAR() xcd_barrier(bar)
#define LDSRING ((LAS unsigned char*)g_lds + RING_OFF)
#define GRIDG opaque_s((int)gridDim.x)
#define BLK opaque_s((int)blockIdx.x)

    if (DBG_STOP == -2) return;
    if (DBG_STOP != -3) p0_prologue();
    GRID_BAR();
    if (DBG_STOP == 0 || DBG_STOP == -3) return;

    for (int l = 0; l < DEPTH; ++l) {
        csum_items(l);
        {
            unsigned char* ws = KWS();
            pg8::Gemm g{(const bf16*)(ws + WS_HB), (const bf16*)(ws + WS_WIN) + (size_t)l * 2048 * DM, MROWS, 2048, DM}; pg8::StaticOrder S; S.init(MROWS, 2048, GRIDG, BLK);
            pg8::EpiProj E{(bf16*)(ws + WS_U), (size_t)(WS_Q - WS_U) / 2, ss_arr(ws, 4 * l), C2, 0};
            pg8::gemm_phase<pg8::EpiProj, pg8::StaticOrder, true, true>(LDSRING, g, S, E);
        }
        GRID_BAR();
        if (DBG_STOP == 1) return;
        if (USE_NAIVE_SSM) ssm_naive_phase(l); else ssm_mfma_phase(l);
        if (USE_NAIVE_ATTN) attn_naive_phase(l); else attn_fox_phase(l);
        GRID_BAR();
        if (DBG_STOP == 2) return;
        {
            unsigned char* ws = KWS();
            pg8::Gemm g{(const bf16*)(ws + WS_GB), (const bf16*)(ws + WS_WGLU) + (size_t)l * DSSM * DSSM, MROWS, DSSM, DSSM}; pg8::StaticOrder S; S.init(MROWS, DSSM, GRIDG, BLK);
            pg8::EpiGlu E{(const bf16*)(ws + WS_GB), (bf16*)(ws + WS_MIX), KIN(12) + l * DSSM, ss_arr(ws, 4 * l + 1), 0};
            pg8::gemm_phase<pg8::EpiGlu, pg8::StaticOrder, true, true>(LDSRING, g, S, E);
        }
        GRID_BAR();
        {
            unsigned char* ws = KWS(); float* out = KOUT();
            pg8::Gemm g{(const bf16*)(ws + WS_MIX), (const bf16*)(ws + WS_WOUT) + (size_t)l * DM * DM, MROWS, DM, DM}; pg8::StaticOrder S; S.init(MROWS, DM, GRIDG, BLK);
            pg8::EpiOut E{l, 8};
            pg8::gemm_phase<pg8::EpiOut, pg8::StaticOrder, true, true>(LDSRING, g, S, E);
        }
        GRID_BAR();
        {
            unsigned char* ws = KWS();
            pg8::Gemm g{(const bf16*)(ws + WS_HB), (const bf16*)(ws + WS_WUP) + (size_t)l * DFF * DM, MROWS, DFF, DM}; pg8::StaticOrder S; S.init(MROWS, DFF, GRIDG, BLK);
            pg8::EpiUp E{(bf16*)(ws + WS_HID), ss_arr(ws, 4 * l + 3), 0};
            pg8::gemm_phase<pg8::EpiUp, pg8::StaticOrder, true, true>(LDSRING, g, S, E);
        }
        GRID_BAR();
        {
            unsigned char* ws = KWS(); float* out = KOUT();
            pg8::Gemm g{(const bf16*)(ws + WS_HID), (const bf16*)(ws + WS_WDN) + (size_t)l * DM * DFF, MROWS, DM, DFF}; pg8::StaticOrder S; S.init(MROWS, DM, GRIDG, BLK);
            pg8::EpiDown E{out, (bf16*)(ws + WS_HB), ss_arr(ws, 4 * l + 4), 0};
            pg8::gemm_phase<pg8::EpiDown, pg8::StaticOrder, true, true>(LDSRING, g, S, E);
        }
        GRID_BAR();
    }
    final_norm_phase();
}

extern "C" void kernel_launch(void* const* d_in, const int* in_sizes, int n_in, void* d_out, int out_size, void* d_ws, size_t ws_size, hipStream_t stream) {
    static int grid = 0;
    if (grid == 0) {
        if (n_in != 21 || out_size != MROWS * DM || ws_size < WS_END) { fprintf(stderr, "kernel_launch: unexpected shapes (n_in %d, out %d, ws %zu)\n", n_in, out_size, ws_size); grid = -1; return; }
        int dev = 0, cus = 0, per_cu = 0;
        if (hipGetDevice(&dev) != hipSuccess || hipDeviceGetAttribute(&cus, hipDeviceAttributeMultiprocessorCount, dev) != hipSuccess) { grid = -1; return; }
        if (hipFuncSetAttribute((const void*)fwd_megakernel, hipFuncAttributeMaxDynamicSharedMemorySize, LDS_BYTES) != hipSuccess) { fprintf(stderr, "kernel_launch: hipFuncSetAttribute failed\n"); grid = -1; return; }
        if (hipOccupancyMaxActiveBlocksPerMultiprocessor(&per_cu, (const void*)fwd_megakernel, NWAVES * 64, LDS_BYTES) != hipSuccess || per_cu < 1) { fprintf(stderr, "kernel_launch: occupancy query says %d blocks per CU\n", per_cu); }
        (void)hipGetLastError();
        grid = cus;
    }
    if (grid < 0) return;
    if (hipMemsetAsync((char*)d_ws + WS_CTL, 0, CTL_ZERO_BYTES, stream) != hipSuccess) { fprintf(stderr, "kernel_launch: memset failed\n"); return; }
    Args a{};
    for (int i = 0; i < 21; ++i) a.in[i] = (const float*)d_in[i];
    a.out = (float*)d_out; a.ws = (unsigned char*)d_ws;
    hipLaunchKernelGGL(fwd_megakernel, dim3(grid), dim3(NWAVES * 64), LDS_BYTES, stream, a);
    const hipError_t le = hipPeekAtLastError();
    if (le != hipSuccess) fprintf(stderr, "kernel_launch: launch failed: %s\n", hipGetErrorName(le));
}
```

```cpp
#include <hip/hip_runtime.h>
#include <cstdio>
#include <cstdint>

constexpr int BATCH = 4, SEQ = 4096, DM = 1024, MROWS = BATCH * SEQ, DEPTH = 2;
constexpr int DSSM = 512, DATT = 512, NHEAD = 8, HDIM = 64, DFF = 4096, DIN = 2056;
constexpr int SG = 32, SP = 16, SN = 64;
constexpr float EPS = 1e-6f;
constexpr float LOG2E = 1.4426950408889634f;
constexpr float C2 = 0.125f * 1.4426950408889634f;
namespace pg8 {
#define PG8_LAS __attribute__((address_space(3)))
typedef unsigned short bf16_t;
typedef short bf16x8 __attribute__((ext_vector_type(8)));
typedef float f32x4 __attribute__((ext_vector_type(4)));
typedef unsigned u32x4 __attribute__((ext_vector_type(4)));
constexpr int BM = 256, BK = 64, HALF = 128, HTB = HALF * BK * 2  , STAGE_BYTES = 8 * HTB, NXCD = 8, WGM = 8;

__host__ __device__ __forceinline__ int lds_byte(int r, int c) { const int st = (r >> 4) * 2 + (c >> 5), rr = r & 15, cc = c & 31, ob = rr * 64 + cc * 2; return st * 1024 + (ob ^ (((ob >> 9) & 1) << 5)); }
__host__ __device__ __forceinline__ void stage_rc(int b, int& R, int& C) { const int st = b / 1024, sb = b % 1024, swz = sb ^ (((sb >> 9) & 1) << 5); R = (st >> 1) * 16 + swz / 64; C = (st & 1) * 32 + (swz % 64) / 2; }
__host__ __device__ __forceinline__ int perm32(int rho) { const int n = rho >> 4, i = rho & 15; return 8 * (i >> 2) + 4 * n + (i & 3); }

struct Unit { int pm, pn; };
struct Gemm { const bf16_t* A; const bf16_t* Bt; int M, N, K; };

struct StaticOrder {
    int nM, nN, nwg, G, c;
    __host__ __device__ void init(int M, int N, int G_, int c_) { nM = M / BM; nN = N / BM; nwg = nM * nN; G = G_; c = c_; }
    __host__ __device__ bool next(int i, Unit& u) const {
        const long L = (long)i * G + c; if (L >= nwg) return false;
        int wgid = (int)L; { const int q = nwg / NXCD, r = nwg % NXCD, xcd = wgid % NXCD, off = wgid / NXCD; wgid = (xcd < r ? xcd * (q + 1) : r * (q + 1) + (xcd - r) * q) + off; }
        const int nig = WGM * nN, gid = wgid / nig, fm = gid * WGM, gsz = (nM - fm) < WGM ? (nM - fm) : WGM;
        u.pm = fm + ((wgid % nig) % gsz); u.pn = (wgid % nig) / gsz; return true;
    }
    __device__ __forceinline__ void a_ready(const Unit&) const {}
    __device__ __forceinline__ void done(const Unit&) const {}
};


__device__ __forceinline__ unsigned cvt_pk_bf16(float lo, float hi) { unsigned r; asm volatile("v_cvt_pk_bf16_f32 %0, %1, %2" : "=v"(r) : "v"(lo), "v"(hi)); return r; }
__device__ __forceinline__ float bflo(unsigned w) { return __uint_as_float(w << 16); }
__device__ __forceinline__ float bfhi(unsigned w) { return __uint_as_float(w & 0xffff0000u); }
typedef unsigned u32x2 __attribute__((ext_vector_type(2)));
constexpr int EP_M = 16384;
typedef __attribute__((address_space(4))) const unsigned char* ep_kptr_t;
template <class T> __device__ __forceinline__ T* ep_karg(int i) { ep_kptr_t p = (ep_kptr_t)__builtin_amdgcn_kernarg_segment_ptr(); asm volatile("" : "+s"(p)); return *(T* const __attribute__((address_space(4)))*)(p + 8 * i); }
__device__ __forceinline__ float* ep_ss(int i) { return (float*)(ep_karg<unsigned char>(22) + (1u << 20)) + (size_t)i * EP_M; }
__device__ __forceinline__ float* ep_out() { return ep_karg<float>(21); }
__device__ __forceinline__ const float* ep_x() { return ep_karg<const float>(0); }
__device__ __forceinline__ bf16_t* ep_hb() { return (bf16_t*)(ep_karg<unsigned char>(22) + (66u << 20)); }

struct EpiProj {
    static constexpr bool PERM = true, AFTER_DRAIN = false, MIDK = false;
    bf16_t* O; size_t stride; const float* ss; float qscale; int midk_t;
    __device__ __forceinline__ void midk(f32x4 (&)[2][2][4][2], const Unit&, int, int, int, int) const {}
    __device__ __forceinline__ void operator()(const f32x4 (&acc)[2][2][4][2], const Unit& u, int wr, int wc, int fr, int fq) const {
        const int row0 = u.pm * BM + wr * 64 + fr; int colt = u.pn * BM; const int t = colt / 512; colt -= t * 512;
        bf16_t* base = O + (size_t)t * stride; const float sc = (t == 1) ? qscale : 1.0f;
        const int col0 = colt + wc * 32 + 8 * fq;
#pragma unroll
        for (int ai = 0; ai < 2; ++ai)
#pragma unroll
            for (int m = 0; m < 4; ++m) { const int row = row0 + ai * HALF + m * 16; const float rs = rsqrtf(ss[row] * (1.0f / 1024.0f) + 1e-6f) * sc;
                bf16_t* rowp = (t == 0) ? base + ((size_t)(col0 >> 4) * EP_M + row) * 16 + (col0 & 15) : base + (size_t)row * 512 + col0;
#pragma unroll
                for (int bj = 0; bj < 2; ++bj) { const f32x4 v0 = acc[ai][bj][m][0] * rs, v1 = acc[ai][bj][m][1] * rs;
                    u32x4 w; w.x = cvt_pk_bf16(v0[0], v0[1]); w.y = cvt_pk_bf16(v0[2], v0[3]); w.z = cvt_pk_bf16(v1[0], v1[1]); w.w = cvt_pk_bf16(v1[2], v1[3]);
                    *(u32x4*)(rowp + (t == 0 ? (size_t)bj * 8 * EP_M * 16 : (size_t)bj * HALF)) = w; } }
    }
};
struct EpiGlu {
    static constexpr bool PERM = true, AFTER_DRAIN = false, MIDK = false;
    const bf16_t* GB; bf16_t* MIX; const float* bias; float* ss; int midk_t;
    __device__ __forceinline__ void midk(f32x4 (&)[2][2][4][2], const Unit&, int, int, int, int) const {}
    __device__ __forceinline__ void operator()(const f32x4 (&acc)[2][2][4][2], const Unit& u, int wr, int wc, int fr, int fq) const {
        const int row0 = u.pm * BM + wr * 64 + fr, col0 = u.pn * BM + wc * 32 + 8 * fq;
        f32x4 bv[2][2];
#pragma unroll
        for (int bj = 0; bj < 2; ++bj)
#pragma unroll
            for (int n = 0; n < 2; ++n) bv[bj][n] = *(const f32x4*)(bias + col0 + bj * HALF + 4 * n);
#pragma unroll
        for (int ai = 0; ai < 2; ++ai)
#pragma unroll
            for (int m = 0; m < 4; ++m) { const int row = row0 + ai * HALF + m * 16; float part = 0.f;
#pragma unroll
                for (int bj = 0; bj < 2; ++bj) {
                    const u32x4 gw = *(const u32x4*)(GB + (size_t)row * 512 + col0 + bj * HALF);
                    const f32x4 z0 = acc[ai][bj][m][0] + bv[bj][0], z1 = acc[ai][bj][m][1] + bv[bj][1];
                    float g[8] = {bflo(gw.x), bfhi(gw.x), bflo(gw.y), bfhi(gw.y), bflo(gw.z), bfhi(gw.z), bflo(gw.w), bfhi(gw.w)};
                    float z[8] = {z0[0], z0[1], z0[2], z0[3], z1[0], z1[1], z1[2], z1[3]}; float o[8];
#pragma unroll
                    for (int e = 0; e < 8; ++e) { const float s = __builtin_amdgcn_rcpf(1.0f + __builtin_amdgcn_exp2f(-z[e] * 1.4426950408889634f)); o[e] = g[e] * s; part += o[e] * o[e]; }
                    u32x4 w; w.x = cvt_pk_bf16(o[0], o[1]); w.y = cvt_pk_bf16(o[2], o[3]); w.z = cvt_pk_bf16(o[4], o[5]); w.w = cvt_pk_bf16(o[6], o[7]);
                    *(u32x4*)(MIX + (size_t)row * 1024 + col0 + bj * HALF) = w; }
                part += __shfl_xor(part, 16); part += __shfl_xor(part, 32);
                if (fq == 0) atomicAdd(ss + row, part); }
    }
};
struct EpiOut {
    static constexpr bool PERM = false, AFTER_DRAIN = false, MIDK = true;
    int l; int midk_t; int dup;
    __device__ __forceinline__ void midk(f32x4 (&acc)[2][2][4][2], const Unit& u, int wr, int wc, int fr, int fq) const {
        const float* ss_ssm = ep_ss(4 * l + 1); const float* ss_att = ss_ssm + EP_M;
        const int row0 = u.pm * BM + wr * 64 + fr;
#pragma unroll
        for (int ai = 0; ai < 2; ++ai)
#pragma unroll
            for (int m = 0; m < 4; ++m) { const int row = row0 + ai * HALF + m * 16;
                const float ra = sqrtf((ss_att[row] * (1.0f / 512.0f) + 1e-6f) / (ss_ssm[row] * (1.0f / 512.0f) + 1e-6f));
#pragma unroll
                for (int bj = 0; bj < 2; ++bj)
#pragma unroll
                    for (int n = 0; n < 2; ++n) acc[ai][bj][m][n] *= ra; }
    }
    __device__ __forceinline__ void operator()(const f32x4 (&acc)[2][2][4][2], const Unit& u, int wr, int wc, int fr, int fq) const {
        const float* ss_att = ep_ss(4 * l + 2); float* ss2 = dup ? ep_ss(9) : (float*)ss_att + EP_M; float* out = ep_out(); const float* base = (l == 0) ? ep_x() : (const float*)out; bf16_t* HB = ep_hb();
        if (dup) { out = (float*)(ep_karg<unsigned char>(22) + (98u << 20)); HB = (bf16_t*)(ep_karg<unsigned char>(22) + (194u << 20)); }
        const int row0 = u.pm * BM + wr * 64 + fr, col0 = u.pn * BM + wc * 32 + 4 * fq;
#pragma unroll
        for (int ai = 0; ai < 2; ++ai)
#pragma unroll
            for (int m = 0; m < 4; ++m) { const int row = row0 + ai * HALF + m * 16; const float r2 = rsqrtf(ss_att[row] * (1.0f / 512.0f) + 1e-6f); float part = 0.f;
                const size_t off = (size_t)row * 1024 + col0;
#pragma unroll
                for (int bj = 0; bj < 2; ++bj)
#pragma unroll
                    for (int n = 0; n < 2; ++n) { const f32x4 bs = *(const f32x4*)(base + off + bj * HALF + n * 16); const f32x4 o = bs + acc[ai][bj][m][n] * r2;
                        *(f32x4*)(out + off + bj * HALF + n * 16) = o; part += (o[0] * o[0] + o[1] * o[1]) + (o[2] * o[2] + o[3] * o[3]);
                        u32x2 w; w.x = cvt_pk_bf16(o[0], o[1]); w.y = cvt_pk_bf16(o[2], o[3]); *(u32x2*)(HB + off + bj * HALF + n * 16) = w; }
                part += __shfl_xor(part, 16); part += __shfl_xor(part, 32);
                if (fq == 0) atomicAdd(ss2 + row, part); }
    }
};
struct EpiUp {
    static constexpr bool PERM = true, AFTER_DRAIN = false, MIDK = false;
    bf16_t* O; const float* ss; int midk_t;
    __device__ __forceinline__ void midk(f32x4 (&)[2][2][4][2], const Unit&, int, int, int, int) const {}
    __device__ __forceinline__ void operator()(const f32x4 (&acc)[2][2][4][2], const Unit& u, int wr, int wc, int fr, int fq) const {
        const int row0 = u.pm * BM + wr * 64 + fr, col0 = u.pn * BM + wc * 32 + 8 * fq;
#pragma unroll
        for (int ai = 0; ai < 2; ++ai)
#pragma unroll
            for (int m = 0; m < 4; ++m) { const int row = row0 + ai * HALF + m * 16; const float rs = rsqrtf(ss[row] * (1.0f / 1024.0f) + 1e-6f);
                bf16_t* rowp = O + (size_t)row * 4096 + col0;
#pragma unroll
                for (int bj = 0; bj < 2; ++bj) { f32x4 v0 = acc[ai][bj][m][0] * rs, v1 = acc[ai][bj][m][1] * rs;
#pragma unroll
                    for (int e = 0; e < 4; ++e) { v0[e] = fmaxf(v0[e], 0.f); v0[e] *= v0[e]; v1[e] = fmaxf(v1[e], 0.f); v1[e] *= v1[e]; }
                    u32x4 w; w.x = cvt_pk_bf16(v0[0], v0[1]); w.y = cvt_pk_bf16(v0[2], v0[3]); w.z = cvt_pk_bf16(v1[0], v1[1]); w.w = cvt_pk_bf16(v1[2], v1[3]);
                    *(u32x4*)(rowp + bj * HALF) = w; } }
    }
};
struct EpiDown {
    static constexpr bool PERM = false, AFTER_DRAIN = false, MIDK = false;
    float* h; bf16_t* HB; float* ssn; int midk_t; int dup;
    __device__ __forceinline__ void midk(f32x4 (&)[2][2][4][2], const Unit&, int, int, int, int) const {}
    __device__ __forceinline__ void operator()(const f32x4 (&acc)[2][2][4][2], const Unit& u, int wr, int wc, int fr, int fq) const {
        const int row0 = u.pm * BM + wr * 64 + fr, col0 = u.pn * BM + wc * 32 + 4 * fq;
#pragma unroll
        for (int ai = 0; ai < 2; ++ai)
#pragma unroll
            for (int m = 0; m < 4; ++m) { const int row = row0 + ai * HALF + m * 16; float part = 0.f;
                const size_t off = (size_t)row * 1024 + col0;
#pragma unroll
                for (int bj = 0; bj < 2; ++bj)
#pragma unroll
                    for (int n = 0; n < 2; ++n) { const f32x4 bs = *(const f32x4*)(h + off + bj * HALF + n * 16); const f32x4 o = bs + acc[ai][bj][m][n];
                        if (dup) *(f32x4*)((float*)(ep_karg<unsigned char>(22) + (228u << 20)) + ((off + bj * HALF + n * 16) & 0x3fffffu)) = o; else *(f32x4*)(h + off + bj * HALF + n * 16) = o; part += (o[0] * o[0] + o[1] * o[1]) + (o[2] * o[2] + o[3] * o[3]);
                        u32x2 w; w.x = cvt_pk_bf16(o[0], o[1]); w.y = cvt_pk_bf16(o[2], o[3]); *(u32x2*)(HB + off + bj * HALF + n * 16) = w; }
                part += __shfl_xor(part, 16); part += __shfl_xor(part, 32);
                if (fq == 0) atomicAdd(ssn + row, part); }
    }
};
template <class Epi, class Sched, bool ALIGN_EPI = false, bool SP2 = false>
__device__ __forceinline__ void gemm_phase(PG8_LAS unsigned char* lds, const Gemm g, const Sched& S, const Epi& E) {
    int tid_ = threadIdx.x; asm volatile("" : "+v"(tid_));
    const int tid = tid_, wid = __builtin_amdgcn_readfirstlane(tid >> 6), lane = tid & 63, wr = wid >> 2, wc = wid & 3, fr = lane & 15, fq = lane >> 4;
    const int K = g.K, nt = K / BK;
    unsigned voffA[2], voffB[2];
#pragma unroll
    for (int i = 0; i < 2; ++i) { int R, C; stage_rc(tid * 16 + i * 8192, R, C); const int Rb = Epi::PERM ? ((R & ~31) + perm32(R & 31)) : R;
        voffA[i] = (unsigned)(R * K + C) * 2u; voffB[i] = (unsigned)(Rb * K + C) * 2u; }
    const size_t kstep = (size_t)(BK * 2);
    const size_t hstep = (size_t)HALF * K * 2;
    const size_t tstep = 2 * hstep;
    const unsigned ldsw = (unsigned)wid * 1024u;
    const int aoff = lds_byte(wr * 64 + fr, fq * 8), boff = lds_byte(wc * 32 + fr, fq * 8);
#define PG8_SA(b, h) (((b) * 2 + (h)) * HTB)
#define PG8_SB(b, h) ((4 + (b) * 2 + (h)) * HTB)
#define PG8_STAGE(bufoff, gbase, voff) do { _Pragma("unroll") for (int _i = 0; _i < 2; ++_i) \
        __builtin_amdgcn_global_load_lds((const unsigned*)((const char*)(gbase) + (voff)[_i]), (PG8_LAS unsigned*)(lds + (bufoff) + ldsw + _i * 8192), 16, 0, 0); } while (0)
#define PG8_LDA(dst, b, h) do { _Pragma("unroll") for (int m = 0; m < 4; ++m) _Pragma("unroll") for (int k = 0; k < 2; ++k) dst[m][k] = *(const PG8_LAS bf16x8*)(lds + PG8_SA(b, h) + aoff + m * 2048 + k * 1024); } while (0)
#define PG8_LDB(dst, b, h) do { _Pragma("unroll") for (int n = 0; n < 2; ++n) _Pragma("unroll") for (int k = 0; k < 2; ++k) dst[n][k] = *(const PG8_LAS bf16x8*)(lds + PG8_SB(b, h) + boff + n * 2048 + k * 1024); } while (0)
#define PG8_MMA(ai, bj, At, Bt) do { __builtin_amdgcn_s_setprio(1); _Pragma("unroll") for (int m = 0; m < 4; ++m) _Pragma("unroll") for (int n = 0; n < 2; ++n) _Pragma("unroll") for (int k = 0; k < 2; ++k) \
        acc[ai][bj][m][n] = __builtin_amdgcn_mfma_f32_16x16x32_bf16(Bt[n][k], At[m][k], acc[ai][bj][m][n], 0, 0, 0); __builtin_amdgcn_s_setprio(0); } while (0)
#define PG8_WAIT_V(n) asm volatile("s_waitcnt vmcnt(" #n ")" ::: "memory")
#define PG8_WAIT_L(n) asm volatile("s_waitcnt lgkmcnt(" #n ")" ::: "memory")
#define PG8_BAR __builtin_amdgcn_s_barrier()
#define PG8_SCHED __builtin_amdgcn_sched_barrier(0)
    Unit cur, nxt; int ui = 0;
    if (!S.next(0, cur)) return;
    f32x4 acc[2][2][4][2];
#pragma unroll
    for (int a = 0; a < 2; ++a)
#pragma unroll
        for (int b = 0; b < 2; ++b)
#pragma unroll
            for (int m = 0; m < 4; ++m)
#pragma unroll
                for (int n = 0; n < 2; ++n) acc[a][b][m][n] = (f32x4){0.f, 0.f, 0.f, 0.f};
    bf16x8 At[4][2], B0[2][2], B1[2][2];
    const char* cA = (const char*)g.A + (size_t)cur.pm * tstep; const char* cB = (const char*)g.Bt + (size_t)cur.pn * tstep;
    S.a_ready(cur);
    if constexpr (SP2) {
        PG8_STAGE(PG8_SB(0, 0), cB, voffB); PG8_STAGE(PG8_SB(0, 1), cB + hstep, voffB); PG8_STAGE(PG8_SA(0, 0), cA, voffA); PG8_STAGE(PG8_SA(0, 1), cA + hstep, voffA);
        if (wr == 1) PG8_BAR;
        PG8_WAIT_V(2); PG8_BAR;
        PG8_STAGE(PG8_SB(1, 0), cB + kstep, voffB); PG8_STAGE(PG8_SA(1, 0), cA + kstep, voffA); PG8_STAGE(PG8_SB(1, 1), cB + hstep + kstep, voffB);
        PG8_WAIT_V(6); PG8_BAR;
    } else {
        PG8_STAGE(PG8_SB(0, 0), cB, voffB); PG8_STAGE(PG8_SA(0, 0), cA, voffA); PG8_STAGE(PG8_SB(0, 1), cB + hstep, voffB); PG8_STAGE(PG8_SA(0, 1), cA + hstep, voffA);
        if (wr == 1) PG8_BAR;
        PG8_WAIT_V(4); PG8_BAR;
        PG8_STAGE(PG8_SB(1, 0), cB + kstep, voffB); PG8_STAGE(PG8_SA(1, 0), cA + kstep, voffA); PG8_STAGE(PG8_SB(1, 1), cB + hstep + kstep, voffB);
        PG8_WAIT_V(6); PG8_BAR;
    }
    for (;;) {
        const bool has_next = S.next(ui + 1, nxt);
        const char* nA = has_next ? (const char*)g.A + (size_t)nxt.pm * tstep : cA; const char* nB = has_next ? (const char*)g.Bt + (size_t)nxt.pn * tstep : cB;
        for (int t = 0; t < nt; t += 2) {
            if constexpr (Epi::MIDK) { if (t == E.midk_t) E.midk(acc, cur, wr, wc, fr, fq); }
            const bool last = (t == nt - 2);
            const char* a1 = cA + (size_t)(t + 1) * kstep;
            const char* a2 = last ? nA : cA + (size_t)(t + 2) * kstep; const char* b2 = last ? nB : cB + (size_t)(t + 2) * kstep;
            const char* a3 = a2 + kstep; const char* b3 = b2 + kstep;
            if (last && has_next) S.a_ready(nxt);
            if constexpr (SP2) {
            PG8_LDB(B0, 0, 0); PG8_LDB(B1, 0, 1); PG8_SCHED; PG8_LDA(At, 0, 0); PG8_STAGE(PG8_SA(1, 1), a1 + hstep, voffA);
            PG8_WAIT_V(8); PG8_WAIT_L(0); PG8_BAR; PG8_MMA(0, 0, At, B0); PG8_MMA(0, 1, At, B1); PG8_BAR; PG8_SCHED;
            PG8_LDA(At, 0, 1); PG8_STAGE(PG8_SB(0, 0), b2, voffB); PG8_STAGE(PG8_SB(0, 1), b2 + hstep, voffB); PG8_STAGE(PG8_SA(0, 0), a2, voffA);
            PG8_WAIT_V(8); PG8_WAIT_L(0); PG8_BAR; PG8_MMA(1, 0, At, B0); PG8_MMA(1, 1, At, B1); PG8_BAR; PG8_SCHED;
            PG8_LDB(B0, 1, 0); PG8_LDB(B1, 1, 1); PG8_SCHED; PG8_LDA(At, 1, 0); PG8_STAGE(PG8_SA(0, 1), a2 + hstep, voffA);
            PG8_WAIT_V(8); PG8_WAIT_L(0); PG8_BAR; PG8_MMA(0, 0, At, B0); PG8_MMA(0, 1, At, B1); PG8_BAR; PG8_SCHED;
            PG8_LDA(At, 1, 1); PG8_STAGE(PG8_SB(1, 0), b3, voffB); PG8_STAGE(PG8_SB(1, 1), b3 + hstep, voffB); PG8_STAGE(PG8_SA(1, 0), a3, voffA);
            PG8_WAIT_V(8); PG8_WAIT_L(0); PG8_BAR; PG8_MMA(1, 0, At, B0); PG8_MMA(1, 1, At, B1); PG8_BAR; PG8_SCHED;
            } else {
            PG8_LDB(B0, 0, 0); PG8_SCHED; PG8_LDA(At, 0, 0); PG8_STAGE(PG8_SA(1, 1), a1 + hstep, voffA);
            PG8_WAIT_L(8); PG8_BAR; PG8_WAIT_L(0); PG8_MMA(0, 0, At, B0); PG8_BAR; PG8_SCHED;
            PG8_LDB(B1, 0, 1); PG8_STAGE(PG8_SB(0, 0), b2, voffB);
            PG8_BAR; PG8_WAIT_L(0); PG8_MMA(0, 1, At, B1); PG8_BAR;
            PG8_LDA(At, 0, 1); PG8_STAGE(PG8_SA(0, 0), a2, voffA);
            PG8_BAR; PG8_WAIT_L(0); PG8_MMA(1, 0, At, B0); PG8_BAR; PG8_SCHED;
            PG8_STAGE(PG8_SB(0, 1), b2 + hstep, voffB);
            PG8_WAIT_V(6); PG8_BAR; PG8_MMA(1, 1, At, B1); PG8_BAR;
            PG8_LDB(B0, 1, 0); PG8_SCHED; PG8_LDA(At, 1, 0); PG8_STAGE(PG8_SA(0, 1), a2 + hstep, voffA);
            PG8_WAIT_L(8); PG8_BAR; PG8_WAIT_L(0); PG8_MMA(0, 0, At, B0); PG8_BAR; PG8_SCHED;
            PG8_LDB(B1, 1, 1); PG8_STAGE(PG8_SB(1, 0), b3, voffB);
            PG8_BAR; PG8_WAIT_L(0); PG8_MMA(0, 1, At, B1); PG8_BAR;
            PG8_LDA(At, 1, 1); PG8_STAGE(PG8_SA(1, 0), a3, voffA);
            PG8_BAR; PG8_WAIT_L(0); PG8_MMA(1, 0, At, B0); PG8_BAR; PG8_SCHED;
            PG8_STAGE(PG8_SB(1, 1), b3 + hstep, voffB);
            PG8_WAIT_V(6); PG8_BAR; PG8_MMA(1, 1, At, B1); PG8_BAR;
            }
        }
        if constexpr (ALIGN_EPI) { if (wr == 0) PG8_BAR; }
        if constexpr (!Epi::AFTER_DRAIN) { E(acc, cur, wr, wc, fr, fq); S.done(cur); }
        if (!has_next) break;
#pragma unroll
        for (int a = 0; a < 2; ++a)
#pragma unroll
            for (int b = 0; b < 2; ++b)
#pragma unroll
                for (int m = 0; m < 4; ++m)
#pragma unroll
                    for (int n = 0; n < 2; ++n) acc[a][b][m][n] = (f32x4){0.f, 0.f, 0.f, 0.f};
        cur = nxt; cA = nA; cB = nB; ++ui;
        if constexpr (ALIGN_EPI) { if (wr == 1) PG8_BAR; }
    }
    PG8_WAIT_V(0);
    if constexpr (!ALIGN_EPI) { if (wr == 0) PG8_BAR; }
    PG8_BAR;
    if constexpr (Epi::AFTER_DRAIN) { E.fused(acc, cur, wr, wc, fr, fq, lds, wid, lane); S.done(cur); }
#undef PG8_SA
#undef PG8_SB
#undef PG8_STAGE
#undef PG8_LDA
#undef PG8_LDB
#undef PG8_MMA
#undef PG8_WAIT_V
#undef PG8_WAIT_L
#undef PG8_BAR
#undef PG8_SCHED
}
}

#define GAS __attribute__((address_space(1)))
#define LAS __attribute__((address_space(3)))
typedef unsigned short bf16;
typedef unsigned v4u __attribute__((ext_vector_type(4)));
typedef float f32x4 __attribute__((ext_vector_type(4)));
typedef short bf16x8 __attribute__((ext_vector_type(8)));
typedef GAS unsigned gu32;
typedef GAS unsigned long long gu64;
#define RLX_AGENT __ATOMIC_RELAXED, __HIP_MEMORY_SCOPE_AGENT
#define LDS_WAIT() asm volatile("s_waitcnt lgkmcnt(0)" ::: "memory")
#define VM_WAIT() asm volatile("s_waitcnt vmcnt(0)" ::: "memory")
__device__ __forceinline__ unsigned long long rt() { return __builtin_amdgcn_s_memrealtime(); }
__device__ __forceinline__ unsigned f2bf(float f) { unsigned u = __builtin_bit_cast(unsigned, f); return (u + 0x7fffu + ((u >> 16) & 1u)) >> 16; }
__device__ __forceinline__ unsigned pk2(float lo, float hi) { return f2bf(lo) | (f2bf(hi) << 16); }
#define XB_TMO      128
#define XB_XCNT(j)  (256  + 64 * (j))
#define XB_XSUB(j)  (1280 + 64 * (j))
#define XB_XGEN(j)  (2304 + 64 * (j))
#define XB_TOP      3328
#define XB_TOPGEN   3392
#define XCD_BAR_WORDS 3456
#define XB_SPIN_CAP (1u << 18)

__device__ __forceinline__ unsigned xb_ld(unsigned* p)              { return __hip_atomic_load(p, __ATOMIC_RELAXED, __HIP_MEMORY_SCOPE_AGENT); }
__device__ __forceinline__ unsigned xb_add(unsigned* p, unsigned v) { return __hip_atomic_fetch_add(p, v, __ATOMIC_RELAXED, __HIP_MEMORY_SCOPE_AGENT); }
__device__ __forceinline__ unsigned xb_xcc_id() { return (unsigned)__builtin_amdgcn_s_getreg((3 << 11) | 20) & 0xFu; }
#define XB_SPIN(cond, bar) do { unsigned _sp = 0; while (cond) { __builtin_amdgcn_s_sleep(1); \
    if ((++_sp & 255u) == 0u) { if (xb_ld(&(bar)[XB_TMO])) break; if (_sp > XB_SPIN_CAP) { atomicAdd(&(bar)[XB_TMO], 1u); break; } } } } while (0)

struct XcdBarrier {
    unsigned* bar; unsigned x;
    volatile LAS unsigned* st;
};

__device__ __forceinline__ XcdBarrier xcd_barrier_post(unsigned* bar, volatile LAS unsigned* st) {
    XcdBarrier b; b.bar = bar; b.x = xb_xcc_id(); b.st = st;
    if (threadIdx.x == 0) (void)xb_add(&bar[XB_XCNT(b.x)], 1u);
    return b;
}
__device__ __forceinline__ void xcd_barrier_complete(unsigned* bar, unsigned x, unsigned& nloc, unsigned& nx) {
    const unsigned G = gridDim.x * gridDim.y * gridDim.z;
    unsigned sum, cnt, mine, sp = 0u;
    for (;;) {
        sum = 0u; cnt = 0u; mine = 0u;
#pragma unroll
        for (unsigned j = 0; j < 16; ++j) { const unsigned c = xb_ld(&bar[XB_XCNT(j)]); sum += c; cnt += (c > 0u) ? 1u : 0u; mine = (j == x) ? c : mine; }
        if (sum == G) break;
        __builtin_amdgcn_s_sleep(1);
        if ((++sp & 255u) == 0u) { if (xb_ld(&bar[XB_TMO])) break; if (sp > XB_SPIN_CAP) { atomicAdd(&bar[XB_TMO], 1u); break; } }
    }
    nloc = mine > 0u ? mine : 1u; nx = cnt > 0u ? cnt : 1u;
}

__device__ __forceinline__ void xcd_barrier(const XcdBarrier& b) {
    asm volatile("s_waitcnt vmcnt(0)" ::: "memory");
    __syncthreads();
    if (threadIdx.x == 0) {
        unsigned* bar = b.bar; unsigned bx = b.x; asm volatile("" : "+s"(bar), "+s"(bx));
        __builtin_amdgcn_s_waitcnt(0);
        unsigned nloc = b.st[0], nx = b.st[1];
        if (nloc == 0u) { xcd_barrier_complete(bar, bx, nloc, nx); b.st[0] = nloc; b.st[1] = nx; }
        const unsigned old = xb_add(&bar[XB_XSUB(bx)], 1u);
        const unsigned gen = old / nloc;
        if (old + 1u == (gen + 1u) * nloc) {
            __builtin_amdgcn_fence(__ATOMIC_RELEASE, "agent");
            asm volatile("s_waitcnt vmcnt(0)" ::: "memory");
            const unsigned og = xb_add(&bar[XB_TOP], 1u);
            const unsigned tg = og / nx;
            if (og + 1u == (tg + 1u) * nx) xb_add(&bar[XB_TOPGEN], 1u);
            else XB_SPIN(xb_ld(&bar[XB_TOPGEN]) == tg, bar);
            __builtin_amdgcn_fence(__ATOMIC_ACQUIRE, "agent");
            xb_add(&bar[XB_XGEN(bx)], 1u);
            asm volatile("s_waitcnt vmcnt(0)" ::: "memory");
        } else {
            XB_SPIN(xb_ld(&bar[XB_XGEN(bx)]) == gen, bar);
            __builtin_amdgcn_fence(__ATOMIC_ACQUIRE, "agent");
            asm volatile("s_waitcnt vmcnt(0)" ::: "memory");
        }
    }
    __syncthreads();
}
#include <hip/hip_bf16.h>
#include <cmath>
namespace attn_body {
using bf16=__hip_bfloat16;
using bf16x8=__attribute__((ext_vector_type(8)))short;
using s16x4=__attribute__((ext_vector_type(4)))short;
using f32x16=__attribute__((ext_vector_type(16)))float;
using u32x4=__attribute__((ext_vector_type(4)))unsigned;
constexpr int BATCH=4,NHEAD=8,SEQ=4096,D=64,DM=NHEAD*D,OPITCH=1024;
constexpr int NW=8,QBLK=32,QB=QBLK*NW,KVBLK=64,NQB=SEQ/QB;
constexpr int ATTN_PITCH=DM, ATTN_UNIT_ROWS=QB;
__device__ __forceinline__ int crow(int r,int hi){return (r&3)+8*(r>>2)+4*hi;}
#define SBAR() __builtin_amdgcn_sched_barrier(0)
__device__ __forceinline__ void cmask(f32x16&p0,f32x16&p1,int jb,int qrel,int hi){
  const float NEG=-INFINITY; int kb=64*jb+4*hi;
  #pragma unroll
  for(int r=0;r<16;++r){int kv=kb+(r&3)+8*(r>>2); if(kv>qrel)p0[r]=NEG; if(kv+32>qrel)p1[r]=NEG;}
}

constexpr int NSLOT=3, SLOTB=9216;
constexpr int LDS_K=0, LDS_V=NSLOT*SLOTB, LDS_WS=2*NSLOT*SLOTB, LDS_OST=LDS_WS+NW*64*4, LDS_OFFT=LDS_OST+NW*4096, LDS_BYTES=LDS_OFFT+256;
constexpr float C2=0.125f*1.4426950408889634f;
__device__ __forceinline__ void glds16(const void*gsrc,unsigned lds_dst){unsigned keep;
  asm volatile("s_mov_b32 %0, m0\n\ts_mov_b32 m0, %2\n\ts_nop 0\n\tglobal_load_lds_dwordx4 %1, off\n\ts_mov_b32 m0, %0":"=&s"(keep):"v"(gsrc),"s"(lds_dst):"memory");}
__device__ __forceinline__ float max3f(float a,float b,float c){float r;asm("v_max3_f32 %0, %1, %2, %3":"=v"(r):"v"(a),"v"(b),"v"(c));return r;}
__device__ __forceinline__ float max2f(float a,float b){float r;asm("v_max_f32_e32 %0, %1, %2":"=v"(r):"v"(a),"v"(b));return r;}
__device__ __forceinline__ float fadd_s(float a,float b){float r;asm("v_add_f32_e32 %0, %1, %2":"=v"(r):"v"(a),"v"(b));return r;}
__device__ __forceinline__ float fsub_s(float a,float b){float r;asm("v_sub_f32_e32 %0, %1, %2":"=v"(r):"v"(a),"v"(b));return r;}
typedef float f32x2_t __attribute__((ext_vector_type(2))); typedef __bf16 bf16x2_t __attribute__((ext_vector_type(2)));
__device__ __forceinline__ unsigned cvtpk_s(float lo,float hi){f32x2_t v={lo,hi};bf16x2_t b=__builtin_convertvector(v,bf16x2_t);return __builtin_bit_cast(unsigned,b);}
#define WAIT_BAR_(N) asm volatile("s_waitcnt vmcnt(" #N ") lgkmcnt(0)\n\ts_barrier":::"memory")
#define WAIT_BAR(N,N0) do{ if(wid==0){WAIT_BAR_(N0);}else{WAIT_BAR_(N);} }while(0)
__device__ __forceinline__ bf16x8 mk_qaug(float x,unsigned himask){
  const unsigned w1=cvtpk_s(1.0f,x); const float r1=x-__uint_as_float(w1&0xffff0000u);
  const unsigned t=cvtpk_s(r1,0.f); const float r2=r1-__uint_as_float(t<<16); const unsigned w2=cvtpk_s(r1,r2);
  u32x4 w; w.x=0x3F803F80u&himask; w.y=w1&himask; w.z=w2&himask; w.w=0u; return __builtin_bit_cast(bf16x8,w);}

__device__ __forceinline__ void qkt(f32x16&p0,f32x16&p1,const char*Kslot,const bf16x8*qr,bf16x8 qa,int r32,int hi){
  const char*kb=Kslot+hi*1024+r32*16; const char*ka=Kslot+8192+r32*16;
  { const bf16x8 a0=*reinterpret_cast<const bf16x8*>(ka), a1=*reinterpret_cast<const bf16x8*>(ka+512); const f32x16 z=f32x16{};
    p0=__builtin_amdgcn_mfma_f32_32x32x16_bf16(a0,qa,z,0,0,0); p1=__builtin_amdgcn_mfma_f32_32x32x16_bf16(a1,qa,z,0,0,0); }
  #pragma unroll
  for(int d0=0;d0<4;++d0){
    const bf16x8 b0=*reinterpret_cast<const bf16x8*>(kb+d0*2048);
    const bf16x8 b1=*reinterpret_cast<const bf16x8*>(kb+d0*2048+512);
    {p0=__builtin_amdgcn_mfma_f32_32x32x16_bf16(b0,qr[d0],p0,0,0,0);p1=__builtin_amdgcn_mfma_f32_32x32x16_bf16(b1,qr[d0],p1,0,0,0);}}
}
typedef __attribute__((address_space(3))) const char* lds_cptr;
typedef short v4i16_t __attribute__((ext_vector_type(4)));
__device__ __forceinline__ void kload8(bf16x8*kf,lds_cptr kp){
  kf[0]=*(const __attribute__((address_space(3))) bf16x8*)(kp);      kf[1]=*(const __attribute__((address_space(3))) bf16x8*)(kp+512);
  kf[2]=*(const __attribute__((address_space(3))) bf16x8*)(kp+2048); kf[3]=*(const __attribute__((address_space(3))) bf16x8*)(kp+2560);
  kf[4]=*(const __attribute__((address_space(3))) bf16x8*)(kp+4096); kf[5]=*(const __attribute__((address_space(3))) bf16x8*)(kp+4608);
  kf[6]=*(const __attribute__((address_space(3))) bf16x8*)(kp+6144); kf[7]=*(const __attribute__((address_space(3))) bf16x8*)(kp+6656);
}
__device__ __forceinline__ void kloada(bf16x8*kf,lds_cptr kpa){ kf[8]=*(const __attribute__((address_space(3))) bf16x8*)(kpa); kf[9]=*(const __attribute__((address_space(3))) bf16x8*)(kpa+512); }
__device__ __forceinline__ void kload2(bf16x8*kf,lds_cptr kp,int j){ kf[2*j]=*(const __attribute__((address_space(3))) bf16x8*)(kp+j*2048); kf[2*j+1]=*(const __attribute__((address_space(3))) bf16x8*)(kp+j*2048+512); }
__device__ __forceinline__ s16x4 vtr(lds_cptr p){ return __builtin_bit_cast(s16x4,__builtin_amdgcn_ds_read_tr16_b64_v4i16((__attribute__((address_space(3))) v4i16_t*)p)); }
__device__ __forceinline__ float rowmax(const f32x16&p0,const f32x16&p1){
  float a=max3f(p0[0],p0[1],p1[0]),b=max3f(p0[2],p0[3],p1[1]);a=max3f(a,p1[2],p1[3]);
  #pragma unroll
  for(int r=4;r<16;r+=4){a=max3f(a,p0[r],p0[r+1]);b=max3f(b,p0[r+2],p0[r+3]);a=max3f(a,p1[r],p1[r+1]);b=max3f(b,p1[r+2],p1[r+3]);}
  const float m=max2f(a,b);
  auto rr=__builtin_amdgcn_permlane32_swap(__float_as_uint(m),__float_as_uint(m),false,false);
  return max2f(__uint_as_float(rr[0]),__uint_as_float(rr[1]));
}
__device__ __forceinline__ void pv(f32x16*o,int vb,bf16x8 pa0,bf16x8 pa1,bf16x8 pa2,bf16x8 pa3){
  #pragma unroll
  for(int d0=0;d0<2;++d0){s16x4 lo[4],hi[4];
    #pragma unroll
    for(int ks=0;ks<4;++ks){
      asm volatile("ds_read_b64_tr_b16 %0,%1 offset:%c2":"=&v"(lo[ks]):"v"(vb),"i"(d0*4096+ks*1024):"memory");
      asm volatile("ds_read_b64_tr_b16 %0,%1 offset:%c2":"=&v"(hi[ks]):"v"(vb),"i"(d0*4096+ks*1024+512):"memory");}
    asm volatile("s_waitcnt lgkmcnt(0)":::"memory");SBAR();
    #define PK(k) (bf16x8){lo[k][0],lo[k][1],lo[k][2],lo[k][3],hi[k][0],hi[k][1],hi[k][2],hi[k][3]}
    o[d0]=__builtin_amdgcn_mfma_f32_32x32x16_bf16(pa0,PK(0),o[d0],0,0,0);
    o[d0]=__builtin_amdgcn_mfma_f32_32x32x16_bf16(pa1,PK(1),o[d0],0,0,0);
    o[d0]=__builtin_amdgcn_mfma_f32_32x32x16_bf16(pa2,PK(2),o[d0],0,0,0);
    o[d0]=__builtin_amdgcn_mfma_f32_32x32x16_bf16(pa3,PK(3),o[d0],0,0,0);
    #undef PK
  }
}

#ifndef ATTN_STORE16
#define ATTN_STORE16(p,v) (*(u32x4*)(p)=(v))
#endif
template<int THRL> __device__ __forceinline__ void attn_unit(int b,int h,int qb,const bf16*Q,const bf16*__restrict__ K,const bf16*__restrict__ V,const bf16*__restrict__ KAUG,const float*CSL,const float*CST,bf16*O,float*ssq,char*shm){
  int tid_=threadIdx.x; asm volatile("":"+v"(tid_));
  const int tid=tid_,lane=tid&63,r32=lane&31,hi=lane>>5; const int wid=__builtin_amdgcn_readfirstlane(tid>>6);
  const long rowbase=(long)b*SEQ; const int q0=qb*QB; const int bh=b*NHEAD+h;
  const bf16*Qw=Q+(rowbase+q0+wid*QBLK)*DM+h*D;
  const bf16*Kh=K+rowbase*DM+h*D,*Vh=V+rowbase*DM+h*D;
  const unsigned lds0=(unsigned)(uintptr_t)shm;
  float*wsf=(float*)(shm+LDS_WS)+wid*64;
  const bf16*ksrc=Kh+(long)lane*DM+wid*8;
  const bf16*vsrc=Vh+(long)(16*(wid&3)+(lane>>2))*DM+(wid>>2)*32+(lane&3)*8;
  const unsigned kdst=lds0+LDS_K+wid*1024, vdst=lds0+LDS_V+wid*1024, kadst=lds0+LDS_K+8192;
  const bf16*kasrc=KAUG+((long)bh*SEQ+lane)*8;
  __attribute__((address_space(3))) float*offt=(__attribute__((address_space(3))) float*)((__attribute__((address_space(3))) char*)shm+LDS_OFFT);
  if(wid==0){ const float v=CST[(long)bh*64+lane]; float inc=v;
    _Pragma("unroll") for(int o_=1;o_<64;o_<<=1){ const float t_=__shfl_up(inc,o_); if(lane>=o_)inc+=t_; }
    offt[lane]=inc-v; }
  const unsigned himask=hi?0u:0xffffffffu;
  #define DMA_K(t,slot) do{ glds16(ksrc+(long)(t)*KVBLK*DM,(unsigned)__builtin_amdgcn_readfirstlane(kdst+(slot))); if(wid==0)glds16(kasrc+(long)(t)*KVBLK*8,(unsigned)__builtin_amdgcn_readfirstlane(kadst+(slot))); }while(0)
  #define DMA_V(t,slot) glds16(vsrc+(long)(t)*KVBLK*DM,(unsigned)__builtin_amdgcn_readfirstlane(vdst+(slot)))
  const int vb0=(int)(lds0+LDS_V)+((lane>>4)&1)*32+(lane&3)*8+(4*hi+((lane&15)>>2))*64;
  const char*Kbase=shm+LDS_K; bf16x8 kf[10];
  const lds_cptr shm3=(lds_cptr)shm; const lds_cptr kp0=shm3+LDS_K+hi*1024+r32*16; const lds_cptr kpa=shm3+LDS_K+8192+r32*16; const lds_cptr vp0=shm3+LDS_V+((lane>>4)&1)*32+(lane&3)*8+(4*hi+((lane&15)>>2))*64;
  const int NT=(q0+QB)/KVBLK;
  DMA_K(0,0);DMA_V(0,0);DMA_K(1,SLOTB);
  bf16x8 qr[4];
  #pragma unroll
  for(int d0=0;d0<4;++d0)qr[d0]=*reinterpret_cast<const bf16x8*>(&Qw[(long)r32*DM+d0*16+hi*8]);
  const float csl_i=CSL[(long)bh*SEQ+q0+wid*QBLK+r32];
  float cm=0.f,l_reg=0.f;f32x16 o[2];o[0]=f32x16{};o[1]=f32x16{};
  const int qrel=wid*QBLK+r32;
  #define CMASK(P0,P1,t) do{int jb_=(t)-(NT-4); if(jb_>=0)cmask(P0,P1,jb_,qrel,hi);}while(0)
  bool resc=false;
  #define START(P0,P1) do{ const float rm=rowmax(P0,P1); resc=false; \
    { const float dl=rm; cm=fsub_s(cm,dl); \
      _Pragma("unroll") for(int r=0;r<16;++r){P0[r]=fsub_s(P0[r],dl);P1[r]=fsub_s(P1[r],dl);} } \
    _Pragma("unroll") for(int r=0;r<16;++r)P0[r]=__builtin_amdgcn_exp2f(P0[r]); }while(0)
  #define RESC() do{ if(resc){ asm volatile("s_waitcnt lgkmcnt(0)":::"memory"); \
      _Pragma("unroll") for(int d_=0;d_<2;++d_) _Pragma("unroll") for(int r=0;r<16;++r)o[d_][r]*=wsf[crow(r,hi)]; } }while(0)
  f32x16 pA0,pA1,pB0,pB1;
  int sl_prev=0,sl_cur=0,sl_next=SLOTB;
  #define ROT() do{sl_prev=sl_cur;sl_cur=sl_next;sl_next=(sl_next==(NSLOT-1)*SLOTB)?0:sl_next+SLOTB;}while(0)
  DMA_K(2,2*SLOTB);
  WAIT_BAR(3,5);
  cm=csl_i+offt[(q0+wid*QBLK)>>6];
  qkt(pA0,pA1,Kbase,qr,mk_qaug(cm,himask),r32,hi);asm volatile("s_nop 15\n\ts_nop 7":"+v"(pA0),"+v"(pA1));CMASK(pA0,pA1,0);
  START(pA0,pA1);
  _Pragma("unroll") for(int r=0;r<16;++r)pA1[r]=__builtin_amdgcn_exp2f(pA1[r]);
  WAIT_BAR(0,0);
  DMA_K(3,0);DMA_V(1,SLOTB);
  ROT();
  kload8(kf,kp0+sl_cur); kloada(kf,kpa+sl_cur);
  WAIT_BAR(2,3);
  s16x4 vlo[8],vhi[8]; u32x4 pw0,pw1,pw2,pw3;
  #define PKW(P,B) cvtpk_s(P[B],P[B+1])
  #define PAF(k) __builtin_bit_cast(bf16x8,pw##k)
  #define VFR(i) (bf16x8){vlo[i][0],vlo[i][1],vlo[i][2],vlo[i][3],vhi[i][0],vhi[i][1],vhi[i][2],vhi[i][3]}
  #define PIN(x) asm volatile("":"+v"(x))
  #define MX3(a,b,c) __builtin_fmaxf(__builtin_fmaxf((a),(b)),(c))
  #define GAPA(MF,A0,A1,A2,A3,W0,W1,PW) do{ MF; sacc+=A0; sacc+=A1; sacc+=A2; sacc+=A3; PIN(sacc); W0; W1; PIN(PW); SBAR(); }while(0)
  #define EX(v) __builtin_amdgcn_exp2f(v)
  #define GAPB(MF,X,B) do{ MF; X[B]=EX(X[B]); X[B+1]=EX(X[B+1]); X[B+2]=EX(X[B+2]); X[B+3]=EX(X[B+3]); PIN(X); SBAR(); }while(0)
  #define VRD(i) do{ vlo[i]=vtr(vp_+(((i)>>2)*4096+((i)&3)*1024)); vhi[i]=vtr(vp_+(((i)>>2)*4096+((i)&3)*1024+512)); }while(0)
  #define KRD(G,j) do{ if(G){ kload2(kf,kp0+sl_next,j); SBAR(); } }while(0)
  #define KRDA(G) do{ if(G){ kloada(kf,kpa+sl_next); SBAR(); } }while(0)
  #define STEP(C0,C1,P0,P1,t,GK,GV,GL) do{ SBAR(); \
    const lds_cptr vp_=vp0+sl_prev; \
    { const bf16x8 qa_=mk_qaug(cm-offt[t],himask); const f32x16 z_=f32x16{}; SBAR(); \
      C0=__builtin_amdgcn_mfma_f32_32x32x16_bf16(kf[8],qa_,z_,0,0,0); SBAR(); C1=__builtin_amdgcn_mfma_f32_32x32x16_bf16(kf[9],qa_,z_,0,0,0); SBAR(); } \
    VRD(0); SBAR(); float sacc=(P0[0]+P0[1]); \
    GAPA(C0=__builtin_amdgcn_mfma_f32_32x32x16_bf16(kf[0],qr[0],C0,0,0,0), P0[2],P0[3],P0[4],P0[5],     pw0[0]=PKW(P0,0), pw0[1]=PKW(P0,2), pw0); \
    VRD(4); SBAR(); GAPA(C1=__builtin_amdgcn_mfma_f32_32x32x16_bf16(kf[1],qr[0],C1,0,0,0), P0[6],P0[7],P0[8],P0[9],     pw0[2]=PKW(P0,4), pw0[3]=PKW(P0,6), pw0); \
    VRD(1); SBAR(); GAPA(C0=__builtin_amdgcn_mfma_f32_32x32x16_bf16(kf[2],qr[1],C0,0,0,0),   P0[10],P0[11],P0[12],P0[13], pw1[0]=PKW(P0,8), pw1[1]=PKW(P0,10), pw1); \
    VRD(5); SBAR(); GAPA(C1=__builtin_amdgcn_mfma_f32_32x32x16_bf16(kf[3],qr[1],C1,0,0,0),   P0[14],P0[15],P1[0],P1[1],   pw1[2]=PKW(P0,12),pw1[3]=PKW(P0,14), pw1); \
    VRD(2); SBAR(); GAPA(C0=__builtin_amdgcn_mfma_f32_32x32x16_bf16(kf[4],qr[2],C0,0,0,0),   P1[2],P1[3],P1[4],P1[5],     pw2[0]=PKW(P1,0), pw2[1]=PKW(P1,2), pw2); \
    VRD(6); SBAR(); GAPA(C1=__builtin_amdgcn_mfma_f32_32x32x16_bf16(kf[5],qr[2],C1,0,0,0),   P1[6],P1[7],P1[8],P1[9],     pw2[2]=PKW(P1,4), pw2[3]=PKW(P1,6), pw2); \
    VRD(3); SBAR(); GAPA(C0=__builtin_amdgcn_mfma_f32_32x32x16_bf16(kf[6],qr[3],C0,0,0,0),   P1[10],P1[11],P1[12],P1[13], pw3[0]=PKW(P1,8), pw3[1]=PKW(P1,10), pw3); \
    VRD(7); SBAR(); GAPA(C1=__builtin_amdgcn_mfma_f32_32x32x16_bf16(kf[7],qr[3],C1,0,0,0),   P1[14],P1[15],0.f,0.f,       pw3[2]=PKW(P1,12),pw3[3]=PKW(P1,14), pw3); \
    l_reg+=sacc; \
    if(GK){DMA_K((t)+3,sl_cur);} if(GV){DMA_V((t)+1,sl_next);} \
    CMASK(C0,C1,t); \
    { float a=MX3(C0[0],C0[1],C1[0]),b=MX3(C0[2],C0[3],C1[1]); a=MX3(a,C1[2],C1[3]); \
      _Pragma("unroll") for(int r=4;r<16;r+=4){a=MX3(a,C0[r],C0[r+1]);b=MX3(b,C0[r+2],C0[r+3]);a=MX3(a,C1[r],C1[r+1]);b=MX3(b,C1[r+2],C1[r+3]);} \
      float rm=__builtin_fmaxf(a,b); { auto rr=__builtin_amdgcn_permlane32_swap(__float_as_uint(rm),__float_as_uint(rm),false,false); rm=__builtin_fmaxf(__uint_as_float(rr[0]),__uint_as_float(rr[1])); } \
      resc=false; \
      if(__builtin_expect(__any(rm>(float)THRL),0)){ const float dl=__builtin_fmaxf(rm,0.f); cm-=dl; \
        _Pragma("unroll") for(int r=0;r<16;++r){C0[r]-=dl;C1[r]-=dl;} \
        const float f=__builtin_amdgcn_exp2f(-dl); l_reg*=f; if(hi==0)wsf[r32]=f; resc=true; } } \
    SBAR(); \
    GAPB(o[0]=__builtin_amdgcn_mfma_f32_32x32x16_bf16(PAF(0),VFR(0),o[0],0,0,0), C0,0); \
    GAPB(o[1]=__builtin_amdgcn_mfma_f32_32x32x16_bf16(PAF(0),VFR(4),o[1],0,0,0), C0,4); \
    KRD(GL,0); GAPB(o[0]=__builtin_amdgcn_mfma_f32_32x32x16_bf16(PAF(1),VFR(1),o[0],0,0,0), C0,8); \
    KRD(GL,1); GAPB(o[1]=__builtin_amdgcn_mfma_f32_32x32x16_bf16(PAF(1),VFR(5),o[1],0,0,0), C0,12); \
    KRD(GL,2); GAPB(o[0]=__builtin_amdgcn_mfma_f32_32x32x16_bf16(PAF(2),VFR(2),o[0],0,0,0), C1,0); \
    KRD(GL,3); GAPB(o[1]=__builtin_amdgcn_mfma_f32_32x32x16_bf16(PAF(2),VFR(6),o[1],0,0,0), C1,4); \
    KRDA(GL); GAPB(o[0]=__builtin_amdgcn_mfma_f32_32x32x16_bf16(PAF(3),VFR(3),o[0],0,0,0), C1,8); \
    GAPB(o[1]=__builtin_amdgcn_mfma_f32_32x32x16_bf16(PAF(3),VFR(7),o[1],0,0,0), C1,12); \
    }while(0)
  int t=1;
  #undef CMASK
  #define CMASK(P0,P1,t) do{}while(0)
  for(;t+5<NT;t+=2){
    STEP(pB0,pB1,pA0,pA1,t,true,true,true);     WAIT_BAR(2,3); RESC(); ROT();
    STEP(pA0,pA1,pB0,pB1,t+1,true,true,true);   WAIT_BAR(2,3); RESC(); ROT();
  }
  #undef CMASK
  #define CMASK(P0,P1,t) do{int jb_=(t)-(NT-4); if(jb_>=0)cmask(P0,P1,jb_,qrel,hi);}while(0)
  #define ENDW(tt) do{ if((tt)+3<NT){WAIT_BAR(2,3);} else if((tt)+2<NT){WAIT_BAR(1,1);} else {WAIT_BAR(0,0);} }while(0)
  for(;t+1<NT;t+=2){
    STEP(pB0,pB1,pA0,pA1,t,(t+3<NT),(t+1<NT),(t+1<NT));       ENDW(t);   RESC(); ROT();
    STEP(pA0,pA1,pB0,pB1,t+1,(t+4<NT),(t+2<NT),(t+2<NT));     ENDW(t+1); RESC(); ROT();
  }
  STEP(pB0,pB1,pA0,pA1,NT-1,false,false,false); RESC();
  { float sacc=pB0[0]+pB0[1]; _Pragma("unroll") for(int r=2;r<16;++r)sacc+=pB0[r]; _Pragma("unroll") for(int r=0;r<16;++r)sacc+=pB1[r]; l_reg+=sacc;
    pw0=(u32x4){PKW(pB0,0),PKW(pB0,2),PKW(pB0,4),PKW(pB0,6)};pw1=(u32x4){PKW(pB0,8),PKW(pB0,10),PKW(pB0,12),PKW(pB0,14)};pw2=(u32x4){PKW(pB1,0),PKW(pB1,2),PKW(pB1,4),PKW(pB1,6)};pw3=(u32x4){PKW(pB1,8),PKW(pB1,10),PKW(pB1,12),PKW(pB1,14)};
    SBAR(); pv(o,vb0+sl_cur,PAF(0),PAF(1),PAF(2),PAF(3)); }
  #undef PKW
  #undef PAF
  #undef VFR
  #undef PIN
  #undef MX3
  #undef GAPA
  #undef GAPB
  #undef EX
  #undef VRD
  #undef KRD
  #undef KRDA
  #undef STEP
  #undef ENDW
  {auto rr=__builtin_amdgcn_permlane32_swap(__float_as_uint(l_reg),__float_as_uint(l_reg),false,false);l_reg=__uint_as_float(rr[0])+__uint_as_float(rr[1]);}
  if(hi==0)wsf[32+r32]=l_reg;asm volatile("s_waitcnt lgkmcnt(0)":::"memory");
  float rli[16];
  #pragma unroll
  for(int r=0;r<16;++r)rli[r]=__builtin_amdgcn_rcpf(wsf[32+crow(r,hi)]);
  bf16*Ow=O+(rowbase+q0+wid*QBLK)*OPITCH+h*D; float*ssw=ssq+rowbase+q0+wid*QBLK;
  { bf16*stg=(bf16*)(shm+LDS_OST)+wid*2048;
    #pragma unroll
    for(int r=0;r<16;++r){const int orow=crow(r,hi);
      #pragma unroll
      for(int d0=0;d0<2;++d0)stg[orow*64+d0*32+r32]=__float2bfloat16(o[d0][r]*rli[r]);}
    asm volatile("s_waitcnt lgkmcnt(0)":::"memory");
    #pragma unroll
    for(int i=0;i<4;++i){const int row=i*8+(lane>>3),ch=lane&7; const u32x4 v=*(const u32x4*)(stg+row*64+ch*8); ATTN_STORE16(Ow+(long)row*OPITCH+ch*8,v);
      float sq=0.f;
      _Pragma("unroll") for(int e=0;e<4;++e){ const float a_=__uint_as_float(v[e]<<16), b_=__uint_as_float(v[e]&0xffff0000u); sq+=a_*a_+b_*b_; }
      sq+=__shfl_xor(sq,1); sq+=__shfl_xor(sq,2); sq+=__shfl_xor(sq,4); if(ch==0)atomicAdd(ssw+row,sq); } }
  asm volatile("s_waitcnt lgkmcnt(0)\n\ts_barrier":::"memory");
  #undef DMA_K
  #undef DMA_V
  #undef CMASK
  #undef START
  #undef RESC
  #undef ROT
}
constexpr int ATTN_LDS_BYTES=LDS_BYTES;
struct AttnTensors { const bf16* Q; const bf16* K; const bf16* V; const bf16* KAUG; const float* CSL; const float* CST; bf16* O; float* ssq; };
struct AttnUnit { int bh; int qb; };
struct StaticOrder {
  int vcu, G;
  __device__ __forceinline__ explicit StaticOrder(int grid,int block):vcu((grid%8==0)?(block%8)*(grid/8)+block/8:block),G(grid){}
  __device__ __forceinline__ bool next(int i,AttnUnit&u)const{ const int j=vcu+i*G; if(j>=512)return false; const int s=j&7; u.bh=(j&255)>>3; u.qb=(j<256)?15-s:s; return true; }
  __device__ __forceinline__ void a_ready(const AttnUnit&)const{}
  __device__ __forceinline__ void done(const AttnUnit&)const{}
};
template<class Sched,int THRL=16> __device__ __forceinline__ void attn_phase(char*lds,const AttnTensors&T,const Sched&S){
  AttnUnit u;
  for(int i=0;S.next(i,u);++i){ S.a_ready(u); attn_unit<THRL>(u.bh/NHEAD,u.bh%NHEAD,u.qb,T.Q,T.K,T.V,T.KAUG,T.CSL,T.CST,T.O,T.ssq,lds); S.done(u); }
}
#undef SBAR
#undef WAIT_BAR
#undef WAIT_BAR_
}

constexpr size_t MiB = 1u << 20;
constexpr size_t WS_CTL = 0, CTL_ZERO_BYTES = 256 * 1024;
constexpr size_t WS_SS = 1 * MiB;
constexpr size_t WS_CST = 1 * MiB + 640 * 1024;
constexpr size_t WS_CSL = 2 * MiB;
constexpr size_t WS_WF = 3 * MiB;
constexpr size_t WS_SPA = 3 * MiB + 64 * 1024;
constexpr size_t WS_SPB = 3 * MiB + 128 * 1024;
constexpr size_t WS_SA16 = 3 * MiB + 704 * 1024;
constexpr size_t WS_WIN = 4 * MiB, WS_WOUT = 12 * MiB, WS_WUP = 16 * MiB, WS_WDN = 32 * MiB, WS_WGLU = 48 * MiB;
constexpr size_t WS_SSMM = 49 * MiB;
constexpr size_t WS_HB = 66 * MiB;
constexpr size_t WS_U = 98 * MiB, WS_Q = 114 * MiB, WS_K = 130 * MiB, WS_V = 146 * MiB;
constexpr size_t WS_MIX = 162 * MiB;
constexpr size_t WS_GB = 194 * MiB;
constexpr size_t WS_ST = 210 * MiB;
constexpr size_t WS_HID = 98 * MiB;
constexpr size_t WS_KAUG = 226 * MiB;
constexpr size_t WS_END = 228 * MiB;
static_assert(WS_SS == (1u << 20) && WS_HB == (66u << 20) && MROWS == pg8::EP_M, "epilogue helper constants");
constexpr int CW_BAR = 4096;

constexpr int RING_OFF = 0, RING_BYTES = 131072;
constexpr int LDSCTL_OFF = RING_BYTES, MISC_OFF = LDSCTL_OFF + 320;
constexpr int LDS_BYTES = 147456;
constexpr int NWAVES = 8;
constexpr bool USE_NAIVE_ATTN = false, USE_NAIVE_SSM = false;
#ifndef REP_P1
#define REP_P1 1
#endif
#ifndef REP_SSM
#define REP_SSM 1
#endif
#ifndef REP_ATT
#define REP_ATT 1
#endif
#ifndef REP_GLU
#define REP_GLU 1
#endif
#ifndef REP_UP
#define REP_UP 1
#endif
#ifndef REP_OUT
#define REP_OUT 1
#endif
#ifndef REP_DN
#define REP_DN 1
#endif
#ifndef REP_SYNC
#define REP_SYNC 0
#endif
#ifndef REP_PRO
#define REP_PRO 1
#endif
static_assert(attn_body::LDS_BYTES <= RING_BYTES, "attention LDS");
#ifndef DBG_STOP_V
#define DBG_STOP_V 99
#endif
constexpr int DBG_STOP = DBG_STOP_V;

struct Frame {
    LAS unsigned char* lds;
    volatile LAS unsigned* MISC;
    int tid, lane, wave, vcu, G;
};
typedef __attribute__((address_space(4))) const unsigned char* kptr_t;
template <class T> __device__ __forceinline__ T* karg(int i) {
    kptr_t p = (kptr_t)__builtin_amdgcn_kernarg_segment_ptr(); asm volatile("" : "+s"(p));
    return *(T* const __attribute__((address_space(4)))*)(p + 8 * i);
}
__device__ __forceinline__ int opaque_s(int x) { asm volatile("" : "+s"(x)); return x; }
__device__ __forceinline__ int opaque_v(int x) { asm volatile("" : "+v"(x)); return x; }
__device__ __forceinline__ int GRIDG_() { return opaque_s((int)gridDim.x); }
__device__ __forceinline__ int BLK_() { return opaque_s((int)blockIdx.x); }
#define KIN(i) karg<const float>(i)
#define KOUT() karg<float>(21)
#define KWS() karg<unsigned char>(22)
extern __shared__ __attribute__((aligned(16))) unsigned char g_lds[];
__device__ __forceinline__ Frame mk_frame() {
    Frame F;
    F.lds = (LAS unsigned char*)g_lds; F.MISC = (volatile LAS unsigned*)(F.lds + MISC_OFF);
    F.tid = opaque_v((int)threadIdx.x); F.lane = F.tid & 63; F.wave = __builtin_amdgcn_readfirstlane(F.tid >> 6);
    F.G = opaque_s((int)gridDim.x); { const int bx = opaque_s((int)blockIdx.x); F.vcu = (F.G % 8 == 0) ? (bx % 8) * (F.G / 8) + bx / 8 : bx; }
    return F;
}
__device__ __forceinline__ float* ss_arr(unsigned char* ws, int i) { return (float*)(ws + WS_SS) + (size_t)i * MROWS; }

__device__ __forceinline__ float wave_sum(float v) {
#pragma unroll
    for (int o = 1; o < 64; o <<= 1) v += __shfl_xor(v, o);
    return v;
}
__device__ __forceinline__ void p0_transpose_item(const float* W, int K, int N, int ldw, const float* gain, bf16* WT, LAS float* scr, int item, int lane) {
    const int nblk = N / 32, kb = item / nblk, nb = item % nblk, k0 = 64 * kb, n0 = 32 * nb;
    f32x4 v[8]; float gv[8];
#pragma unroll
    for (int i = 0; i < 8; ++i) { const int idx = i * 64 + lane, kk = idx >> 3, c4 = (idx & 7) * 4; v[i] = *(const GAS f32x4*)(W + (size_t)(k0 + kk) * ldw + n0 + c4); gv[i] = gain ? gain[k0 + kk] : 1.0f; }
#pragma unroll
    for (int i = 0; i < 8; ++i) { const int idx = i * 64 + lane, kk = idx >> 3, c4 = (idx & 7) * 4; LAS float* d = scr + kk * 33 + c4; const f32x4 x = v[i] * gv[i]; d[0] = x.x; d[1] = x.y; d[2] = x.z; d[3] = x.w; }
    LDS_WAIT(); asm volatile("" ::: "memory");
    const int c = lane & 7;
#pragma unroll
    for (int j = 0; j < 4; ++j) { const int n = (lane >> 3) + 8 * j; const LAS float* s = scr + (8 * c) * 33 + n;
        v4u o; o.x = pk2(s[0 * 33], s[1 * 33]); o.y = pk2(s[2 * 33], s[3 * 33]); o.z = pk2(s[4 * 33], s[5 * 33]); o.w = pk2(s[6 * 33], s[7 * 33]);
        *(GAS v4u*)(WT + (size_t)(n0 + n) * K + k0 + 8 * c) = o; }
    LDS_WAIT(); asm volatile("" ::: "memory");
}

struct Inputs {
    const float *x, *ln1_g, *w_in, *log_dt, *lam_re, *lam_im, *b_re, *b_im, *c_re, *c_im, *ssm_d, *glu_w, *glu_b, *fgate_b, *gn_ssm_g, *gn_attn_g, *w_out, *ln2_g, *w_up, *w_down, *final_g;
};

__device__ __forceinline__ float gelu_tanh(float x) {
    const float k = 0.7978845608028654f;
    const float inner = k * (x + 0.044715f * x * x * x);
    const float e = __builtin_amdgcn_exp2f(inner * (2.0f * LOG2E));
    const float th = 1.0f - 2.0f * __builtin_amdgcn_rcpf(e + 1.0f);
    return 0.5f * x * (1.0f + th);
}

typedef float f32x2f __attribute__((ext_vector_type(2)));
constexpr int SSM_MAT_ELEMS = 131072;
__device__ __forceinline__ void ssm_mats_item(Frame& F, const Inputs& I, unsigned char* ws, int l, int g) {
    LAS f32x2f* AP = (LAS f32x2f*)(F.lds);
    LAS f32x2f* BB = (LAS f32x2f*)(F.lds + 8704);
    LAS f32x2f* CC = (LAS f32x2f*)(F.lds + 16896);
    LAS float* KT = (LAS float*)(F.lds + 25088);
    LAS float* DSK = (LAS float*)(F.lds + 41472);
    const int lg = l * SG + g, tid = F.tid;
    const float dt = expf(I.log_dt[lg]);
    for (int i = tid; i < 17 * 64; i += 512) { const int j = i >> 6, n = i & 63; const float lr = I.lam_re[lg * SN + n], li = I.lam_im[lg * SN + n];
        const float mag = expf(lr * dt * (float)j); float sn, cs; sincosf(li * dt * (float)j, &sn, &cs); AP[i] = (f32x2f){mag * cs, mag * sn}; }
    for (int i = tid; i < 64 * 16; i += 512) { const int n = i >> 4; const float lr = I.lam_re[lg * SN + n], li = I.lam_im[lg * SN + n];
        const float mag = expf(lr * dt); float sn, cs; sincosf(li * dt, &sn, &cs);
        const float are = mag * cs, aim = mag * sn, den = lr * lr + li * li, nr = are - 1.0f;
        const float sre = (nr * lr + aim * li) / den, sim = (aim * lr - nr * li) / den;
        const float br = I.b_re[(size_t)lg * SN * SP + i], bi = I.b_im[(size_t)lg * SN * SP + i];
        BB[i] = (f32x2f){sre * br - sim * bi, sre * bi + sim * br}; }
    for (int i = tid; i < 16 * 64; i += 512) CC[i] = (f32x2f){I.c_re[(size_t)lg * SP * SN + i], I.c_im[(size_t)lg * SP * SN + i]};
    if (tid < 16) DSK[tid] = I.ssm_d[l * DSSM + g * SP + tid];
    __syncthreads();
    {
        const int ln = F.lane, pq = ln & 15, kk = ln >> 4, part = kk & 1;
        for (int jj = 0; jj < 2; ++jj) { const int j = 2 * F.wave + jj; f32x4 acc = (f32x4){0.f, 0.f, 0.f, 0.f};
#pragma unroll 4
            for (int n0 = 0; n0 < 64; n0 += 2) { const int n = n0 + (kk >> 1); const f32x2f c = CC[pq * 64 + n], a = AP[j * 64 + n], b = BB[n * 16 + pq];
                const float av = part ? -c.y : c.x, bv = part ? (a.x * b.y + a.y * b.x) : (a.x * b.x - a.y * b.y);
                acc = __builtin_amdgcn_mfma_f32_16x16x4f32(av, bv, acc, 0, 0, 0); }
#pragma unroll
            for (int r = 0; r < 4; ++r) KT[(j * 16 + 4 * kk + r) * 16 + pq] = acc[r]; }
    }
    __syncthreads();
    bf16* base = (bf16*)(ws + WS_SSMM) + (size_t)lg * SSM_MAT_ELEMS;
    for (int i = 0; i < 8; ++i) {
        const int li_ = tid + 512 * i, frg = li_ >> 6, ln = li_ & 63, rt = frg >> 3, ks = frg & 7, row = 16 * rt + (ln & 15), n = row & 63, isim = row >> 6;
        const int k0 = 32 * ks + 8 * (ln >> 4), s = k0 >> 4, q0 = k0 & 15; const f32x2f a = AP[(15 - s) * 64 + n]; float v[8];
#pragma unroll
        for (int j8 = 0; j8 < 8; ++j8) { const f32x2f b = BB[n * 16 + q0 + j8]; v[j8] = isim ? (a.x * b.y + a.y * b.x) : (a.x * b.x - a.y * b.y); }
        v4u w; w.x = pk2(v[0], v[1]); w.y = pk2(v[2], v[3]); w.z = pk2(v[4], v[5]); w.w = pk2(v[6], v[7]);
        *(GAS v4u*)(base + (size_t)li_ * 8) = w; }
    for (int i = 0; i < 24; ++i) {
        const int li_ = tid + 512 * i, frg = li_ >> 6, ln = li_ & 63, t = frg / 12, ks = frg % 12, p = ln & 15, k0 = 32 * ks + 8 * (ln >> 4); float v[8];
        if (k0 < 256) { const int s = k0 >> 4, q0 = k0 & 15;
#pragma unroll
            for (int j8 = 0; j8 < 8; ++j8) { const int q = q0 + j8; float x = 0.f; if (s <= t) { x = KT[((t - s) * 16 + p) * 16 + q]; if (s == t && p == q) x += DSK[p]; } v[j8] = x; }
        } else { const bool im = k0 >= 320; const int n0 = k0 - (im ? 320 : 256);
#pragma unroll
            for (int j8 = 0; j8 < 8; ++j8) { const f32x2f a = AP[(t + 1) * 64 + n0 + j8], c = CC[p * 64 + n0 + j8]; v[j8] = im ? -(c.x * a.y + c.y * a.x) : (c.x * a.x - c.y * a.y); }
        }
        v4u w; w.x = pk2(v[0], v[1]); w.y = pk2(v[2], v[3]); w.z = pk2(v[4], v[5]); w.w = pk2(v[6], v[7]);
        *(GAS v4u*)(base + (size_t)(4096 + li_) * 8) = w; }
    if (tid < 64) ((f32x2f*)(ws + WS_SA16))[lg * SN + tid] = AP[16 * 64 + tid];
    __syncthreads();
}

constexpr int SSM_UT = 8448, SSM_XROW = 272;
__device__ __forceinline__ void ssm_mfma_phase(int l) {
    Frame F = mk_frame(); unsigned char* ws = KWS();
    LAS unsigned char* UT = F.lds; LAS unsigned char* XB = F.lds + 2 * SSM_UT; LAS f32x2f* EX = (LAS f32x2f*)(F.lds + 2 * SSM_UT + 256 * SSM_XROW);
    const int lane = F.lane, wave = F.wave, tid = F.tid, fr = lane & 15, fq = lane >> 4;
    const int uoff = tid * 16 + (tid >> 5) * 16;
    const int boff = fr * 528 + (lane >> 5) * 32 + ((lane >> 4) & 1) * 16;
    for (int item = F.vcu; item < BATCH * SG; item += F.G) {
        const int b = item >> 5, g = item & 31, lg = l * SG + g;
        const unsigned char* Ug = (const unsigned char*)((const bf16*)(ws + WS_U) + ((size_t)g * MROWS + (size_t)b * SEQ) * 16);
        const bf16* MAT = (const bf16*)(ws + WS_SSMM) + (size_t)lg * SSM_MAT_ELEMS;
        float* SL = (float*)(ws + WS_ST) + (size_t)item * 256 * 128;
        {
            bf16x8 wa[8];
#pragma unroll
            for (int ks = 0; ks < 8; ++ks) wa[ks] = *(const bf16x8*)(MAT + (size_t)((wave * 8 + ks) * 64 + lane) * 8);
            v4u ureg = *(const v4u*)(Ug + tid * 16);
            __syncthreads();
            *(LAS v4u*)(UT + uoff) = ureg;
            for (int j = 0; j < 16; ++j) {
                __syncthreads();
                if (j + 1 < 16) ureg = *(const v4u*)(Ug + (size_t)(j + 1) * 8192 + tid * 16);
                const LAS unsigned char* ut = UT + (j & 1) * SSM_UT + boff;
                f32x4 acc = (f32x4){0.f, 0.f, 0.f, 0.f};
#pragma unroll
                for (int ks = 0; ks < 8; ++ks) acc = __builtin_amdgcn_mfma_f32_16x16x32_bf16(wa[ks], *(const LAS bf16x8*)(ut + ks * 64), acc, 0, 0, 0);
                *(f32x4*)(SL + (size_t)(16 * j + fr) * 128 + 16 * wave + 4 * fq) = acc;
                if (j + 1 < 16) *(LAS v4u*)(UT + ((j + 1) & 1) * SSM_UT + uoff) = ureg;
            }
        }
        asm volatile("s_waitcnt vmcnt(0)" ::: "memory");
        __syncthreads();
        {
            const f32x2f a16 = ((const f32x2f*)(ws + WS_SA16))[lg * SN + lane];
            float pr = a16.x, pi = a16.y;
#pragma unroll
            for (int i = 0; i < 5; ++i) { const float nr = pr * pr - pi * pi, ni = 2.0f * pr * pi; pr = nr; pi = ni; }
            float sr[32], si[32];
#pragma unroll
            for (int i = 0; i < 32; ++i) { sr[i] = SL[(size_t)(32 * wave + i) * 128 + lane]; si[i] = SL[(size_t)(32 * wave + i) * 128 + 64 + lane]; }
            float xr = 0.f, xi = 0.f;
#pragma unroll
            for (int i = 0; i < 32; ++i) { const float nr = a16.x * xr - a16.y * xi + sr[i], ni = a16.x * xi + a16.y * xr + si[i]; xr = nr; xi = ni; }
            EX[wave * 64 + lane] = (f32x2f){xr, xi};
            __syncthreads();
            xr = 0.f; xi = 0.f;
            for (int w2 = 0; w2 < wave; ++w2) { const f32x2f e = EX[w2 * 64 + lane]; const float nr = pr * xr - pi * xi + e.x, ni = pr * xi + pi * xr + e.y; xr = nr; xi = ni; }
#pragma unroll
            for (int i = 0; i < 32; ++i) {
                LAS unsigned short* xrow = (LAS unsigned short*)(XB + (32 * wave + i) * SSM_XROW);
                xrow[lane] = (unsigned short)f2bf(xr); xrow[64 + lane] = (unsigned short)f2bf(xi);
                const float nr = a16.x * xr - a16.y * xi + sr[i], ni = a16.x * xi + a16.y * xr + si[i]; xr = nr; xi = ni; }
        }
        __syncthreads();
        {
            const int t0 = wave, t1 = 15 - wave;
            bf16x8 wc0[12], wc1[12];
#pragma unroll
            for (int ks = 0; ks < 12; ++ks) { wc0[ks] = *(const bf16x8*)(MAT + (size_t)(4096 + (t0 * 12 + ks) * 64 + lane) * 8); wc1[ks] = *(const bf16x8*)(MAT + (size_t)(4096 + (t1 * 12 + ks) * 64 + lane) * 8); }
            bf16* GB = (bf16*)(ws + WS_GB);
            v4u ureg = *(const v4u*)(Ug + tid * 16);
            *(LAS v4u*)(UT + uoff) = ureg;
            for (int j = 0; j < 16; ++j) {
                __syncthreads();
                if (j + 1 < 16) ureg = *(const v4u*)(Ug + (size_t)(j + 1) * 8192 + tid * 16);
                const LAS unsigned char* ut = UT + (j & 1) * SSM_UT + boff;
                const LAS unsigned char* xb = XB + (16 * j + fr) * SSM_XROW + fq * 16;
                f32x4 acc0 = (f32x4){0.f, 0.f, 0.f, 0.f}, acc1 = (f32x4){0.f, 0.f, 0.f, 0.f};
#pragma unroll
                for (int ks = 0; ks < 8; ++ks) { const bf16x8 ub = *(const LAS bf16x8*)(ut + ks * 64);
                    if (ks <= (t0 >> 1)) acc0 = __builtin_amdgcn_mfma_f32_16x16x32_bf16(wc0[ks], ub, acc0, 0, 0, 0);
                    if (ks <= (t1 >> 1)) acc1 = __builtin_amdgcn_mfma_f32_16x16x32_bf16(wc1[ks], ub, acc1, 0, 0, 0); }
#pragma unroll
                for (int kp = 0; kp < 4; ++kp) { const bf16x8 xf = *(const LAS bf16x8*)(xb + kp * 64);
                    acc0 = __builtin_amdgcn_mfma_f32_16x16x32_bf16(wc0[8 + kp], xf, acc0, 0, 0, 0);
                    acc1 = __builtin_amdgcn_mfma_f32_16x16x32_bf16(wc1[8 + kp], xf, acc1, 0, 0, 0); }
                const size_t row0 = (size_t)b * SEQ + 16 * (16 * j + fr);
                { pg8::u32x2 w; w.x = pk2(gelu_tanh(acc0[0]), gelu_tanh(acc0[1])); w.y = pk2(gelu_tanh(acc0[2]), gelu_tanh(acc0[3])); *(pg8::u32x2*)(GB + (row0 + t0) * 512 + g * SP + 4 * fq) = w; }
                { pg8::u32x2 w; w.x = pk2(gelu_tanh(acc1[0]), gelu_tanh(acc1[1])); w.y = pk2(gelu_tanh(acc1[2]), gelu_tanh(acc1[3])); *(pg8::u32x2*)(GB + (row0 + t1) * 512 + g * SP + 4 * fq) = w; }
                if (j + 1 < 16) *(LAS v4u*)(UT + ((j + 1) & 1) * SSM_UT + uoff) = ureg;
            }
        }
        __syncthreads();
    }
}


__device__ __forceinline__ Inputs load_inputs() {
    Inputs I;
    I.x = KIN(0); I.ln1_g = KIN(1); I.w_in = KIN(2); I.log_dt = KIN(3); I.lam_re = KIN(4); I.lam_im = KIN(5); I.b_re = KIN(6); I.b_im = KIN(7);
    I.c_re = KIN(8); I.c_im = KIN(9); I.ssm_d = KIN(10); I.glu_w = KIN(11); I.glu_b = KIN(12); I.fgate_b = KIN(13); I.gn_ssm_g = KIN(14); I.gn_attn_g = KIN(15);
    I.w_out = KIN(16); I.ln2_g = KIN(17); I.w_up = KIN(18); I.w_down = KIN(19); I.final_g = KIN(20);
    return I;
}
__device__ __forceinline__ void p0_prologue() {
    Frame F = mk_frame();
    const Inputs I = load_inputs();
    LAS float* scr = (LAS float*)(F.lds + RING_OFF + F.wave * 16384);
    const int gw = opaque_s(F.vcu) * NWAVES + opaque_s(F.wave), NGW = opaque_s(F.G) * NWAVES;
    unsigned char* ws = KWS();
    for (int it = F.vcu; it < DEPTH * SG; it += F.G) ssm_mats_item(F, I, ws, it / SG, it % SG);
    constexpr int I_IN = (DM / 64) * (2048 / 32), I_OUT = (DM / 64) * (DM / 32), I_UP = (DM / 64) * (DFF / 32), I_DN = (DFF / 64) * (DM / 32), I_GLU = (DSSM / 64) * (DSSM / 32);
    constexpr int PER_L = I_IN + I_OUT + I_UP + I_DN + I_GLU;
    for (int it = gw; it < DEPTH * PER_L; it += NGW) {
        const int l = it / PER_L; int r = it % PER_L;
        if (r < I_IN) { p0_transpose_item(I.w_in + (size_t)l * DM * DIN, DM, 2048, DIN, I.ln1_g + l * DM, (bf16*)(ws + WS_WIN) + (size_t)l * 2048 * DM, scr, r, F.lane); continue; } r -= I_IN;
        if (r < I_OUT) {
            const int kb = r / (DM / 32); const float* gain = (kb < 8) ? (I.gn_ssm_g + l * DSSM) : (I.gn_attn_g + l * DATT - 512);
            p0_transpose_item(I.w_out + (size_t)l * DM * DM, DM, DM, DM, gain, (bf16*)(ws + WS_WOUT) + (size_t)l * DM * DM, scr, r, F.lane); continue; } r -= I_OUT;
        if (r < I_UP) { p0_transpose_item(I.w_up + (size_t)l * DM * DFF, DM, DFF, DFF, I.ln2_g + l * DM, (bf16*)(ws + WS_WUP) + (size_t)l * DFF * DM, scr, r, F.lane); continue; } r -= I_UP;
        if (r < I_DN) { p0_transpose_item(I.w_down + (size_t)l * DFF * DM, DFF, DM, DM, nullptr, (bf16*)(ws + WS_WDN) + (size_t)l * DM * DFF, scr, r, F.lane); continue; } r -= I_DN;
        p0_transpose_item(I.glu_w + (size_t)l * DSSM * DSSM, DSSM, DSSM, DSSM, nullptr, (bf16*)(ws + WS_WGLU) + (size_t)l * DSSM * DSSM, scr, r, F.lane);
    }
    for (int i = gw * 64 + F.lane; i < DEPTH * 8 * DM; i += NGW * 64) { const int l = i / (8 * DM), h = (i / DM) % 8, k = i % DM;
        ((float*)(ws + WS_WF))[i] = I.w_in[(size_t)l * DM * DIN + (size_t)k * DIN + 2048 + h] * I.ln1_g[l * DM + k]; }
    for (int i = gw * 64 + F.lane; i < DEPTH * SG * SN; i += NGW * 64) {
        const int l = i / (SG * SN), gn = i % (SG * SN), g = gn / SN;
        const float dt = expf(I.log_dt[l * SG + g]);
        const float lr = I.lam_re[i], li = I.lam_im[i];
        const float mag = expf(lr * dt); float sn, cs; sincosf(li * dt, &sn, &cs);
        const float are = mag * cs, aim = mag * sn, den = lr * lr + li * li, nr = are - 1.0f;
        const float sre = (nr * lr + aim * li) / den, sim = (aim * lr - nr * li) / den;
        float* pa = (float*)(ws + WS_SPA) + (size_t)i * 2; pa[0] = are; pa[1] = aim;
        float* pb = (float*)(ws + WS_SPB) + (size_t)i * SP * 2;
        for (int p = 0; p < SP; ++p) { const float br = I.b_re[(size_t)i * SP + p], bi = I.b_im[(size_t)i * SP + p]; pb[p * 2] = sre * br - sim * bi; pb[p * 2 + 1] = sre * bi + sim * br; }
    }
    { f32x4* z = (f32x4*)ss_arr(ws, 1); for (int i = gw * 64 + F.lane; i < 8 * MROWS / 4; i += NGW * 64) z[i] = (f32x4){0.f, 0.f, 0.f, 0.f}; }
    for (int m0 = gw * 4; m0 < MROWS; m0 += NGW * 4) {
        f32x4 v[4][4];
#pragma unroll
        for (int r = 0; r < 4; ++r)
#pragma unroll
            for (int j = 0; j < 4; ++j) v[r][j] = ((const GAS f32x4*)(I.x + (size_t)(m0 + r) * DM) + F.lane)[64 * j];
#pragma unroll
        for (int r = 0; r < 4; ++r) {
            GAS unsigned long long* o8 = (GAS unsigned long long*)((bf16*)(ws + WS_HB) + (size_t)(m0 + r) * DM) + F.lane; float s = 0.f;
#pragma unroll
            for (int j = 0; j < 4; ++j) { const f32x4 x = v[r][j]; s += (x.x * x.x + x.y * x.y) + (x.z * x.z + x.w * x.w);
                o8[64 * j] = (unsigned long long)pk2(x.x, x.y) | ((unsigned long long)pk2(x.z, x.w) << 32); }
            s = wave_sum(s);
            if (F.lane == 0) ss_arr(ws, 0)[m0 + r] = s;
        }
    }
}

__device__ __forceinline__ void csum_items(int l) {
    Frame F = mk_frame();
    LAS float* wfl = (LAS float*)(F.lds); LAS float* Fs = (LAS float*)(F.lds + 32768);
    unsigned char* ws = KWS(); const float* fbias = KIN(13) + l * NHEAD; const float* ss1 = ss_arr(ws, 4 * l);
    const float* wf = (const float*)(ws + WS_WF) + (size_t)l * 8 * DM;
    for (int i = F.tid; i < 8 * DM; i += 512) wfl[i] = wf[i];
    __syncthreads();
    const bf16* HB = (const bf16*)(ws + WS_HB);
    float* CSL = (float*)(ws + WS_CSL); float* CST = (float*)(ws + WS_CST);
    for (int chunk = F.vcu; chunk < MROWS / 64; chunk += F.G) {
        for (int rr = 0; rr < 8; ++rr) {
            const int row = chunk * 64 + F.wave * 8 + rr;
            const v4u x0 = *(const v4u*)(HB + (size_t)row * DM + F.lane * 8), x1 = *(const v4u*)(HB + (size_t)row * DM + 512 + F.lane * 8);
            float xv[16] = {pg8::bflo(x0.x), pg8::bfhi(x0.x), pg8::bflo(x0.y), pg8::bfhi(x0.y), pg8::bflo(x0.z), pg8::bfhi(x0.z), pg8::bflo(x0.w), pg8::bfhi(x0.w),
                            pg8::bflo(x1.x), pg8::bfhi(x1.x), pg8::bflo(x1.y), pg8::bfhi(x1.y), pg8::bflo(x1.z), pg8::bfhi(x1.z), pg8::bflo(x1.w), pg8::bfhi(x1.w)};
            float mine = 0.f;
#pragma unroll
            for (int h = 0; h < 8; ++h) {
                const LAS f32x4* w = (const LAS f32x4*)(wfl + h * DM + F.lane * 8);
                const f32x4 w0 = w[0], w1 = w[1], w2 = w[128], w3 = w[129];
                float a = 0.f;
#pragma unroll
                for (int e = 0; e < 4; ++e) { a = fmaf(xv[e], w0[e], a); a = fmaf(xv[4 + e], w1[e], a); a = fmaf(xv[8 + e], w2[e], a); a = fmaf(xv[12 + e], w3[e], a); }
                a = wave_sum(a);
                if (F.lane == h) mine = a;
            }
            if (F.lane < 8) {
                const float f = mine * rsqrtf(ss1[row] * (1.0f / 1024.0f) + EPS) + fbias[F.lane];
                const float ls = (f >= 0.f) ? -log1pf(expf(-f)) : (f - log1pf(expf(f)));
                Fs[(F.wave * 8 + rr) * 8 + F.lane] = ls * LOG2E;
            }
        }
        __syncthreads();
        {
            float v = Fs[F.lane * 8 + F.wave];
#pragma unroll
            for (int o = 1; o < 64; o <<= 1) { const float t = __shfl_up(v, o); if (F.lane >= o) v += t; }
            const int row = chunk * 64 + F.lane, b = row / SEQ, t = row % SEQ;
            CSL[((size_t)b * NHEAD + F.wave) * SEQ + t] = v;
            { const float nv = -v; const unsigned h1 = f2bf(nv); const float r1 = nv - __uint_as_float(h1 << 16); const unsigned h2 = f2bf(r1); const float r2 = r1 - __uint_as_float(h2 << 16); const unsigned h3 = f2bf(r2);
              v4u w; w.x = h1 | (h2 << 16); w.y = h3 | 0x3F800000u; w.z = 0x3F803F80u; w.w = 0u;
              *(v4u*)((bf16*)(ws + WS_KAUG) + (((size_t)b * NHEAD + F.wave) * SEQ + t) * 8) = w; }
            if (F.lane == 63) CST[((size_t)b * NHEAD + F.wave) * 64 + t / 64] = v;
        }
        __syncthreads();
    }
}


__device__ __forceinline__ void ssm_naive_phase(int l) {
    Frame F = mk_frame();
    unsigned char* ws = KWS(); Inputs I; I.c_re = KIN(8); I.c_im = KIN(9); I.ssm_d = KIN(10);
    const int gw = opaque_s(F.vcu) * NWAVES + opaque_s(F.wave), NGW = opaque_s(F.G) * NWAVES;
    const bf16* U = (const bf16*)(ws + WS_U); bf16* GB = (bf16*)(ws + WS_GB);
    for (int it = gw; it < BATCH * SG; it += NGW) {
        const int b = it / SG, g = it % SG, n = F.lane;
        const float* bb = (const float*)(ws + WS_SPB) + ((size_t)(l * SG + g) * SN + n) * SP * 2;
        const float* pa = (const float*)(ws + WS_SPA) + ((size_t)(l * SG + g) * SN + n) * 2;
        const float* cre = I.c_re + (size_t)(l * SG + g) * SP * SN; const float* cim = I.c_im + (size_t)(l * SG + g) * SP * SN;
        float bbr[SP], bbi[SP], cr[SP], ci[SP];
#pragma unroll
        for (int p = 0; p < SP; ++p) { bbr[p] = bb[p * 2]; bbi[p] = bb[p * 2 + 1]; cr[p] = cre[p * SN + n]; ci[p] = cim[p * SN + n]; }
        const float ar = pa[0], ai = pa[1];
        const float dsk = I.ssm_d[l * DSSM + g * SP + (n & 15)];
        float xr = 0.f, xi = 0.f;
        for (int t = 0; t < SEQ; ++t) {
            const size_t row = (size_t)b * SEQ + t;
            const v4u u0 = *(const v4u*)(U + ((size_t)g * MROWS + row) * 16), u1 = *(const v4u*)(U + ((size_t)g * MROWS + row) * 16 + 8);
            float u[16] = {pg8::bflo(u0.x), pg8::bfhi(u0.x), pg8::bflo(u0.y), pg8::bfhi(u0.y), pg8::bflo(u0.z), pg8::bfhi(u0.z), pg8::bflo(u0.w), pg8::bfhi(u0.w),
                           pg8::bflo(u1.x), pg8::bfhi(u1.x), pg8::bflo(u1.y), pg8::bfhi(u1.y), pg8::bflo(u1.z), pg8::bfhi(u1.z), pg8::bflo(u1.w), pg8::bfhi(u1.w)};
            float bur = 0.f, bui = 0.f;
#pragma unroll
            for (int p = 0; p < SP; ++p) { bur = fmaf(bbr[p], u[p], bur); bui = fmaf(bbi[p], u[p], bui); }
            const float nxr = ar * xr - ai * xi + bur, nxi = ar * xi + ai * xr + bui;
            xr = nxr; xi = nxi;
            float mine = 0.f;
#pragma unroll
            for (int p = 0; p < SP; ++p) { const float v = wave_sum(cr[p] * xr - ci[p] * xi); if ((n & 15) == p) mine = v + dsk * u[p]; }
            if (n < SP) GB[row * 512 + g * SP + n] = (bf16)f2bf(gelu_tanh(mine));
        }
    }
}

__device__ __forceinline__ void attn_naive_phase(int l) {
    Frame F = mk_frame();
    unsigned char* ws = KWS(); float* ss_att = ss_arr(ws, 4 * l + 2);
    const int gw = opaque_s(F.vcu) * NWAVES + opaque_s(F.wave), NGW = opaque_s(F.G) * NWAVES;
    const bf16* Q = (const bf16*)(ws + WS_Q); const bf16* K = (const bf16*)(ws + WS_K); const bf16* V = (const bf16*)(ws + WS_V); bf16* MIX = (bf16*)(ws + WS_MIX);
    const float* CSL = (const float*)(ws + WS_CSL); const float* CST = (const float*)(ws + WS_CST);
    LAS unsigned char* wl = F.lds + F.wave * 8448;
    LAS v4u* Kt = (LAS v4u*)wl; LAS v4u* Vt = (LAS v4u*)(wl + 4096); LAS float* Cs = (LAS float*)(wl + 8192);
    for (int it = gw; it < BATCH * NHEAD * 64; it += NGW) {
        const int qb = 63 - it / 32, bh = it % 32, b = bh / NHEAD, h = bh % NHEAD;
        const int i = qb * 64 + F.lane; const size_t qrow = (size_t)b * SEQ + i;
        float q[64], o[64];
#pragma unroll
        for (int c = 0; c < 8; ++c) { const v4u w = *(const v4u*)(Q + qrow * 512 + h * 64 + c * 8);
            q[c * 8 + 0] = pg8::bflo(w.x); q[c * 8 + 1] = pg8::bfhi(w.x); q[c * 8 + 2] = pg8::bflo(w.y); q[c * 8 + 3] = pg8::bfhi(w.y);
            q[c * 8 + 4] = pg8::bflo(w.z); q[c * 8 + 5] = pg8::bfhi(w.z); q[c * 8 + 6] = pg8::bflo(w.w); q[c * 8 + 7] = pg8::bfhi(w.w); }
#pragma unroll
        for (int d = 0; d < 64; ++d) o[d] = 0.f;
        const float* cst = CST + (size_t)bh * 64; const float* csl = CSL + (size_t)bh * SEQ;
        float offq = 0.f; for (int c = 0; c < qb; ++c) offq += cst[c];
        const float ci = csl[i] + offq;
        float offk = 0.f, m = -INFINITY, lsum = 0.f;
        for (int kt = 0; kt < 2 * qb + 2; ++kt) {
            if (kt > 0 && (kt & 1) == 0) offk += cst[kt / 2 - 1];
            asm volatile("s_waitcnt lgkmcnt(0)" ::: "memory");
#pragma unroll
            for (int r = 0; r < 4; ++r) { const int idx = r * 64 + F.lane, key = idx >> 3, ch = idx & 7; const size_t krow = (size_t)b * SEQ + kt * 32 + key;
                Kt[idx] = *(const v4u*)(K + krow * 512 + h * 64 + ch * 8); Vt[idx] = *(const v4u*)(V + krow * 512 + h * 64 + ch * 8); }
            if (F.lane < 32) Cs[F.lane] = csl[kt * 32 + F.lane] + offk;
            asm volatile("s_waitcnt vmcnt(0) lgkmcnt(0)" ::: "memory");
            for (int j = 0; j < 32; ++j) {
                const int kj = kt * 32 + j;
                float s = 0.f;
#pragma unroll
                for (int c = 0; c < 8; ++c) { const v4u w = Kt[j * 8 + c];
                    s = fmaf(q[c * 8 + 0], pg8::bflo(w.x), s); s = fmaf(q[c * 8 + 1], pg8::bfhi(w.x), s); s = fmaf(q[c * 8 + 2], pg8::bflo(w.y), s); s = fmaf(q[c * 8 + 3], pg8::bfhi(w.y), s);
                    s = fmaf(q[c * 8 + 4], pg8::bflo(w.z), s); s = fmaf(q[c * 8 + 5], pg8::bfhi(w.z), s); s = fmaf(q[c * 8 + 6], pg8::bflo(w.w), s); s = fmaf(q[c * 8 + 7], pg8::bfhi(w.w), s); }
                s += ci - Cs[j];
                if (kj <= i) {
                    if (s > m) { const float f = __builtin_amdgcn_exp2f(m - s); lsum *= f;
#pragma unroll
                        for (int d = 0; d < 64; ++d) o[d] *= f;
                        m = s; }
                    const float p = __builtin_amdgcn_exp2f(s - m); lsum += p;
#pragma unroll
                    for (int c = 0; c < 8; ++c) { const v4u w = Vt[j * 8 + c];
                        o[c * 8 + 0] = fmaf(p, pg8::bflo(w.x), o[c * 8 + 0]); o[c * 8 + 1] = fmaf(p, pg8::bfhi(w.x), o[c * 8 + 1]); o[c * 8 + 2] = fmaf(p, pg8::bflo(w.y), o[c * 8 + 2]); o[c * 8 + 3] = fmaf(p, pg8::bfhi(w.y), o[c * 8 + 3]);
                        o[c * 8 + 4] = fmaf(p, pg8::bflo(w.z), o[c * 8 + 4]); o[c * 8 + 5] = fmaf(p, pg8::bfhi(w.z), o[c * 8 + 5]); o[c * 8 + 6] = fmaf(p, pg8::bflo(w.w), o[c * 8 + 6]); o[c * 8 + 7] = fmaf(p, pg8::bfhi(w.w), o[c * 8 + 7]); }
                }
            }
        }
        const float inv = 1.0f / lsum; float part = 0.f;
#pragma unroll
        for (int c = 0; c < 8; ++c) { float e[8];
#pragma unroll
            for (int d = 0; d < 8; ++d) { e[d] = o[c * 8 + d] * inv; part += e[d] * e[d]; }
            v4u w; w.x = pk2(e[0], e[1]); w.y = pk2(e[2], e[3]); w.z = pk2(e[4], e[5]); w.w = pk2(e[6], e[7]);
            *(v4u*)(MIX + qrow * 1024 + 512 + h * 64 + c * 8) = w; }
        atomicAdd(ss_att + qrow, part);
    }
}

__device__ __forceinline__ void attn_fox_phase(int l, int rep) {
    unsigned char* ws = KWS();
    const attn_body::AttnTensors AT{(const attn_body::bf16*)(ws + WS_Q), (const attn_body::bf16*)(ws + WS_K), (const attn_body::bf16*)(ws + WS_V), (const attn_body::bf16*)(ws + WS_KAUG),
                                    (const float*)(ws + WS_CSL), (const float*)(ws + WS_CST), (attn_body::bf16*)(ws + WS_MIX) + 512, ss_arr(ws, rep == 0 ? 4 * l + 2 : 9)};
    const attn_body::StaticOrder S(GRIDG_(), BLK_());
    attn_body::attn_phase<attn_body::StaticOrder>((char*)g_lds + RING_OFF, AT, S);
}

__device__ __forceinline__ void final_norm_phase() {
    Frame F = mk_frame();
    float* out = KOUT(); const float* ssf = ss_arr(KWS(), 8); const float* g = KIN(20);
    const int gw = opaque_s(F.vcu) * NWAVES + opaque_s(F.wave), NGW = opaque_s(F.G) * NWAVES;
    for (int m = gw; m < MROWS; m += NGW) {
        GAS f32x4* xr = (GAS f32x4*)(out + (size_t)m * DM) + F.lane; const f32x4* gr = (const f32x4*)g + F.lane;
        const float r = rsqrtf(ssf[m] * (1.0f / 1024.0f) + EPS);
#pragma unroll
        for (int j = 0; j < 4; ++j) { const f32x4 v = xr[64 * j]; const f32x4 gg = gr[64 * j]; xr[64 * j] = v * r * gg; }
    }
}

struct Args { const float* in[21]; float* out; unsigned char* ws; int pad0, pad1; };
__global__ void __launch_bounds__(NWAVES * 64, 2) fwd_megakernel(Args args) {
    if (DBG_STOP == -4) return;
    {
        Frame F = mk_frame();
        for (int u = F.tid; u < (LDS_BYTES - LDSCTL_OFF) / 4; u += NWAVES * 64) ((LAS unsigned*)(F.lds + LDSCTL_OFF))[u] = 0u;
        __syncthreads();
    }
    if (DBG_STOP == -5) return;
    XcdBarrier bar = xcd_barrier_post((unsigned*)(KWS() + WS_CTL) + CW_BAR, (volatile LAS unsigned*)((LAS unsigned char*)g_lds + MISC_OFF) + 8);
#ifndef REP_BAR
#define REP_BAR 1
#endif
#define GRID_BAR() do { for (int rb_ = 0; rb_ < REP_BAR; ++rb_) xcd_barrier(bar); } while (0)
#define LDSRING ((LAS unsigned char*)g_lds + RING_OFF)
#define GRIDG opaque_s((int)gridDim.x)
#define BLK opaque_s((int)blockIdx.x)

    if (DBG_STOP == -2) return;
    for (int rep = 0; rep < REP_PRO; ++rep) { p0_prologue(); __syncthreads(); }
    GRID_BAR();
    if (DBG_STOP == 0 || DBG_STOP == -3) return;

    for (int l = 0; l < DEPTH; ++l) {
        for (int rep = 0; rep < REP_P1; ++rep) {
        csum_items(l);
        {
            unsigned char* ws = KWS();
            pg8::Gemm g{(const bf16*)(ws + WS_HB), (const bf16*)(ws + WS_WIN) + (size_t)l * 2048 * DM, MROWS, 2048, DM}; pg8::StaticOrder S; S.init(MROWS, 2048, GRIDG, BLK);
            pg8::EpiProj E{(bf16*)(ws + WS_U), (size_t)(WS_Q - WS_U) / 2, ss_arr(ws, 4 * l), C2, 0};
            pg8::gemm_phase<pg8::EpiProj, pg8::StaticOrder, true, true>(LDSRING, g, S, E);
        }
        __syncthreads();
        }
        GRID_BAR();
        if (DBG_STOP == 1) return;
        for (int rep = 0; rep < REP_SSM; ++rep) { if (USE_NAIVE_SSM) ssm_naive_phase(l); else ssm_mfma_phase(l); }
        for (int rep = 0; rep < REP_ATT; ++rep) { if (USE_NAIVE_ATTN) attn_naive_phase(l); else attn_fox_phase(l, rep); }
        GRID_BAR();
        if (DBG_STOP == 2) return;
        for (int rep = 0; rep < REP_GLU; ++rep) {
            unsigned char* ws = KWS();
            pg8::Gemm g{(const bf16*)(ws + WS_GB), (const bf16*)(ws + WS_WGLU) + (size_t)l * DSSM * DSSM, MROWS, DSSM, DSSM}; pg8::StaticOrder S; S.init(MROWS, DSSM, GRIDG, BLK);
            pg8::EpiGlu E{(const bf16*)(ws + WS_GB), (bf16*)(ws + WS_MIX), KIN(12) + l * DSSM, ss_arr(ws, rep == 0 ? 4 * l + 1 : 9), 0};
            pg8::gemm_phase<pg8::EpiGlu, pg8::StaticOrder, true, true>(LDSRING, g, S, E);
            __syncthreads();
            if (REP_SYNC && rep + 1 < REP_GLU) GRID_BAR();
        }
        GRID_BAR();
        for (int rep = REP_OUT - 1; rep >= 0; --rep) {
            unsigned char* ws = KWS(); float* out = KOUT();
            pg8::Gemm g{(const bf16*)(ws + WS_MIX), (const bf16*)(ws + WS_WOUT) + (size_t)l * DM * DM, MROWS, DM, DM}; pg8::StaticOrder S; S.init(MROWS, DM, GRIDG, BLK);
            pg8::EpiOut E{l, 8, rep};
            pg8::gemm_phase<pg8::EpiOut, pg8::StaticOrder, true, true>(LDSRING, g, S, E);
            __syncthreads();
            if (REP_SYNC && rep != 0) GRID_BAR();
        }
        GRID_BAR();
        for (int rep = 0; rep < REP_UP; ++rep) {
            unsigned char* ws = KWS();
            pg8::Gemm g{(const bf16*)(ws + WS_HB), (const bf16*)(ws + WS_WUP) + (size_t)l * DFF * DM, MROWS, DFF, DM}; pg8::StaticOrder S; S.init(MROWS, DFF, GRIDG, BLK);
            pg8::EpiUp E{(bf16*)(ws + WS_HID), ss_arr(ws, 4 * l + 3), 0};
            pg8::gemm_phase<pg8::EpiUp, pg8::StaticOrder, true, true>(LDSRING, g, S, E);
            __syncthreads();
            if (REP_SYNC && rep + 1 < REP_UP) GRID_BAR();
        }
        GRID_BAR();
        for (int rep = REP_DN - 1; rep >= 0; --rep) {
            unsigned char* ws = KWS(); float* out = KOUT();
            pg8::Gemm g{(const bf16*)(ws + WS_HID), (const bf16*)(ws + WS_WDN) + (size_t)l * DM * DFF, MROWS, DM, DFF}; pg8::StaticOrder S; S.init(MROWS, DM, GRIDG, BLK);
            pg8::EpiDown E{out, (bf16*)(ws + WS_HB), ss_arr(ws, rep ? 9 : 4 * l + 4), 0, rep};
            pg8::gemm_phase<pg8::EpiDown, pg8::StaticOrder, true, true>(LDSRING, g, S, E);
            __syncthreads();
            if (REP_SYNC && rep != 0) GRID_BAR();
        }
        GRID_BAR();
    }
    final_norm_phase();
}

extern "C" void kernel_launch(void* const* d_in, const int* in_sizes, int n_in, void* d_out, int out_size, void* d_ws, size_t ws_size, hipStream_t stream) {
    static int grid = 0;
    if (grid == 0) {
        if (n_in != 21 || out_size != MROWS * DM || ws_size < WS_END) { fprintf(stderr, "kernel_launch: unexpected shapes (n_in %d, out %d, ws %zu)\n", n_in, out_size, ws_size); grid = -1; return; }
        int dev = 0, cus = 0, per_cu = 0;
        if (hipGetDevice(&dev) != hipSuccess || hipDeviceGetAttribute(&cus, hipDeviceAttributeMultiprocessorCount, dev) != hipSuccess) { grid = -1; return; }
        if (hipFuncSetAttribute((const void*)fwd_megakernel, hipFuncAttributeMaxDynamicSharedMemorySize, LDS_BYTES) != hipSuccess) { fprintf(stderr, "kernel_launch: hipFuncSetAttribute failed\n"); grid = -1; return; }
        if (hipOccupancyMaxActiveBlocksPerMultiprocessor(&per_cu, (const void*)fwd_megakernel, NWAVES * 64, LDS_BYTES) != hipSuccess || per_cu < 1) { fprintf(stderr, "kernel_launch: occupancy query says %d blocks per CU\n", per_cu); }
        (void)hipGetLastError();
        grid = cus;
    }
    if (grid < 0) return;
    if (hipMemsetAsync((char*)d_ws + WS_CTL, 0, CTL_ZERO_BYTES, stream) != hipSuccess) { fprintf(stderr, "kernel_launch: memset failed\n"); return; }
    Args a{};
    for (int i = 0; i < 21; ++i) a.in[i] = (const float*)d_in[i];
    a.out = (float*)d_out; a.ws = (unsigned char*)d_ws;
    hipLaunchKernelGGL(fwd_megakernel, dim3(grid), dim3(NWAVES * 64), LDS_BYTES, stream, a);
    const hipError_t le = hipPeekAtLastError();
    if (le != hipSuccess) fprintf(stderr, "kernel_launch: launch failed: %s\n", hipGetErrorName(le));
}
```

```cpp
#include <hip/hip_runtime.h>
#include <cstdio>
#include <cstdint>

constexpr int BATCH = 4, SEQ = 4096, DM = 1024, MROWS = BATCH * SEQ, DEPTH = 2;
constexpr int DSSM = 512, DATT = 512, NHEAD = 8, HDIM = 64, DFF = 4096, DIN = 2056;
constexpr int SG = 32, SP = 16, SN = 64;
constexpr float EPS = 1e-6f;
constexpr float LOG2E = 1.4426950408889634f;
constexpr float C2 = 0.125f * 1.4426950408889634f;
namespace pg8 {
#define PG8_LAS __attribute__((address_space(3)))
typedef unsigned short bf16_t;
typedef short bf16x8 __attribute__((ext_vector_type(8)));
typedef float f32x4 __attribute__((ext_vector_type(4)));
typedef unsigned u32x4 __attribute__((ext_vector_type(4)));
constexpr int BM = 256, BK = 64, HALF = 128, HTB = HALF * BK * 2  , STAGE_BYTES = 8 * HTB, NXCD = 8, WGM = 8;

__host__ __device__ __forceinline__ int lds_byte(int r, int c) { const int st = (r >> 4) * 2 + (c >> 5), rr = r & 15, cc = c & 31, ob = rr * 64 + cc * 2; return st * 1024 + (ob ^ (((ob >> 9) & 1) << 5)); }
__host__ __device__ __forceinline__ void stage_rc(int b, int& R, int& C) { const int st = b / 1024, sb = b % 1024, swz = sb ^ (((sb >> 9) & 1) << 5); R = (st >> 1) * 16 + swz / 64; C = (st & 1) * 32 + (swz % 64) / 2; }
__host__ __device__ __forceinline__ int perm32(int rho) { const int n = rho >> 4, i = rho & 15; return 8 * (i >> 2) + 4 * n + (i & 3); }

struct Unit { int pm, pn; };
struct Gemm { const bf16_t* A; const bf16_t* Bt; int M, N, K; };

struct StaticOrder {
    int nM, nN, nwg, G, c;
    __host__ __device__ void init(int M, int N, int G_, int c_) { nM = M / BM; nN = N / BM; nwg = nM * nN; G = G_; c = c_; }
    __host__ __device__ bool next(int i, Unit& u) const {
        const long L = (long)i * G + c; if (L >= nwg) return false;
        int wgid = (int)L; { const int q = nwg / NXCD, r = nwg % NXCD, xcd = wgid % NXCD, off = wgid / NXCD; wgid = (xcd < r ? xcd * (q + 1) : r * (q + 1) + (xcd - r) * q) + off; }
        const int nig = WGM * nN, gid = wgid / nig, fm = gid * WGM, gsz = (nM - fm) < WGM ? (nM - fm) : WGM;
        u.pm = fm + ((wgid % nig) % gsz); u.pn = (wgid % nig) / gsz; return true;
    }
    __device__ __forceinline__ void a_ready(const Unit&) const {}
    __device__ __forceinline__ void done(const Unit&) const {}
};


__device__ __forceinline__ unsigned cvt_pk_bf16(float lo, float hi) { unsigned r; asm volatile("v_cvt_pk_bf16_f32 %0, %1, %2" : "=v"(r) : "v"(lo), "v"(hi)); return r; }
__device__ __forceinline__ float bflo(unsigned w) { return __uint_as_float(w << 16); }
__device__ __forceinline__ float bfhi(unsigned w) { return __uint_as_float(w & 0xffff0000u); }
typedef unsigned u32x2 __attribute__((ext_vector_type(2)));
constexpr int EP_M = 16384;
typedef __attribute__((address_space(4))) const unsigned char* ep_kptr_t;
template <class T> __device__ __forceinline__ T* ep_karg(int i) { ep_kptr_t p = (ep_kptr_t)__builtin_amdgcn_kernarg_segment_ptr(); asm volatile("" : "+s"(p)); return *(T* const __attribute__((address_space(4)))*)(p + 8 * i); }
__device__ __forceinline__ float* ep_ss(int i) { return (float*)(ep_karg<unsigned char>(22) + (1u << 20)) + (size_t)i * EP_M; }
__device__ __forceinline__ float* ep_out() { return ep_karg<float>(21); }
__device__ __forceinline__ const float* ep_x() { return ep_karg<const float>(0); }
__device__ __forceinline__ bf16_t* ep_hb() { return (bf16_t*)(ep_karg<unsigned char>(22) + (66u << 20)); }

struct EpiProj {
    static constexpr bool PERM = true, AFTER_DRAIN = false, MIDK = false;
    bf16_t* O; size_t stride; const float* ss; float qscale; int midk_t;
    __device__ __forceinline__ void midk(f32x4 (&)[2][2][4][2], const Unit&, int, int, int, int) const {}
    __device__ __forceinline__ void operator()(const f32x4 (&acc)[2][2][4][2], const Unit& u, int wr, int wc, int fr, int fq) const {
        const int row0 = u.pm * BM + wr * 64 + fr; int colt = u.pn * BM; const int t = colt / 512; colt -= t * 512;
        bf16_t* base = O + (size_t)t * stride; const float sc = (t == 1) ? qscale : 1.0f;
        const int col0 = colt + wc * 32 + 8 * fq;
#pragma unroll
        for (int ai = 0; ai < 2; ++ai)
#pragma unroll
            for (int m = 0; m < 4; ++m) { const int row = row0 + ai * HALF + m * 16; const float rs = rsqrtf(ss[row] * (1.0f / 1024.0f) + 1e-6f) * sc;
                bf16_t* rowp = (t == 0) ? base + ((size_t)(col0 >> 4) * EP_M + row) * 16 + (col0 & 15) : base + (size_t)row * 512 + col0;
#pragma unroll
                for (int bj = 0; bj < 2; ++bj) { const f32x4 v0 = acc[ai][bj][m][0] * rs, v1 = acc[ai][bj][m][1] * rs;
                    u32x4 w; w.x = cvt_pk_bf16(v0[0], v0[1]); w.y = cvt_pk_bf16(v0[2], v0[3]); w.z = cvt_pk_bf16(v1[0], v1[1]); w.w = cvt_pk_bf16(v1[2], v1[3]);
                    *(u32x4*)(rowp + (t == 0 ? (size_t)bj * 8 * EP_M * 16 : (size_t)bj * HALF)) = w; } }
    }
};
struct EpiGlu {
    static constexpr bool PERM = true, AFTER_DRAIN = false, MIDK = false;
    const bf16_t* GB; bf16_t* MIX; const float* bias; float* ss; int midk_t;
    __device__ __forceinline__ void midk(f32x4 (&)[2][2][4][2], const Unit&, int, int, int, int) const {}
    __device__ __forceinline__ void operator()(const f32x4 (&acc)[2][2][4][2], const Unit& u, int wr, int wc, int fr, int fq) const {
        const int row0 = u.pm * BM + wr * 64 + fr, col0 = u.pn * BM + wc * 32 + 8 * fq;
        f32x4 bv[2][2];
#pragma unroll
        for (int bj = 0; bj < 2; ++bj)
#pragma unroll
            for (int n = 0; n < 2; ++n) bv[bj][n] = *(const f32x4*)(bias + col0 + bj * HALF + 4 * n);
#pragma unroll
        for (int ai = 0; ai < 2; ++ai)
#pragma unroll
            for (int m = 0; m < 4; ++m) { const int row = row0 + ai * HALF + m * 16; float part = 0.f;
#pragma unroll
                for (int bj = 0; bj < 2; ++bj) {
                    const u32x4 gw = *(const u32x4*)(GB + (size_t)row * 512 + col0 + bj * HALF);
                    const f32x4 z0 = acc[ai][bj][m][0] + bv[bj][0], z1 = acc[ai][bj][m][1] + bv[bj][1];
                    float g[8] = {bflo(gw.x), bfhi(gw.x), bflo(gw.y), bfhi(gw.y), bflo(gw.z), bfhi(gw.z), bflo(gw.w), bfhi(gw.w)};
                    float z[8] = {z0[0], z0[1], z0[2], z0[3], z1[0], z1[1], z1[2], z1[3]}; float o[8];
#pragma unroll
                    for (int e = 0; e < 8; ++e) { const float s = __builtin_amdgcn_rcpf(1.0f + __builtin_amdgcn_exp2f(-z[e] * 1.4426950408889634f)); o[e] = g[e] * s; part += o[e] * o[e]; }
                    u32x4 w; w.x = cvt_pk_bf16(o[0], o[1]); w.y = cvt_pk_bf16(o[2], o[3]); w.z = cvt_pk_bf16(o[4], o[5]); w.w = cvt_pk_bf16(o[6], o[7]);
                    *(u32x4*)(MIX + (size_t)row * 1024 + col0 + bj * HALF) = w; }
                part += __shfl_xor(part, 16); part += __shfl_xor(part, 32);
                if (fq == 0) atomicAdd(ss + row, part); }
    }
};
struct EpiOut {
    static constexpr bool PERM = false, AFTER_DRAIN = false, MIDK = true;
    int l; int midk_t; int dup;
    __device__ __forceinline__ void midk(f32x4 (&acc)[2][2][4][2], const Unit& u, int wr, int wc, int fr, int fq) const {
        const float* ss_ssm = ep_ss(4 * l + 1); const float* ss_att = ss_ssm + EP_M;
        const int row0 = u.pm * BM + wr * 64 + fr;
#pragma unroll
        for (int ai = 0; ai < 2; ++ai)
#pragma unroll
            for (int m = 0; m < 4; ++m) { const int row = row0 + ai * HALF + m * 16;
                const float ra = sqrtf((ss_att[row] * (1.0f / 512.0f) + 1e-6f) / (ss_ssm[row] * (1.0f / 512.0f) + 1e-6f));
#pragma unroll
                for (int bj = 0; bj < 2; ++bj)
#pragma unroll
                    for (int n = 0; n < 2; ++n) acc[ai][bj][m][n] *= ra; }
    }
    __device__ __forceinline__ void operator()(const f32x4 (&acc)[2][2][4][2], const Unit& u, int wr, int wc, int fr, int fq) const {
        const float* ss_att = ep_ss(4 * l + 2); float* ss2 = dup ? ep_ss(9) : (float*)ss_att + EP_M; float* out = ep_out(); const float* base = (l == 0) ? ep_x() : (const float*)out; bf16_t* HB = ep_hb();
        if (dup) { out = (float*)(ep_karg<unsigned char>(22) + (98u << 20)); HB = (bf16_t*)(ep_karg<unsigned char>(22) + (194u << 20)); }
        const int row0 = u.pm * BM + wr * 64 + fr, col0 = u.pn * BM + wc * 32 + 4 * fq;
#pragma unroll
        for (int ai = 0; ai < 2; ++ai)
#pragma unroll
            for (int m = 0; m < 4; ++m) { const int row = row0 + ai * HALF + m * 16; const float r2 = rsqrtf(ss_att[row] * (1.0f / 512.0f) + 1e-6f); float part = 0.f;
                const size_t off = (size_t)row * 1024 + col0;
#pragma unroll
                for (int bj = 0; bj < 2; ++bj)
#pragma unroll
                    for (int n = 0; n < 2; ++n) { const f32x4 bs = *(const f32x4*)(base + off + bj * HALF + n * 16); const f32x4 o = bs + acc[ai][bj][m][n] * r2;
                        *(f32x4*)(out + off + bj * HALF + n * 16) = o; part += (o[0] * o[0] + o[1] * o[1]) + (o[2] * o[2] + o[3] * o[3]);
                        u32x2 w; w.x = cvt_pk_bf16(o[0], o[1]); w.y = cvt_pk_bf16(o[2], o[3]); *(u32x2*)(HB + off + bj * HALF + n * 16) = w; }
                part += __shfl_xor(part, 16); part += __shfl_xor(part, 32);
                if (fq == 0) atomicAdd(ss2 + row, part); }
    }
};
struct EpiUp {
    static constexpr bool PERM = true, AFTER_DRAIN = false, MIDK = false;
    bf16_t* O; const float* ss; int midk_t;
    __device__ __forceinline__ void midk(f32x4 (&)[2][2][4][2], const Unit&, int, int, int, int) const {}
    __device__ __forceinline__ void operator()(const f32x4 (&acc)[2][2][4][2], const Unit& u, int wr, int wc, int fr, int fq) const {
        const int row0 = u.pm * BM + wr * 64 + fr, col0 = u.pn * BM + wc * 32 + 8 * fq;
#pragma unroll
        for (int ai = 0; ai < 2; ++ai)
#pragma unroll
            for (int m = 0; m < 4; ++m) { const int row = row0 + ai * HALF + m * 16; const float rs = rsqrtf(ss[row] * (1.0f / 1024.0f) + 1e-6f);
                bf16_t* rowp = O + (size_t)row * 4096 + col0;
#pragma unroll
                for (int bj = 0; bj < 2; ++bj) { f32x4 v0 = acc[ai][bj][m][0] * rs, v1 = acc[ai][bj][m][1] * rs;
#pragma unroll
                    for (int e = 0; e < 4; ++e) { v0[e] = fmaxf(v0[e], 0.f); v0[e] *= v0[e]; v1[e] = fmaxf(v1[e], 0.f); v1[e] *= v1[e]; }
                    u32x4 w; w.x = cvt_pk_bf16(v0[0], v0[1]); w.y = cvt_pk_bf16(v0[2], v0[3]); w.z = cvt_pk_bf16(v1[0], v1[1]); w.w = cvt_pk_bf16(v1[2], v1[3]);
                    *(u32x4*)(rowp + bj * HALF) = w; } }
    }
};
struct EpiDown {
    static constexpr bool PERM = false, AFTER_DRAIN = false, MIDK = false;
    float* h; bf16_t* HB; float* ssn; int midk_t; int dup;
    __device__ __forceinline__ void midk(f32x4 (&)[2][2][4][2], const Unit&, int, int, int, int) const {}
    __device__ __forceinline__ void operator()(const f32x4 (&acc)[2][2][4][2], const Unit& u, int wr, int wc, int fr, int fq) const {
        const int row0 = u.pm * BM + wr * 64 + fr, col0 = u.pn * BM + wc * 32 + 4 * fq;
#pragma unroll
        for (int ai = 0; ai < 2; ++ai)
#pragma unroll
            for (int m = 0; m < 4; ++m) { const int row = row0 + ai * HALF + m * 16; float part = 0.f;
                const size_t off = (size_t)row * 1024 + col0;
#pragma unroll
                for (int bj = 0; bj < 2; ++bj)
#pragma unroll
                    for (int n = 0; n < 2; ++n) { const f32x4 bs = *(const f32x4*)(h + off + bj * HALF + n * 16); const f32x4 o = bs + acc[ai][bj][m][n];
                        if (dup) *(f32x4*)((float*)(ep_karg<unsigned char>(22) + (228u << 20)) + ((off + bj * HALF + n * 16) & 0x3fffffu)) = o; else *(f32x4*)(h + off + bj * HALF + n * 16) = o; part += (o[0] * o[0] + o[1] * o[1]) + (o[2] * o[2] + o[3] * o[3]);
                        u32x2 w; w.x = cvt_pk_bf16(o[0], o[1]); w.y = cvt_pk_bf16(o[2], o[3]); *(u32x2*)(HB + off + bj * HALF + n * 16) = w; }
                part += __shfl_xor(part, 16); part += __shfl_xor(part, 32);
                if (fq == 0) atomicAdd(ssn + row, part); }
    }
};
template <class Epi, class Sched, bool ALIGN_EPI = false, bool SP2 = false>
__device__ __forceinline__ void gemm_phase(PG8_LAS unsigned char* lds, const Gemm g, const Sched& S, const Epi& E) {
    int tid_ = threadIdx.x; asm volatile("" : "+v"(tid_));
    const int tid = tid_, wid = __builtin_amdgcn_readfirstlane(tid >> 6), lane = tid & 63, wr = wid >> 2, wc = wid & 3, fr = lane & 15, fq = lane >> 4;
    const int K = g.K, nt = K / BK;
    unsigned voffA[2], voffB[2];
#pragma unroll
    for (int i = 0; i < 2; ++i) { int R, C; stage_rc(tid * 16 + i * 8192, R, C); const int Rb = Epi::PERM ? ((R & ~31) + perm32(R & 31)) : R;
        voffA[i] = (unsigned)(R * K + C) * 2u; voffB[i] = (unsigned)(Rb * K + C) * 2u; }
    const size_t kstep = (size_t)(BK * 2);
    const size_t hstep = (size_t)HALF * K * 2;
    const size_t tstep = 2 * hstep;
    const unsigned ldsw = (unsigned)wid * 1024u;
    const int aoff = lds_byte(wr * 64 + fr, fq * 8), boff = lds_byte(wc * 32 + fr, fq * 8);
#define PG8_SA(b, h) (((b) * 2 + (h)) * HTB)
#define PG8_SB(b, h) ((4 + (b) * 2 + (h)) * HTB)
#define PG8_STAGE(bufoff, gbase, voff) do { _Pragma("unroll") for (int _i = 0; _i < 2; ++_i) \
        __builtin_amdgcn_global_load_lds((const unsigned*)((const char*)(gbase) + (voff)[_i]), (PG8_LAS unsigned*)(lds + (bufoff) + ldsw + _i * 8192), 16, 0, 0); } while (0)
#define PG8_LDA(dst, b, h) do { _Pragma("unroll") for (int m = 0; m < 4; ++m) _Pragma("unroll") for (int k = 0; k < 2; ++k) dst[m][k] = *(const PG8_LAS bf16x8*)(lds + PG8_SA(b, h) + aoff + m * 2048 + k * 1024); } while (0)
#define PG8_LDB(dst, b, h) do { _Pragma("unroll") for (int n = 0; n < 2; ++n) _Pragma("unroll") for (int k = 0; k < 2; ++k) dst[n][k] = *(const PG8_LAS bf16x8*)(lds + PG8_SB(b, h) + boff + n * 2048 + k * 1024); } while (0)
#define PG8_MMA(ai, bj, At, Bt) do { __builtin_amdgcn_s_setprio(1); _Pragma("unroll") for (int m = 0; m < 4; ++m) _Pragma("unroll") for (int n = 0; n < 2; ++n) _Pragma("unroll") for (int k = 0; k < 2; ++k) \
        acc[ai][bj][m][n] = __builtin_amdgcn_mfma_f32_16x16x32_bf16(Bt[n][k], At[m][k], acc[ai][bj][m][n], 0, 0, 0); __builtin_amdgcn_s_setprio(0); } while (0)
#define PG8_WAIT_V(n) asm volatile("s_waitcnt vmcnt(" #n ")" ::: "memory")
#define PG8_WAIT_L(n) asm volatile("s_waitcnt lgkmcnt(" #n ")" ::: "memory")
#define PG8_BAR __builtin_amdgcn_s_barrier()
#define PG8_SCHED __builtin_amdgcn_sched_barrier(0)
    Unit cur, nxt; int ui = 0;
    if (!S.next(0, cur)) return;
    f32x4 acc[2][2][4][2];
#pragma unroll
    for (int a = 0; a < 2; ++a)
#pragma unroll
        for (int b = 0; b < 2; ++b)
#pragma unroll
            for (int m = 0; m < 4; ++m)
#pragma unroll
                for (int n = 0; n < 2; ++n) acc[a][b][m][n] = (f32x4){0.f, 0.f, 0.f, 0.f};
    bf16x8 At[4][2], B0[2][2], B1[2][2];
    const char* cA = (const char*)g.A + (size_t)cur.pm * tstep; const char* cB = (const char*)g.Bt + (size_t)cur.pn * tstep;
    S.a_ready(cur);
    if constexpr (SP2) {
        PG8_STAGE(PG8_SB(0, 0), cB, voffB); PG8_STAGE(PG8_SB(0, 1), cB + hstep, voffB); PG8_STAGE(PG8_SA(0, 0), cA, voffA); PG8_STAGE(PG8_SA(0, 1), cA + hstep, voffA);
        if (wr == 1) PG8_BAR;
        PG8_WAIT_V(2); PG8_BAR;
        PG8_STAGE(PG8_SB(1, 0), cB + kstep, voffB); PG8_STAGE(PG8_SA(1, 0), cA + kstep, voffA); PG8_STAGE(PG8_SB(1, 1), cB + hstep + kstep, voffB);
        PG8_WAIT_V(6); PG8_BAR;
    } else {
        PG8_STAGE(PG8_SB(0, 0), cB, voffB); PG8_STAGE(PG8_SA(0, 0), cA, voffA); PG8_STAGE(PG8_SB(0, 1), cB + hstep, voffB); PG8_STAGE(PG8_SA(0, 1), cA + hstep, voffA);
        if (wr == 1) PG8_BAR;
        PG8_WAIT_V(4); PG8_BAR;
        PG8_STAGE(PG8_SB(1, 0), cB + kstep, voffB); PG8_STAGE(PG8_SA(1, 0), cA + kstep, voffA); PG8_STAGE(PG8_SB(1, 1), cB + hstep + kstep, voffB);
        PG8_WAIT_V(6); PG8_BAR;
    }
    for (;;) {
        const bool has_next = S.next(ui + 1, nxt);
        const char* nA = has_next ? (const char*)g.A + (size_t)nxt.pm * tstep : cA; const char* nB = has_next ? (const char*)g.Bt + (size_t)nxt.pn * tstep : cB;
        for (int t = 0; t < nt; t += 2) {
            if constexpr (Epi::MIDK) { if (t == E.midk_t) E.midk(acc, cur, wr, wc, fr, fq); }
            const bool last = (t == nt - 2);
            const char* a1 = cA + (size_t)(t + 1) * kstep;
            const char* a2 = last ? nA : cA + (size_t)(t + 2) * kstep; const char* b2 = last ? nB : cB + (size_t)(t + 2) * kstep;
            const char* a3 = a2 + kstep; const char* b3 = b2 + kstep;
            if (last && has_next) S.a_ready(nxt);
            if constexpr (SP2) {
            PG8_LDB(B0, 0, 0); PG8_LDB(B1, 0, 1); PG8_SCHED; PG8_LDA(At, 0, 0); PG8_STAGE(PG8_SA(1, 1), a1 + hstep, voffA);
            PG8_WAIT_V(8); PG8_WAIT_L(0); PG8_BAR; PG8_MMA(0, 0, At, B0); PG8_MMA(0, 1, At, B1); PG8_BAR; PG8_SCHED;
            PG8_LDA(At, 0, 1); PG8_STAGE(PG8_SB(0, 0), b2, voffB); PG8_STAGE(PG8_SB(0, 1), b2 + hstep, voffB); PG8_STAGE(PG8_SA(0, 0), a2, voffA);
            PG8_WAIT_V(8); PG8_WAIT_L(0); PG8_BAR; PG8_MMA(1, 0, At, B0); PG8_MMA(1, 1, At, B1); PG8_BAR; PG8_SCHED;
            PG8_LDB(B0, 1, 0); PG8_LDB(B1, 1, 1); PG8_SCHED; PG8_LDA(At, 1, 0); PG8_STAGE(PG8_SA(0, 1), a2 + hstep, voffA);
            PG8_WAIT_V(8); PG8_WAIT_L(0); PG8_BAR; PG8_MMA(0, 0, At, B0); PG8_MMA(0, 1, At, B1); PG8_BAR; PG8_SCHED;
            PG8_LDA(At, 1, 1); PG8_STAGE(PG8_SB(1, 0), b3, voffB); PG8_STAGE(PG8_SB(1, 1), b3 + hstep, voffB); PG8_STAGE(PG8_SA(1, 0), a3, voffA);
            PG8_WAIT_V(8); PG8_WAIT_L(0); PG8_BAR; PG8_MMA(1, 0, At, B0); PG8_MMA(1, 1, At, B1); PG8_BAR; PG8_SCHED;
            } else {
            PG8_LDB(B0, 0, 0); PG8_SCHED; PG8_LDA(At, 0, 0); PG8_STAGE(PG8_SA(1, 1), a1 + hstep, voffA);
            PG8_WAIT_L(8); PG8_BAR; PG8_WAIT_L(0); PG8_MMA(0, 0, At, B0); PG8_BAR; PG8_SCHED;
            PG8_LDB(B1, 0, 1); PG8_STAGE(PG8_SB(0, 0), b2, voffB);
            PG8_BAR; PG8_WAIT_L(0); PG8_MMA(0, 1, At, B1); PG8_BAR;
            PG8_LDA(At, 0, 1); PG8_STAGE(PG8_SA(0, 0), a2, voffA);
            PG8_BAR; PG8_WAIT_L(0); PG8_MMA(1, 0, At, B0); PG8_BAR; PG8_SCHED;
            PG8_STAGE(PG8_SB(0, 1), b2 + hstep, voffB);
            PG8_WAIT_V(6); PG8_BAR; PG8_MMA(1, 1, At, B1); PG8_BAR;
            PG8_LDB(B0, 1, 0); PG8_SCHED; PG8_LDA(At, 1, 0); PG8_STAGE(PG8_SA(0, 1), a2 + hstep, voffA);
            PG8_WAIT_L(8); PG8_BAR; PG8_WAIT_L(0); PG8_MMA(0, 0, At, B0); PG8_BAR; PG8_SCHED;
            PG8_LDB(B1, 1, 1); PG8_STAGE(PG8_SB(1, 0), b3, voffB);
            PG8_BAR; PG8_WAIT_L(0); PG8_MMA(0, 1, At, B1); PG8_BAR;
            PG8_LDA(At, 1, 1); PG8_STAGE(PG8_SA(1, 0), a3, voffA);
            PG8_BAR; PG8_WAIT_L(0); PG8_MMA(1, 0, At, B0); PG8_BAR; PG8_SCHED;
            PG8_STAGE(PG8_SB(1, 1), b3 + hstep, voffB);
            PG8_WAIT_V(6); PG8_BAR; PG8_MMA(1, 1, At, B1); PG8_BAR;
            }
        }
        if constexpr (ALIGN_EPI) { if (wr == 0) PG8_BAR; }
        if constexpr (!Epi::AFTER_DRAIN) { E(acc, cur, wr, wc, fr, fq); S.done(cur); }
        if (!has_next) break;
#pragma unroll
        for (int a = 0; a < 2; ++a)
#pragma unroll
            for (int b = 0; b < 2; ++b)
#pragma unroll
                for (int m = 0; m < 4; ++m)
#pragma unroll
                    for (int n = 0; n < 2; ++n) acc[a][b][m][n] = (f32x4){0.f, 0.f, 0.f, 0.f};
        cur = nxt; cA = nA; cB = nB; ++ui;
        if constexpr (ALIGN_EPI) { if (wr == 1) PG8_BAR; }
    }
    PG8_WAIT_V(0);
    if constexpr (!ALIGN_EPI) { if (wr == 0) PG8_BAR; }
    PG8_BAR;
    if constexpr (Epi::AFTER_DRAIN) { E.fused(acc, cur, wr, wc, fr, fq, lds, wid, lane); S.done(cur); }
#undef PG8_SA
#undef PG8_SB
#undef PG8_STAGE
#undef PG8_LDA
#undef PG8_LDB
#undef PG8_MMA
#undef PG8_WAIT_V
#undef PG8_WAIT_L
#undef PG8_BAR
#undef PG8_SCHED
}
}

#define GAS __attribute__((address_space(1)))
#define LAS __attribute__((address_space(3)))
typedef unsigned short bf16;
typedef unsigned v4u __attribute__((ext_vector_type(4)));
typedef float f32x4 __attribute__((ext_vector_type(4)));
typedef short bf16x8 __attribute__((ext_vector_type(8)));
typedef GAS unsigned gu32;
typedef GAS unsigned long long gu64;
#define RLX_AGENT __ATOMIC_RELAXED, __HIP_MEMORY_SCOPE_AGENT
#define LDS_WAIT() asm volatile("s_waitcnt lgkmcnt(0)" ::: "memory")
#define VM_WAIT() asm volatile("s_waitcnt vmcnt(0)" ::: "memory")
__device__ __forceinline__ unsigned long long rt() { return __builtin_amdgcn_s_memrealtime(); }
__device__ __forceinline__ unsigned f2bf(float f) { unsigned u = __builtin_bit_cast(unsigned, f); return (u + 0x7fffu + ((u >> 16) & 1u)) >> 16; }
__device__ __forceinline__ unsigned pk2(float lo, float hi) { return f2bf(lo) | (f2bf(hi) << 16); }
#define XB_TMO      128
#define XB_XCNT(j)  (256  + 64 * (j))
#define XB_XSUB(j)  (1280 + 64 * (j))
#define XB_XGEN(j)  (2304 + 64 * (j))
#define XB_TOP      3328
#define XB_TOPGEN   3392
#define XCD_BAR_WORDS 3456
#define XB_SPIN_CAP (1u << 18)

__device__ __forceinline__ unsigned xb_ld(unsigned* p)              { return __hip_atomic_load(p, __ATOMIC_RELAXED, __HIP_MEMORY_SCOPE_AGENT); }
__device__ __forceinline__ unsigned xb_add(unsigned* p, unsigned v) { return __hip_atomic_fetch_add(p, v, __ATOMIC_RELAXED, __HIP_MEMORY_SCOPE_AGENT); }
__device__ __forceinline__ unsigned xb_xcc_id() { return (unsigned)__builtin_amdgcn_s_getreg((3 << 11) | 20) & 0xFu; }
#define XB_SPIN(cond, bar) do { unsigned _sp = 0; while (cond) { __builtin_amdgcn_s_sleep(1); \
    if ((++_sp & 255u) == 0u) { if (xb_ld(&(bar)[XB_TMO])) break; if (_sp > XB_SPIN_CAP) { atomicAdd(&(bar)[XB_TMO], 1u); break; } } } } while (0)

struct XcdBarrier {
    unsigned* bar; unsigned x;
    volatile LAS unsigned* st;
};

__device__ __forceinline__ XcdBarrier xcd_barrier_post(unsigned* bar, volatile LAS unsigned* st) {
    XcdBarrier b; b.bar = bar; b.x = xb_xcc_id(); b.st = st;
    if (threadIdx.x == 0) (void)xb_add(&bar[XB_XCNT(b.x)], 1u);
    return b;
}
__device__ __forceinline__ void xcd_barrier_complete(unsigned* bar, unsigned x, unsigned& nloc, unsigned& nx) {
    const unsigned G = gridDim.x * gridDim.y * gridDim.z;
    unsigned sum, cnt, mine, sp = 0u;
    for (;;) {
        sum = 0u; cnt = 0u; mine = 0u;
#pragma unroll
        for (unsigned j = 0; j < 16; ++j) { const unsigned c = xb_ld(&bar[XB_XCNT(j)]); sum += c; cnt += (c > 0u) ? 1u : 0u; mine = (j == x) ? c : mine; }
        if (sum == G) break;
        __builtin_amdgcn_s_sleep(1);
        if ((++sp & 255u) == 0u) { if (xb_ld(&bar[XB_TMO])) break; if (sp > XB_SPIN_CAP) { atomicAdd(&bar[XB_TMO], 1u); break; } }
    }
    nloc = mine > 0u ? mine : 1u; nx = cnt > 0u ? cnt : 1u;
}

__device__ __forceinline__ void xcd_barrier(const XcdBarrier& b) {
    asm volatile("s_waitcnt vmcnt(0)" ::: "memory");
    __syncthreads();
    if (threadIdx.x == 0) {
        unsigned* bar = b.bar; unsigned bx = b.x; asm volatile("" : "+s"(bar), "+s"(bx));
        __builtin_amdgcn_s_waitcnt(0);
        unsigned nloc = b.st[0], nx = b.st[1];
        if (nloc == 0u) { xcd_barrier_complete(bar, bx, nloc, nx); b.st[0] = nloc; b.st[1] = nx; }
        const unsigned old = xb_add(&bar[XB_XSUB(bx)], 1u);
        const unsigned gen = old / nloc;
        if (old + 1u == (gen + 1u) * nloc) {
            __builtin_amdgcn_fence(__ATOMIC_RELEASE, "agent");
            asm volatile("s_waitcnt vmcnt(0)" ::: "memory");
            const unsigned og = xb_add(&bar[XB_TOP], 1u);
            const unsigned tg = og / nx;
            if (og + 1u == (tg + 1u) * nx) xb_add(&bar[XB_TOPGEN], 1u);
            else XB_SPIN(xb_ld(&bar[XB_TOPGEN]) == tg, bar);
            __builtin_amdgcn_fence(__ATOMIC_ACQUIRE, "agent");
            xb_add(&bar[XB_XGEN(bx)], 1u);
            asm volatile("s_waitcnt vmcnt(0)" ::: "memory");
        } else {
            XB_SPIN(xb_ld(&bar[XB_XGEN(bx)]) == gen, bar);
            __builtin_amdgcn_fence(__ATOMIC_ACQUIRE, "agent");
            asm volatile("s_waitcnt vmcnt(0)" ::: "memory");
        }
    }
    __syncthreads();
}
#include <hip/hip_bf16.h>
#include <cmath>
namespace attn_body {
using bf16=__hip_bfloat16;
using bf16x8=__attribute__((ext_vector_type(8)))short;
using s16x4=__attribute__((ext_vector_type(4)))short;
using f32x16=__attribute__((ext_vector_type(16)))float;
using u32x4=__attribute__((ext_vector_type(4)))unsigned;
constexpr int BATCH=4,NHEAD=8,SEQ=4096,D=64,DM=NHEAD*D,OPITCH=1024;
constexpr int NW=8,QBLK=32,QB=QBLK*NW,KVBLK=64,NQB=SEQ/QB;
constexpr int ATTN_PITCH=DM, ATTN_UNIT_ROWS=QB;
__device__ __forceinline__ int crow(int r,int hi){return (r&3)+8*(r>>2)+4*hi;}
#define SBAR() __builtin_amdgcn_sched_barrier(0)
__device__ __forceinline__ void cmask(f32x16&p0,f32x16&p1,int jb,int qrel,int hi){
  const float NEG=-INFINITY; int kb=64*jb+4*hi;
  #pragma unroll
  for(int r=0;r<16;++r){int kv=kb+(r&3)+8*(r>>2); if(kv>qrel)p0[r]=NEG; if(kv+32>qrel)p1[r]=NEG;}
}

constexpr int NSLOT=3, SLOTB=9216;
constexpr int LDS_K=0, LDS_V=NSLOT*SLOTB, LDS_WS=2*NSLOT*SLOTB, LDS_OST=LDS_WS+NW*64*4, LDS_OFFT=LDS_OST+NW*4096, LDS_BYTES=LDS_OFFT+256;
constexpr float C2=0.125f*1.4426950408889634f;
__device__ __forceinline__ void glds16(const void*gsrc,unsigned lds_dst){unsigned keep;
  asm volatile("s_mov_b32 %0, m0\n\ts_mov_b32 m0, %2\n\ts_nop 0\n\tglobal_load_lds_dwordx4 %1, off\n\ts_mov_b32 m0, %0":"=&s"(keep):"v"(gsrc),"s"(lds_dst):"memory");}
__device__ __forceinline__ float max3f(float a,float b,float c){float r;asm("v_max3_f32 %0, %1, %2, %3":"=v"(r):"v"(a),"v"(b),"v"(c));return r;}
__device__ __forceinline__ float max2f(float a,float b){float r;asm("v_max_f32_e32 %0, %1, %2":"=v"(r):"v"(a),"v"(b));return r;}
__device__ __forceinline__ float fadd_s(float a,float b){float r;asm("v_add_f32_e32 %0, %1, %2":"=v"(r):"v"(a),"v"(b));return r;}
__device__ __forceinline__ float fsub_s(float a,float b){float r;asm("v_sub_f32_e32 %0, %1, %2":"=v"(r):"v"(a),"v"(b));return r;}
typedef float f32x2_t __attribute__((ext_vector_type(2))); typedef __bf16 bf16x2_t __attribute__((ext_vector_type(2)));
__device__ __forceinline__ unsigned cvtpk_s(float lo,float hi){f32x2_t v={lo,hi};bf16x2_t b=__builtin_convertvector(v,bf16x2_t);return __builtin_bit_cast(unsigned,b);}
#define WAIT_BAR_(N) asm volatile("s_waitcnt vmcnt(" #N ") lgkmcnt(0)\n\ts_barrier":::"memory")
#define WAIT_BAR(N,N0) do{ if(wid==0){WAIT_BAR_(N0);}else{WAIT_BAR_(N);} }while(0)
__device__ __forceinline__ bf16x8 mk_qaug(float x,unsigned himask){
  const unsigned w1=cvtpk_s(1.0f,x); const float r1=x-__uint_as_float(w1&0xffff0000u);
  const unsigned t=cvtpk_s(r1,0.f); const float r2=r1-__uint_as_float(t<<16); const unsigned w2=cvtpk_s(r1,r2);
  u32x4 w; w.x=0x3F803F80u&himask; w.y=w1&himask; w.z=w2&himask; w.w=0u; return __builtin_bit_cast(bf16x8,w);}

__device__ __forceinline__ void qkt(f32x16&p0,f32x16&p1,const char*Kslot,const bf16x8*qr,bf16x8 qa,int r32,int hi){
  const char*kb=Kslot+hi*1024+r32*16; const char*ka=Kslot+8192+r32*16;
  { const bf16x8 a0=*reinterpret_cast<const bf16x8*>(ka), a1=*reinterpret_cast<const bf16x8*>(ka+512); const f32x16 z=f32x16{};
    p0=__builtin_amdgcn_mfma_f32_32x32x16_bf16(a0,qa,z,0,0,0); p1=__builtin_amdgcn_mfma_f32_32x32x16_bf16(a1,qa,z,0,0,0); }
  #pragma unroll
  for(int d0=0;d0<4;++d0){
    const bf16x8 b0=*reinterpret_cast<const bf16x8*>(kb+d0*2048);
    const bf16x8 b1=*reinterpret_cast<const bf16x8*>(kb+d0*2048+512);
    {p0=__builtin_amdgcn_mfma_f32_32x32x16_bf16(b0,qr[d0],p0,0,0,0);p1=__builtin_amdgcn_mfma_f32_32x32x16_bf16(b1,qr[d0],p1,0,0,0);}}
}
typedef __attribute__((address_space(3))) const char* lds_cptr;
typedef short v4i16_t __attribute__((ext_vector_type(4)));
__device__ __forceinline__ void kload8(bf16x8*kf,lds_cptr kp){
  kf[0]=*(const __attribute__((address_space(3))) bf16x8*)(kp);      kf[1]=*(const __attribute__((address_space(3))) bf16x8*)(kp+512);
  kf[2]=*(const __attribute__((address_space(3))) bf16x8*)(kp+2048); kf[3]=*(const __attribute__((address_space(3))) bf16x8*)(kp+2560);
  kf[4]=*(const __attribute__((address_space(3))) bf16x8*)(kp+4096); kf[5]=*(const __attribute__((address_space(3))) bf16x8*)(kp+4608);
  kf[6]=*(const __attribute__((address_space(3))) bf16x8*)(kp+6144); kf[7]=*(const __attribute__((address_space(3))) bf16x8*)(kp+6656);
}
__device__ __forceinline__ void kloada(bf16x8*kf,lds_cptr kpa){ kf[8]=*(const __attribute__((address_space(3))) bf16x8*)(kpa); kf[9]=*(const __attribute__((address_space(3))) bf16x8*)(kpa+512); }
__device__ __forceinline__ void kload2(bf16x8*kf,lds_cptr kp,int j){ kf[2*j]=*(const __attribute__((address_space(3))) bf16x8*)(kp+j*2048); kf[2*j+1]=*(const __attribute__((address_space(3))) bf16x8*)(kp+j*2048+512); }
__device__ __forceinline__ s16x4 vtr(lds_cptr p){ return __builtin_bit_cast(s16x4,__builtin_amdgcn_ds_read_tr16_b64_v4i16((__attribute__((address_space(3))) v4i16_t*)p)); }
__device__ __forceinline__ float rowmax(const f32x16&p0,const f32x16&p1){
  float a=max3f(p0[0],p0[1],p1[0]),b=max3f(p0[2],p0[3],p1[1]);a=max3f(a,p1[2],p1[3]);
  #pragma unroll
  for(int r=4;r<16;r+=4){a=max3f(a,p0[r],p0[r+1]);b=max3f(b,p0[r+2],p0[r+3]);a=max3f(a,p1[r],p1[r+1]);b=max3f(b,p1[r+2],p1[r+3]);}
  const float m=max2f(a,b);
  auto rr=__builtin_amdgcn_permlane32_swap(__float_as_uint(m),__float_as_uint(m),false,false);
  return max2f(__uint_as_float(rr[0]),__uint_as_float(rr[1]));
}
__device__ __forceinline__ void pv(f32x16*o,int vb,bf16x8 pa0,bf16x8 pa1,bf16x8 pa2,bf16x8 pa3){
  #pragma unroll
  for(int d0=0;d0<2;++d0){s16x4 lo[4],hi[4];
    #pragma unroll
    for(int ks=0;ks<4;++ks){
      asm volatile("ds_read_b64_tr_b16 %0,%1 offset:%c2":"=&v"(lo[ks]):"v"(vb),"i"(d0*4096+ks*1024):"memory");
      asm volatile("ds_read_b64_tr_b16 %0,%1 offset:%c2":"=&v"(hi[ks]):"v"(vb),"i"(d0*4096+ks*1024+512):"memory");}
    asm volatile("s_waitcnt lgkmcnt(0)":::"memory");SBAR();
    #define PK(k) (bf16x8){lo[k][0],lo[k][1],lo[k][2],lo[k][3],hi[k][0],hi[k][1],hi[k][2],hi[k][3]}
    o[d0]=__builtin_amdgcn_mfma_f32_32x32x16_bf16(pa0,PK(0),o[d0],0,0,0);
    o[d0]=__builtin_amdgcn_mfma_f32_32x32x16_bf16(pa1,PK(1),o[d0],0,0,0);
    o[d0]=__builtin_amdgcn_mfma_f32_32x32x16_bf16(pa2,PK(2),o[d0],0,0,0);
    o[d0]=__builtin_amdgcn_mfma_f32_32x32x16_bf16(pa3,PK(3),o[d0],0,0,0);
    #undef PK
  }
}

#ifndef ATTN_STORE16
#define ATTN_STORE16(p,v) (*(u32x4*)(p)=(v))
#endif
template<int THRL> __device__ __forceinline__ void attn_unit(int b,int h,int qb,const bf16*Q,const bf16*__restrict__ K,const bf16*__restrict__ V,const bf16*__restrict__ KAUG,const float*CSL,const float*CST,bf16*O,float*ssq,char*shm){
  int tid_=threadIdx.x; asm volatile("":"+v"(tid_));
  const int tid=tid_,lane=tid&63,r32=lane&31,hi=lane>>5; const int wid=__builtin_amdgcn_readfirstlane(tid>>6);
  const long rowbase=(long)b*SEQ; const int q0=qb*QB; const int bh=b*NHEAD+h;
  const bf16*Qw=Q+(rowbase+q0+wid*QBLK)*DM+h*D;
  const bf16*Kh=K+rowbase*DM+h*D,*Vh=V+rowbase*DM+h*D;
  const unsigned lds0=(unsigned)(uintptr_t)shm;
  float*wsf=(float*)(shm+LDS_WS)+wid*64;
  const bf16*ksrc=Kh+(long)lane*DM+wid*8;
  const bf16*vsrc=Vh+(long)(16*(wid&3)+(lane>>2))*DM+(wid>>2)*32+(lane&3)*8;
  const unsigned kdst=lds0+LDS_K+wid*1024, vdst=lds0+LDS_V+wid*1024, kadst=lds0+LDS_K+8192;
  const bf16*kasrc=KAUG+((long)bh*SEQ+lane)*8;
  __attribute__((address_space(3))) float*offt=(__attribute__((address_space(3))) float*)((__attribute__((address_space(3))) char*)shm+LDS_OFFT);
  if(wid==0){ const float v=CST[(long)bh*64+lane]; float inc=v;
    _Pragma("unroll") for(int o_=1;o_<64;o_<<=1){ const float t_=__shfl_up(inc,o_); if(lane>=o_)inc+=t_; }
    offt[lane]=inc-v; }
  const unsigned himask=hi?0u:0xffffffffu;
  #define DMA_K(t,slot) do{ glds16(ksrc+(long)(t)*KVBLK*DM,(unsigned)__builtin_amdgcn_readfirstlane(kdst+(slot))); if(wid==0)glds16(kasrc+(long)(t)*KVBLK*8,(unsigned)__builtin_amdgcn_readfirstlane(kadst+(slot))); }while(0)
  #define DMA_V(t,slot) glds16(vsrc+(long)(t)*KVBLK*DM,(unsigned)__builtin_amdgcn_readfirstlane(vdst+(slot)))
  const int vb0=(int)(lds0+LDS_V)+((lane>>4)&1)*32+(lane&3)*8+(4*hi+((lane&15)>>2))*64;
  const char*Kbase=shm+LDS_K; bf16x8 kf[10];
  const lds_cptr shm3=(lds_cptr)shm; const lds_cptr kp0=shm3+LDS_K+hi*1024+r32*16; const lds_cptr kpa=shm3+LDS_K+8192+r32*16; const lds_cptr vp0=shm3+LDS_V+((lane>>4)&1)*32+(lane&3)*8+(4*hi+((lane&15)>>2))*64;
  const int NT=(q0+QB)/KVBLK;
  DMA_K(0,0);DMA_V(0,0);DMA_K(1,SLOTB);
  bf16x8 qr[4];
  #pragma unroll
  for(int d0=0;d0<4;++d0)qr[d0]=*reinterpret_cast<const bf16x8*>(&Qw[(long)r32*DM+d0*16+hi*8]);
  const float csl_i=CSL[(long)bh*SEQ+q0+wid*QBLK+r32];
  float cm=0.f,l_reg=0.f;f32x16 o[2];o[0]=f32x16{};o[1]=f32x16{};
  const int qrel=wid*QBLK+r32;
  #define CMASK(P0,P1,t) do{int jb_=(t)-(NT-4); if(jb_>=0)cmask(P0,P1,jb_,qrel,hi);}while(0)
  bool resc=false;
  #define START(P0,P1) do{ const float rm=rowmax(P0,P1); resc=false; \
    { const float dl=rm; cm=fsub_s(cm,dl); \
      _Pragma("unroll") for(int r=0;r<16;++r){P0[r]=fsub_s(P0[r],dl);P1[r]=fsub_s(P1[r],dl);} } \
    _Pragma("unroll") for(int r=0;r<16;++r)P0[r]=__builtin_amdgcn_exp2f(P0[r]); }while(0)
  #define RESC() do{ if(resc){ asm volatile("s_waitcnt lgkmcnt(0)":::"memory"); \
      _Pragma("unroll") for(int d_=0;d_<2;++d_) _Pragma("unroll") for(int r=0;r<16;++r)o[d_][r]*=wsf[crow(r,hi)]; } }while(0)
  f32x16 pA0,pA1,pB0,pB1;
  int sl_prev=0,sl_cur=0,sl_next=SLOTB;
  #define ROT() do{sl_prev=sl_cur;sl_cur=sl_next;sl_next=(sl_next==(NSLOT-1)*SLOTB)?0:sl_next+SLOTB;}while(0)
  DMA_K(2,2*SLOTB);
  WAIT_BAR(3,5);
  cm=csl_i+offt[(q0+wid*QBLK)>>6];
  qkt(pA0,pA1,Kbase,qr,mk_qaug(cm,himask),r32,hi);asm volatile("s_nop 15\n\ts_nop 7":"+v"(pA0),"+v"(pA1));CMASK(pA0,pA1,0);
  START(pA0,pA1);
  _Pragma("unroll") for(int r=0;r<16;++r)pA1[r]=__builtin_amdgcn_exp2f(pA1[r]);
  WAIT_BAR(0,0);
  DMA_K(3,0);DMA_V(1,SLOTB);
  ROT();
  kload8(kf,kp0+sl_cur); kloada(kf,kpa+sl_cur);
  WAIT_BAR(2,3);
  s16x4 vlo[8],vhi[8]; u32x4 pw0,pw1,pw2,pw3;
  #define PKW(P,B) cvtpk_s(P[B],P[B+1])
  #define PAF(k) __builtin_bit_cast(bf16x8,pw##k)
  #define VFR(i) (bf16x8){vlo[i][0],vlo[i][1],vlo[i][2],vlo[i][3],vhi[i][0],vhi[i][1],vhi[i][2],vhi[i][3]}
  #define PIN(x) asm volatile("":"+v"(x))
  #define MX3(a,b,c) __builtin_fmaxf(__builtin_fmaxf((a),(b)),(c))
  #define GAPA(MF,A0,A1,A2,A3,W0,W1,PW) do{ MF; sacc+=A0; sacc+=A1; sacc+=A2; sacc+=A3; PIN(sacc); W0; W1; PIN(PW); SBAR(); }while(0)
  #define EX(v) __builtin_amdgcn_exp2f(v)
  #define GAPB(MF,X,B) do{ MF; X[B]=EX(X[B]); X[B+1]=EX(X[B+1]); X[B+2]=EX(X[B+2]); X[B+3]=EX(X[B+3]); PIN(X); SBAR(); }while(0)
  #define VRD(i) do{ vlo[i]=vtr(vp_+(((i)>>2)*4096+((i)&3)*1024)); vhi[i]=vtr(vp_+(((i)>>2)*4096+((i)&3)*1024+512)); }while(0)
  #define KRD(G,j) do{ if(G){ kload2(kf,kp0+sl_next,j); SBAR(); } }while(0)
  #define KRDA(G) do{ if(G){ kloada(kf,kpa+sl_next); SBAR(); } }while(0)
  #define STEP(C0,C1,P0,P1,t,GK,GV,GL) do{ SBAR(); \
    const lds_cptr vp_=vp0+sl_prev; \
    { const bf16x8 qa_=mk_qaug(cm-offt[t],himask); const f32x16 z_=f32x16{}; SBAR(); \
      C0=__builtin_amdgcn_mfma_f32_32x32x16_bf16(kf[8],qa_,z_,0,0,0); SBAR(); C1=__builtin_amdgcn_mfma_f32_32x32x16_bf16(kf[9],qa_,z_,0,0,0); SBAR(); } \
    VRD(0); SBAR(); float sacc=(P0[0]+P0[1]); \
    GAPA(C0=__builtin_amdgcn_mfma_f32_32x32x16_bf16(kf[0],qr[0],C0,0,0,0), P0[2],P0[3],P0[4],P0[5],     pw0[0]=PKW(P0,0), pw0[1]=PKW(P0,2), pw0); \
    VRD(4); SBAR(); GAPA(C1=__builtin_amdgcn_mfma_f32_32x32x16_bf16(kf[1],qr[0],C1,0,0,0), P0[6],P0[7],P0[8],P0[9],     pw0[2]=PKW(P0,4), pw0[3]=PKW(P0,6), pw0); \
    VRD(1); SBAR(); GAPA(C0=__builtin_amdgcn_mfma_f32_32x32x16_bf16(kf[2],qr[1],C0,0,0,0),   P0[10],P0[11],P0[12],P0[13], pw1[0]=PKW(P0,8), pw1[1]=PKW(P0,10), pw1); \
    VRD(5); SBAR(); GAPA(C1=__builtin_amdgcn_mfma_f32_32x32x16_bf16(kf[3],qr[1],C1,0,0,0),   P0[14],P0[15],P1[0],P1[1],   pw1[2]=PKW(P0,12),pw1[3]=PKW(P0,14), pw1); \
    VRD(2); SBAR(); GAPA(C0=__builtin_amdgcn_mfma_f32_32x32x16_bf16(kf[4],qr[2],C0,0,0,0),   P1[2],P1[3],P1[4],P1[5],     pw2[0]=PKW(P1,0), pw2[1]=PKW(P1,2), pw2); \
    VRD(6); SBAR(); GAPA(C1=__builtin_amdgcn_mfma_f32_32x32x16_bf16(kf[5],qr[2],C1,0,0,0),   P1[6],P1[7],P1[8],P1[9],     pw2[2]=PKW(P1,4), pw2[3]=PKW(P1,6), pw2); \
    VRD(3); SBAR(); GAPA(C0=__builtin_amdgcn_mfma_f32_32x32x16_bf16(kf[6],qr[3],C0,0,0,0),   P1[10],P1[11],P1[12],P1[13], pw3[0]=PKW(P1,8), pw3[1]=PKW(P1,10), pw3); \
    VRD(7); SBAR(); GAPA(C1=__builtin_amdgcn_mfma_f32_32x32x16_bf16(kf[7],qr[3],C1,0,0,0),   P1[14],P1[15],0.f,0.f,       pw3[2]=PKW(P1,12),pw3[3]=PKW(P1,14), pw3); \
    l_reg+=sacc; \
    if(GK){DMA_K((t)+3,sl_cur);} if(GV){DMA_V((t)+1,sl_next);} \
    CMASK(C0,C1,t); \
    { float a=MX3(C0[0],C0[1],C1[0]),b=MX3(C0[2],C0[3],C1[1]); a=MX3(a,C1[2],C1[3]); \
      _Pragma("unroll") for(int r=4;r<16;r+=4){a=MX3(a,C0[r],C0[r+1]);b=MX3(b,C0[r+2],C0[r+3]);a=MX3(a,C1[r],C1[r+1]);b=MX3(b,C1[r+2],C1[r+3]);} \
      float rm=__builtin_fmaxf(a,b); { auto rr=__builtin_amdgcn_permlane32_swap(__float_as_uint(rm),__float_as_uint(rm),false,false); rm=__builtin_fmaxf(__uint_as_float(rr[0]),__uint_as_float(rr[1])); } \
      resc=false; \
      if(__builtin_expect(__any(rm>(float)THRL),0)){ const float dl=__builtin_fmaxf(rm,0.f); cm-=dl; \
        _Pragma("unroll") for(int r=0;r<16;++r){C0[r]-=dl;C1[r]-=dl;} \
        const float f=__builtin_amdgcn_exp2f(-dl); l_reg*=f; if(hi==0)wsf[r32]=f; resc=true; } } \
    SBAR(); \
    GAPB(o[0]=__builtin_amdgcn_mfma_f32_32x32x16_bf16(PAF(0),VFR(0),o[0],0,0,0), C0,0); \
    GAPB(o[1]=__builtin_amdgcn_mfma_f32_32x32x16_bf16(PAF(0),VFR(4),o[1],0,0,0), C0,4); \
    KRD(GL,0); GAPB(o[0]=__builtin_amdgcn_mfma_f32_32x32x16_bf16(PAF(1),VFR(1),o[0],0,0,0), C0,8); \
    KRD(GL,1); GAPB(o[1]=__builtin_amdgcn_mfma_f32_32x32x16_bf16(PAF(1),VFR(5),o[1],0,0,0), C0,12); \
    KRD(GL,2); GAPB(o[0]=__builtin_amdgcn_mfma_f32_32x32x16_bf16(PAF(2),VFR(2),o[0],0,0,0), C1,0); \
    KRD(GL,3); GAPB(o[1]=__builtin_amdgcn_mfma_f32_32x32x16_bf16(PAF(2),VFR(6),o[1],0,0,0), C1,4); \
    KRDA(GL); GAPB(o[0]=__builtin_amdgcn_mfma_f32_32x32x16_bf16(PAF(3),VFR(3),o[0],0,0,0), C1,8); \
    GAPB(o[1]=__builtin_amdgcn_mfma_f32_32x32x16_bf16(PAF(3),VFR(7),o[1],0,0,0), C1,12); \
    }while(0)
  int t=1;
  #undef CMASK
  #define CMASK(P0,P1,t) do{}while(0)
  for(;t+5<NT;t+=2){
    STEP(pB0,pB1,pA0,pA1,t,true,true,true);     WAIT_BAR(2,3); RESC(); ROT();
    STEP(pA0,pA1,pB0,pB1,t+1,true,true,true);   WAIT_BAR(2,3); RESC(); ROT();
  }
  #undef CMASK
  #define CMASK(P0,P1,t) do{int jb_=(t)-(NT-4); if(jb_>=0)cmask(P0,P1,jb_,qrel,hi);}while(0)
  #define ENDW(tt) do{ if((tt)+3<NT){WAIT_BAR(2,3);} else if((tt)+2<NT){WAIT_BAR(1,1);} else {WAIT_BAR(0,0);} }while(0)
  for(;t+1<NT;t+=2){
    STEP(pB0,pB1,pA0,pA1,t,(t+3<NT),(t+1<NT),(t+1<NT));       ENDW(t);   RESC(); ROT();
    STEP(pA0,pA1,pB0,pB1,t+1,(t+4<NT),(t+2<NT),(t+2<NT));     ENDW(t+1); RESC(); ROT();
  }
  STEP(pB0,pB1,pA0,pA1,NT-1,false,false,false); RESC();
  { float sacc=pB0[0]+pB0[1]; _Pragma("unroll") for(int r=2;r<16;++r)sacc+=pB0[r]; _Pragma("unroll") for(int r=0;r<16;++r)sacc+=pB1[r]; l_reg+=sacc;
    pw0=(u32x4){PKW(pB0,0),PKW(pB0,2),PKW(pB0,4),PKW(pB0,6)};pw1=(u32x4){PKW(pB0,8),PKW(pB0,10),PKW(pB0,12),PKW(pB0,14)};pw2=(u32x4){PKW(pB1,0),PKW(pB1,2),PKW(pB1,4),PKW(pB1,6)};pw3=(u32x4){PKW(pB1,8),PKW(pB1,10),PKW(pB1,12),PKW(pB1,14)};
    SBAR(); pv(o,vb0+sl_cur,PAF(0),PAF(1),PAF(2),PAF(3)); }
  #undef PKW
  #undef PAF
  #undef VFR
  #undef PIN
  #undef MX3
  #undef GAPA
  #undef GAPB
  #undef EX
  #undef VRD
  #undef KRD
  #undef KRDA
  #undef STEP
  #undef ENDW
  {auto rr=__builtin_amdgcn_permlane32_swap(__float_as_uint(l_reg),__float_as_uint(l_reg),false,false);l_reg=__uint_as_float(rr[0])+__uint_as_float(rr[1]);}
  if(hi==0)wsf[32+r32]=l_reg;asm volatile("s_waitcnt lgkmcnt(0)":::"memory");
  float rli[16];
  #pragma unroll
  for(int r=0;r<16;++r)rli[r]=__builtin_amdgcn_rcpf(wsf[32+crow(r,hi)]);
  bf16*Ow=O+(rowbase+q0+wid*QBLK)*OPITCH+h*D; float*ssw=ssq+rowbase+q0+wid*QBLK;
  { bf16*stg=(bf16*)(shm+LDS_OST)+wid*2048;
    #pragma unroll
    for(int r=0;r<16;++r){const int orow=crow(r,hi);
      #pragma unroll
      for(int d0=0;d0<2;++d0)stg[orow*64+d0*32+r32]=__float2bfloat16(o[d0][r]*rli[r]);}
    asm volatile("s_waitcnt lgkmcnt(0)":::"memory");
    #pragma unroll
    for(int i=0;i<4;++i){const int row=i*8+(lane>>3),ch=lane&7; const u32x4 v=*(const u32x4*)(stg+row*64+ch*8); ATTN_STORE16(Ow+(long)row*OPITCH+ch*8,v);
      float sq=0.f;
      _Pragma("unroll") for(int e=0;e<4;++e){ const float a_=__uint_as_float(v[e]<<16), b_=__uint_as_float(v[e]&0xffff0000u); sq+=a_*a_+b_*b_; }
      sq+=__shfl_xor(sq,1); sq+=__shfl_xor(sq,2); sq+=__shfl_xor(sq,4); if(ch==0)atomicAdd(ssw+row,sq); } }
  asm volatile("s_waitcnt lgkmcnt(0)\n\ts_barrier":::"memory");
  #undef DMA_K
  #undef DMA_V
  #undef CMASK
  #undef START
  #undef RESC
  #undef ROT
}
constexpr int ATTN_LDS_BYTES=LDS_BYTES;
struct AttnTensors { const bf16* Q; const bf16* K; const bf16* V; const bf16* KAUG; const float* CSL; const float* CST; bf16* O; float* ssq; };
struct AttnUnit { int bh; int qb; };
struct StaticOrder {
  int vcu, G;
  __device__ __forceinline__ explicit StaticOrder(int grid,int block):vcu((grid%8==0)?(block%8)*(grid/8)+block/8:block),G(grid){}
  __device__ __forceinline__ bool next(int i,AttnUnit&u)const{ const int j=vcu+i*G; if(j>=512)return false; const int s=j&7; u.bh=(j&255)>>3; u.qb=(j<256)?15-s:s; return true; }
  __device__ __forceinline__ void a_ready(const AttnUnit&)const{}
  __device__ __forceinline__ void done(const AttnUnit&)const{}
};
template<class Sched,int THRL=16> __device__ __forceinline__ void attn_phase(char*lds,const AttnTensors&T,const Sched&S){
  AttnUnit u;
  for(int i=0;S.next(i,u);++i){ S.a_ready(u); attn_unit<THRL>(u.bh/NHEAD,u.bh%NHEAD,u.qb,T.Q,T.K,T.V,T.KAUG,T.CSL,T.CST,T.O,T.ssq,lds); S.done(u); }
}
#undef SBAR
#undef WAIT_BAR
#undef WAIT_BAR_
}

constexpr size_t MiB = 1u << 20;
constexpr size_t WS_CTL = 0, CTL_ZERO_BYTES = 256 * 1024;
constexpr size_t WS_SS = 1 * MiB;
constexpr size_t WS_CST = 1 * MiB + 640 * 1024;
constexpr size_t WS_CSL = 2 * MiB;
constexpr size_t WS_WF = 3 * MiB;
constexpr size_t WS_SPA = 3 * MiB + 64 * 1024;
constexpr size_t WS_SPB = 3 * MiB + 128 * 1024;
constexpr size_t WS_SA16 = 3 * MiB + 704 * 1024;
constexpr size_t WS_WIN = 4 * MiB, WS_WOUT = 12 * MiB, WS_WUP = 16 * MiB, WS_WDN = 32 * MiB, WS_WGLU = 48 * MiB;
constexpr size_t WS_SSMM = 49 * MiB;
constexpr size_t WS_HB = 66 * MiB;
constexpr size_t WS_U = 98 * MiB, WS_Q = 114 * MiB, WS_K = 130 * MiB, WS_V = 146 * MiB;
constexpr size_t WS_MIX = 162 * MiB;
constexpr size_t WS_GB = 194 * MiB;
constexpr size_t WS_ST = 210 * MiB;
constexpr size_t WS_HID = 98 * MiB;
constexpr size_t WS_KAUG = 226 * MiB;
constexpr size_t WS_END = 228 * MiB;
static_assert(WS_SS == (1u << 20) && WS_HB == (66u << 20) && MROWS == pg8::EP_M, "epilogue helper constants");
constexpr int CW_Q = 8192;
constexpr int CW_BAR = 4096;

constexpr int RING_OFF = 0, RING_BYTES = 131072;
constexpr int LDSCTL_OFF = RING_BYTES, MISC_OFF = LDSCTL_OFF + 320;
constexpr int LDS_BYTES = 147456;
constexpr int NWAVES = 8;
constexpr bool USE_NAIVE_ATTN = false, USE_NAIVE_SSM = false;
#ifndef REP_P1
#define REP_P1 1
#endif
#ifndef REP_SSM
#define REP_SSM 1
#endif
#ifndef REP_ATT
#define REP_ATT 1
#endif
#ifndef REP_GLU
#define REP_GLU 1
#endif
#ifndef REP_UP
#define REP_UP 1
#endif
#ifndef REP_OUT
#define REP_OUT 1
#endif
#ifndef REP_DN
#define REP_DN 1
#endif
#ifndef REP_SYNC
#define REP_SYNC 0
#endif
#ifndef REP_PRO
#define REP_PRO 1
#endif
static_assert(attn_body::LDS_BYTES <= RING_BYTES, "attention LDS");
#ifndef DBG_STOP_V
#define DBG_STOP_V 99
#endif
constexpr int DBG_STOP = DBG_STOP_V;

struct Frame {
    LAS unsigned char* lds;
    volatile LAS unsigned* MISC;
    int tid, lane, wave, vcu, G;
};
typedef __attribute__((address_space(4))) const unsigned char* kptr_t;
template <class T> __device__ __forceinline__ T* karg(int i) {
    kptr_t p = (kptr_t)__builtin_amdgcn_kernarg_segment_ptr(); asm volatile("" : "+s"(p));
    return *(T* const __attribute__((address_space(4)))*)(p + 8 * i);
}
__device__ __forceinline__ int opaque_s(int x) { asm volatile("" : "+s"(x)); return x; }
__device__ __forceinline__ int opaque_v(int x) { asm volatile("" : "+v"(x)); return x; }
__device__ __forceinline__ int GRIDG_() { return opaque_s((int)gridDim.x); }
__device__ __forceinline__ int BLK_() { return opaque_s((int)blockIdx.x); }
#define KIN(i) karg<const float>(i)
#define KOUT() karg<float>(21)
#define KWS() karg<unsigned char>(22)
extern __shared__ __attribute__((aligned(16))) unsigned char g_lds[];
__device__ __forceinline__ Frame mk_frame() {
    Frame F;
    F.lds = (LAS unsigned char*)g_lds; F.MISC = (volatile LAS unsigned*)(F.lds + MISC_OFF);
    F.tid = opaque_v((int)threadIdx.x); F.lane = F.tid & 63; F.wave = __builtin_amdgcn_readfirstlane(F.tid >> 6);
    F.G = opaque_s((int)gridDim.x); { const int bx = opaque_s((int)blockIdx.x); F.vcu = (F.G % 8 == 0) ? (bx % 8) * (F.G / 8) + bx / 8 : bx; }
    return F;
}
__device__ __forceinline__ float* ss_arr(unsigned char* ws, int i) { return (float*)(ws + WS_SS) + (size_t)i * MROWS; }

__device__ __forceinline__ float wave_sum(float v) {
#pragma unroll
    for (int o = 1; o < 64; o <<= 1) v += __shfl_xor(v, o);
    return v;
}
__device__ __forceinline__ void p0_transpose_item(const float* W, int K, int N, int ldw, const float* gain, bf16* WT, LAS float* scr, int item, int lane) {
    const int nblk = N / 32, kb = item / nblk, nb = item % nblk, k0 = 64 * kb, n0 = 32 * nb;
    f32x4 v[8]; float gv[8];
#pragma unroll
    for (int i = 0; i < 8; ++i) { const int idx = i * 64 + lane, kk = idx >> 3, c4 = (idx & 7) * 4; v[i] = *(const GAS f32x4*)(W + (size_t)(k0 + kk) * ldw + n0 + c4); gv[i] = gain ? gain[k0 + kk] : 1.0f; }
#pragma unroll
    for (int i = 0; i < 8; ++i) { const int idx = i * 64 + lane, kk = idx >> 3, c4 = (idx & 7) * 4; LAS float* d = scr + kk * 33 + c4; const f32x4 x = v[i] * gv[i]; d[0] = x.x; d[1] = x.y; d[2] = x.z; d[3] = x.w; }
    LDS_WAIT(); asm volatile("" ::: "memory");
    const int c = lane & 7;
#pragma unroll
    for (int j = 0; j < 4; ++j) { const int n = (lane >> 3) + 8 * j; const LAS float* s = scr + (8 * c) * 33 + n;
        v4u o; o.x = pk2(s[0 * 33], s[1 * 33]); o.y = pk2(s[2 * 33], s[3 * 33]); o.z = pk2(s[4 * 33], s[5 * 33]); o.w = pk2(s[6 * 33], s[7 * 33]);
        *(GAS v4u*)(WT + (size_t)(n0 + n) * K + k0 + 8 * c) = o; }
    LDS_WAIT(); asm volatile("" ::: "memory");
}

struct Inputs {
    const float *x, *ln1_g, *w_in, *log_dt, *lam_re, *lam_im, *b_re, *b_im, *c_re, *c_im, *ssm_d, *glu_w, *glu_b, *fgate_b, *gn_ssm_g, *gn_attn_g, *w_out, *ln2_g, *w_up, *w_down, *final_g;
};

__device__ __forceinline__ float gelu_tanh(float x) {
    const float k = 0.7978845608028654f;
    const float inner = k * (x + 0.044715f * x * x * x);
    const float e = __builtin_amdgcn_exp2f(inner * (2.0f * LOG2E));
    const float th = 1.0f - 2.0f * __builtin_amdgcn_rcpf(e + 1.0f);
    return 0.5f * x * (1.0f + th);
}

typedef float f32x2f __attribute__((ext_vector_type(2)));
constexpr int SSM_MAT_ELEMS = 131072;
__device__ __forceinline__ void ssm_mats_item(Frame& F, const Inputs& I, unsigned char* ws, int l, int g) {
    LAS f32x2f* AP = (LAS f32x2f*)(F.lds);
    LAS f32x2f* BB = (LAS f32x2f*)(F.lds + 8704);
    LAS f32x2f* CC = (LAS f32x2f*)(F.lds + 16896);
    LAS float* KT = (LAS float*)(F.lds + 25088);
    LAS float* DSK = (LAS float*)(F.lds + 41472);
    const int lg = l * SG + g, tid = F.tid;
    const float dt = expf(I.log_dt[lg]);
    for (int i = tid; i < 17 * 64; i += 512) { const int j = i >> 6, n = i & 63; const float lr = I.lam_re[lg * SN + n], li = I.lam_im[lg * SN + n];
        const float mag = expf(lr * dt * (float)j); float sn, cs; sincosf(li * dt * (float)j, &sn, &cs); AP[i] = (f32x2f){mag * cs, mag * sn}; }
    for (int i = tid; i < 64 * 16; i += 512) { const int n = i >> 4; const float lr = I.lam_re[lg * SN + n], li = I.lam_im[lg * SN + n];
        const float mag = expf(lr * dt); float sn, cs; sincosf(li * dt, &sn, &cs);
        const float are = mag * cs, aim = mag * sn, den = lr * lr + li * li, nr = are - 1.0f;
        const float sre = (nr * lr + aim * li) / den, sim = (aim * lr - nr * li) / den;
        const float br = I.b_re[(size_t)lg * SN * SP + i], bi = I.b_im[(size_t)lg * SN * SP + i];
        BB[i] = (f32x2f){sre * br - sim * bi, sre * bi + sim * br}; }
    for (int i = tid; i < 16 * 64; i += 512) CC[i] = (f32x2f){I.c_re[(size_t)lg * SP * SN + i], I.c_im[(size_t)lg * SP * SN + i]};
    if (tid < 16) DSK[tid] = I.ssm_d[l * DSSM + g * SP + tid];
    __syncthreads();
    {
        const int ln = F.lane, pq = ln & 15, kk = ln >> 4, part = kk & 1;
        for (int jj = 0; jj < 2; ++jj) { const int j = 2 * F.wave + jj; f32x4 acc = (f32x4){0.f, 0.f, 0.f, 0.f};
#pragma unroll 4
            for (int n0 = 0; n0 < 64; n0 += 2) { const int n = n0 + (kk >> 1); const f32x2f c = CC[pq * 64 + n], a = AP[j * 64 + n], b = BB[n * 16 + pq];
                const float av = part ? -c.y : c.x, bv = part ? (a.x * b.y + a.y * b.x) : (a.x * b.x - a.y * b.y);
                acc = __builtin_amdgcn_mfma_f32_16x16x4f32(av, bv, acc, 0, 0, 0); }
#pragma unroll
            for (int r = 0; r < 4; ++r) KT[(j * 16 + 4 * kk + r) * 16 + pq] = acc[r]; }
    }
    __syncthreads();
    bf16* base = (bf16*)(ws + WS_SSMM) + (size_t)lg * SSM_MAT_ELEMS;
    for (int i = 0; i < 8; ++i) {
        const int li_ = tid + 512 * i, frg = li_ >> 6, ln = li_ & 63, rt = frg >> 3, ks = frg & 7, row = 16 * rt + (ln & 15), n = row & 63, isim = row >> 6;
        const int k0 = 32 * ks + 8 * (ln >> 4), s = k0 >> 4, q0 = k0 & 15; const f32x2f a = AP[(15 - s) * 64 + n]; float v[8];
#pragma unroll
        for (int j8 = 0; j8 < 8; ++j8) { const f32x2f b = BB[n * 16 + q0 + j8]; v[j8] = isim ? (a.x * b.y + a.y * b.x) : (a.x * b.x - a.y * b.y); }
        v4u w; w.x = pk2(v[0], v[1]); w.y = pk2(v[2], v[3]); w.z = pk2(v[4], v[5]); w.w = pk2(v[6], v[7]);
        *(GAS v4u*)(base + (size_t)li_ * 8) = w; }
    for (int i = 0; i < 24; ++i) {
        const int li_ = tid + 512 * i, frg = li_ >> 6, ln = li_ & 63, t = frg / 12, ks = frg % 12, p = ln & 15, k0 = 32 * ks + 8 * (ln >> 4); float v[8];
        if (k0 < 256) { const int s = k0 >> 4, q0 = k0 & 15;
#pragma unroll
            for (int j8 = 0; j8 < 8; ++j8) { const int q = q0 + j8; float x = 0.f; if (s <= t) { x = KT[((t - s) * 16 + p) * 16 + q]; if (s == t && p == q) x += DSK[p]; } v[j8] = x; }
        } else { const bool im = k0 >= 320; const int n0 = k0 - (im ? 320 : 256);
#pragma unroll
            for (int j8 = 0; j8 < 8; ++j8) { const f32x2f a = AP[(t + 1) * 64 + n0 + j8], c = CC[p * 64 + n0 + j8]; v[j8] = im ? -(c.x * a.y + c.y * a.x) : (c.x * a.x - c.y * a.y); }
        }
        v4u w; w.x = pk2(v[0], v[1]); w.y = pk2(v[2], v[3]); w.z = pk2(v[4], v[5]); w.w = pk2(v[6], v[7]);
        *(GAS v4u*)(base + (size_t)(4096 + li_) * 8) = w; }
    if (tid < 64) ((f32x2f*)(ws + WS_SA16))[lg * SN + tid] = AP[16 * 64 + tid];
    __syncthreads();
}

constexpr int SSM_UT = 8448, SSM_XROW = 272;
#ifndef REP_SA
#define REP_SA 1
#endif
#ifndef REP_CA
#define REP_CA 1
#endif
#ifndef REP_SC
#define REP_SC 1
#endif
#define SSM_ULOAD(T) (*(const v4u*)(Ug + (size_t)(T) * 8192 + tid * 16))
__device__ __forceinline__ void ssm_item(int l, int item) {
    Frame F = mk_frame(); unsigned char* ws = KWS();
    LAS unsigned char* UT = F.lds; LAS unsigned char* XB = F.lds + 2 * SSM_UT; LAS f32x2f* EX = (LAS f32x2f*)(F.lds + 2 * SSM_UT + 256 * SSM_XROW);
    const int lane = F.lane, wave = F.wave, tid = F.tid, fr = lane & 15, fq = lane >> 4;
    const int uoff = tid * 16 + (tid >> 5) * 16;
    const int boff = fr * 528 + (lane >> 5) * 32 + ((lane >> 4) & 1) * 16;
    {
        const int b = item >> 5, g = item & 31, lg = l * SG + g;
        const unsigned char* Ug = (const unsigned char*)((const bf16*)(ws + WS_U) + ((size_t)g * MROWS + (size_t)b * SEQ) * 16);
        const bf16* MAT = (const bf16*)(ws + WS_SSMM) + (size_t)lg * SSM_MAT_ELEMS;
        float* SL = (float*)(ws + WS_ST) + (size_t)item * 256 * 128;
        v4u ur[8];
        for (int repa = 0; repa < REP_SA; ++repa) {
            bf16x8 wa[8];
#pragma unroll
            for (int ks = 0; ks < 8; ++ks) wa[ks] = *(const bf16x8*)(MAT + (size_t)((wave * 8 + ks) * 64 + lane) * 8);
#pragma unroll
            for (int k = 0; k < 6; ++k) ur[k] = SSM_ULOAD(k);
            __syncthreads();
            *(LAS v4u*)(UT + uoff) = ur[0];
            for (int jo = 0; jo < 16; jo += 8) {
#pragma unroll
                for (int ji = 0; ji < 8; ++ji) { const int j = jo + ji;
                    __syncthreads();
                    ur[(ji + 6) & 7] = SSM_ULOAD((j + 6) & 15);
                    const LAS unsigned char* ut = UT + (j & 1) * SSM_UT + boff;
                    f32x4 acc = (f32x4){0.f, 0.f, 0.f, 0.f};
#pragma unroll
                    for (int ks = 0; ks < 8; ++ks) acc = __builtin_amdgcn_mfma_f32_16x16x32_bf16(wa[ks], *(const LAS bf16x8*)(ut + ks * 64), acc, 0, 0, 0);
                    *(f32x4*)(SL + (size_t)(16 * j + fr) * 128 + 16 * wave + 4 * fq) = acc;
                    *(LAS v4u*)(UT + ((j + 1) & 1) * SSM_UT + uoff) = ur[(ji + 1) & 7];
                }
            }
        }
        asm volatile("s_waitcnt vmcnt(0)" ::: "memory");
        __syncthreads();
#pragma unroll
        for (int k = 0; k < 6; ++k) ur[k] = SSM_ULOAD(k);
        for (int repc = 0; repc < REP_CA; ++repc) {
            __syncthreads();
            const f32x2f a16 = ((const f32x2f*)(ws + WS_SA16))[lg * SN + lane];
            float pr = a16.x, pi = a16.y;
#pragma unroll
            for (int i = 0; i < 5; ++i) { const float nr = pr * pr - pi * pi, ni = 2.0f * pr * pi; pr = nr; pi = ni; }
            float sr[32], si[32];
#pragma unroll
            for (int i = 0; i < 32; ++i) { sr[i] = SL[(size_t)(32 * wave + i) * 128 + lane]; si[i] = SL[(size_t)(32 * wave + i) * 128 + 64 + lane]; }
            float xr = 0.f, xi = 0.f;
#pragma unroll
            for (int i = 0; i < 32; ++i) { const float nr = a16.x * xr - a16.y * xi + sr[i], ni = a16.x * xi + a16.y * xr + si[i]; xr = nr; xi = ni; }
            EX[wave * 64 + lane] = (f32x2f){xr, xi};
            __syncthreads();
            xr = 0.f; xi = 0.f;
            for (int w2 = 0; w2 < wave; ++w2) { const f32x2f e = EX[w2 * 64 + lane]; const float nr = pr * xr - pi * xi + e.x, ni = pr * xi + pi * xr + e.y; xr = nr; xi = ni; }
#pragma unroll
            for (int i = 0; i < 32; ++i) {
                LAS unsigned short* xrow = (LAS unsigned short*)(XB + (32 * wave + i) * SSM_XROW);
                xrow[lane] = (unsigned short)f2bf(xr); xrow[64 + lane] = (unsigned short)f2bf(xi);
                const float nr = a16.x * xr - a16.y * xi + sr[i], ni = a16.x * xi + a16.y * xr + si[i]; xr = nr; xi = ni; }
        }
        for (int reps = 0; reps < REP_SC; ++reps) {
            if (reps) { __syncthreads(); _Pragma("unroll") for (int k = 0; k < 6; ++k) ur[k] = SSM_ULOAD(k); }
            const int t0 = wave, t1 = 15 - wave;
            bf16x8 wc0[12], wc1[12];
#pragma unroll
            for (int ks = 0; ks < 12; ++ks) { wc0[ks] = *(const bf16x8*)(MAT + (size_t)(4096 + (t0 * 12 + ks) * 64 + lane) * 8); wc1[ks] = *(const bf16x8*)(MAT + (size_t)(4096 + (t1 * 12 + ks) * 64 + lane) * 8); }
            bf16* GB = (bf16*)(ws + WS_GB);
            *(LAS v4u*)(UT + uoff) = ur[0];
            for (int jo = 0; jo < 16; jo += 8) {
#pragma unroll
                for (int ji = 0; ji < 8; ++ji) { const int j = jo + ji;
                    __syncthreads();
                    ur[(ji + 6) & 7] = SSM_ULOAD((j + 6) & 15);
                    const LAS unsigned char* ut = UT + (j & 1) * SSM_UT + boff;
                    const LAS unsigned char* xb = XB + (16 * j + fr) * SSM_XROW + fq * 16;
                    f32x4 acc0 = (f32x4){0.f, 0.f, 0.f, 0.f}, acc1 = (f32x4){0.f, 0.f, 0.f, 0.f};
#pragma unroll
                    for (int ks = 0; ks < 8; ++ks) { const bf16x8 ub = *(const LAS bf16x8*)(ut + ks * 64);
                        acc0 = __builtin_amdgcn_mfma_f32_16x16x32_bf16(wc0[ks], ub, acc0, 0, 0, 0);
                        acc1 = __builtin_amdgcn_mfma_f32_16x16x32_bf16(wc1[ks], ub, acc1, 0, 0, 0); }
#pragma unroll
                    for (int kp = 0; kp < 4; ++kp) { const bf16x8 xf = *(const LAS bf16x8*)(xb + kp * 64);
                        acc0 = __builtin_amdgcn_mfma_f32_16x16x32_bf16(wc0[8 + kp], xf, acc0, 0, 0, 0);
                        acc1 = __builtin_amdgcn_mfma_f32_16x16x32_bf16(wc1[8 + kp], xf, acc1, 0, 0, 0); }
                    const size_t row0 = (size_t)b * SEQ + 16 * (16 * j + fr);
                    { pg8::u32x2 w; w.x = pk2(gelu_tanh(acc0[0]), gelu_tanh(acc0[1])); w.y = pk2(gelu_tanh(acc0[2]), gelu_tanh(acc0[3])); *(pg8::u32x2*)(GB + (row0 + t0) * 512 + g * SP + 4 * fq) = w; }
                    { pg8::u32x2 w; w.x = pk2(gelu_tanh(acc1[0]), gelu_tanh(acc1[1])); w.y = pk2(gelu_tanh(acc1[2]), gelu_tanh(acc1[3])); *(pg8::u32x2*)(GB + (row0 + t1) * 512 + g * SP + 4 * fq) = w; }
                    *(LAS v4u*)(UT + ((j + 1) & 1) * SSM_UT + uoff) = ur[(ji + 1) & 7];
                }
            }
        }
        __syncthreads();
    }
}
__device__ __forceinline__ void ssm_mfma_phase(int l) {
    const int G = GRIDG_(), bx = BLK_(); const int vcu = (G % 8 == 0) ? (bx % 8) * (G / 8) + bx / 8 : bx;
    for (int item = vcu; item < BATCH * SG; item += G) ssm_item(l, item);
}
__device__ __forceinline__ Inputs load_inputs() {
    Inputs I;
    I.x = KIN(0); I.ln1_g = KIN(1); I.w_in = KIN(2); I.log_dt = KIN(3); I.lam_re = KIN(4); I.lam_im = KIN(5); I.b_re = KIN(6); I.b_im = KIN(7);
    I.c_re = KIN(8); I.c_im = KIN(9); I.ssm_d = KIN(10); I.glu_w = KIN(11); I.glu_b = KIN(12); I.fgate_b = KIN(13); I.gn_ssm_g = KIN(14); I.gn_attn_g = KIN(15);
    I.w_out = KIN(16); I.ln2_g = KIN(17); I.w_up = KIN(18); I.w_down = KIN(19); I.final_g = KIN(20);
    return I;
}
__device__ __forceinline__ void p0_prologue() {
    Frame F = mk_frame();
    const Inputs I = load_inputs();
    LAS float* scr = (LAS float*)(F.lds + RING_OFF + F.wave * 16384);
    const int gw = opaque_s(F.vcu) * NWAVES + opaque_s(F.wave), NGW = opaque_s(F.G) * NWAVES;
    unsigned char* ws = KWS();
    for (int it = F.vcu; it < DEPTH * SG; it += F.G) ssm_mats_item(F, I, ws, it / SG, it % SG);
    constexpr int I_IN = (DM / 64) * (2048 / 32), I_OUT = (DM / 64) * (DM / 32), I_UP = (DM / 64) * (DFF / 32), I_DN = (DFF / 64) * (DM / 32), I_GLU = (DSSM / 64) * (DSSM / 32);
    constexpr int PER_L = I_IN + I_OUT + I_UP + I_DN + I_GLU;
    for (int it = gw; it < DEPTH * PER_L; it += NGW) {
        const int l = it / PER_L; int r = it % PER_L;
        if (r < I_IN) { p0_transpose_item(I.w_in + (size_t)l * DM * DIN, DM, 2048, DIN, I.ln1_g + l * DM, (bf16*)(ws + WS_WIN) + (size_t)l * 2048 * DM, scr, r, F.lane); continue; } r -= I_IN;
        if (r < I_OUT) {
            const int kb = r / (DM / 32); const float* gain = (kb < 8) ? (I.gn_ssm_g + l * DSSM) : (I.gn_attn_g + l * DATT - 512);
            p0_transpose_item(I.w_out + (size_t)l * DM * DM, DM, DM, DM, gain, (bf16*)(ws + WS_WOUT) + (size_t)l * DM * DM, scr, r, F.lane); continue; } r -= I_OUT;
        if (r < I_UP) { p0_transpose_item(I.w_up + (size_t)l * DM * DFF, DM, DFF, DFF, I.ln2_g + l * DM, (bf16*)(ws + WS_WUP) + (size_t)l * DFF * DM, scr, r, F.lane); continue; } r -= I_UP;
        if (r < I_DN) { p0_transpose_item(I.w_down + (size_t)l * DFF * DM, DFF, DM, DM, nullptr, (bf16*)(ws + WS_WDN) + (size_t)l * DM * DFF, scr, r, F.lane); continue; } r -= I_DN;
        p0_transpose_item(I.glu_w + (size_t)l * DSSM * DSSM, DSSM, DSSM, DSSM, nullptr, (bf16*)(ws + WS_WGLU) + (size_t)l * DSSM * DSSM, scr, r, F.lane);
    }
    for (int i = gw * 64 + F.lane; i < DEPTH * 8 * DM; i += NGW * 64) { const int l = i / (8 * DM), h = (i / DM) % 8, k = i % DM;
        ((float*)(ws + WS_WF))[i] = I.w_in[(size_t)l * DM * DIN + (size_t)k * DIN + 2048 + h] * I.ln1_g[l * DM + k]; }
    for (int i = gw * 64 + F.lane; i < DEPTH * SG * SN; i += NGW * 64) {
        const int l = i / (SG * SN), gn = i % (SG * SN), g = gn / SN;
        const float dt = expf(I.log_dt[l * SG + g]);
        const float lr = I.lam_re[i], li = I.lam_im[i];
        const float mag = expf(lr * dt); float sn, cs; sincosf(li * dt, &sn, &cs);
        const float are = mag * cs, aim = mag * sn, den = lr * lr + li * li, nr = are - 1.0f;
        const float sre = (nr * lr + aim * li) / den, sim = (aim * lr - nr * li) / den;
        float* pa = (float*)(ws + WS_SPA) + (size_t)i * 2; pa[0] = are; pa[1] = aim;
        float* pb = (float*)(ws + WS_SPB) + (size_t)i * SP * 2;
        for (int p = 0; p < SP; ++p) { const float br = I.b_re[(size_t)i * SP + p], bi = I.b_im[(size_t)i * SP + p]; pb[p * 2] = sre * br - sim * bi; pb[p * 2 + 1] = sre * bi + sim * br; }
    }
    { f32x4* z = (f32x4*)ss_arr(ws, 1); for (int i = gw * 64 + F.lane; i < 8 * MROWS / 4; i += NGW * 64) z[i] = (f32x4){0.f, 0.f, 0.f, 0.f}; }
    for (int m0 = gw * 4; m0 < MROWS; m0 += NGW * 4) {
        f32x4 v[4][4];
#pragma unroll
        for (int r = 0; r < 4; ++r)
#pragma unroll
            for (int j = 0; j < 4; ++j) v[r][j] = ((const GAS f32x4*)(I.x + (size_t)(m0 + r) * DM) + F.lane)[64 * j];
#pragma unroll
        for (int r = 0; r < 4; ++r) {
            GAS unsigned long long* o8 = (GAS unsigned long long*)((bf16*)(ws + WS_HB) + (size_t)(m0 + r) * DM) + F.lane; float s = 0.f;
#pragma unroll
            for (int j = 0; j < 4; ++j) { const f32x4 x = v[r][j]; s += (x.x * x.x + x.y * x.y) + (x.z * x.z + x.w * x.w);
                o8[64 * j] = (unsigned long long)pk2(x.x, x.y) | ((unsigned long long)pk2(x.z, x.w) << 32); }
            s = wave_sum(s);
            if (F.lane == 0) ss_arr(ws, 0)[m0 + r] = s;
        }
    }
}

__device__ __forceinline__ void csum_items(int l) {
    Frame F = mk_frame();
    LAS float* wfl = (LAS float*)(F.lds); LAS float* Fs = (LAS float*)(F.lds + 32768);
    unsigned char* ws = KWS(); const float* fbias = KIN(13) + l * NHEAD; const float* ss1 = ss_arr(ws, 4 * l);
    const float* wf = (const float*)(ws + WS_WF) + (size_t)l * 8 * DM;
    for (int i = F.tid; i < 8 * DM; i += 512) wfl[i] = wf[i];
    __syncthreads();
    const bf16* HB = (const bf16*)(ws + WS_HB);
    float* CSL = (float*)(ws + WS_CSL); float* CST = (float*)(ws + WS_CST);
    for (int chunk = F.vcu; chunk < MROWS / 64; chunk += F.G) {
        for (int rr = 0; rr < 8; ++rr) {
            const int row = chunk * 64 + F.wave * 8 + rr;
            const v4u x0 = *(const v4u*)(HB + (size_t)row * DM + F.lane * 8), x1 = *(const v4u*)(HB + (size_t)row * DM + 512 + F.lane * 8);
            float xv[16] = {pg8::bflo(x0.x), pg8::bfhi(x0.x), pg8::bflo(x0.y), pg8::bfhi(x0.y), pg8::bflo(x0.z), pg8::bfhi(x0.z), pg8::bflo(x0.w), pg8::bfhi(x0.w),
                            pg8::bflo(x1.x), pg8::bfhi(x1.x), pg8::bflo(x1.y), pg8::bfhi(x1.y), pg8::bflo(x1.z), pg8::bfhi(x1.z), pg8::bflo(x1.w), pg8::bfhi(x1.w)};
            float mine = 0.f;
#pragma unroll
            for (int h = 0; h < 8; ++h) {
                const LAS f32x4* w = (const LAS f32x4*)(wfl + h * DM + F.lane * 8);
                const f32x4 w0 = w[0], w1 = w[1], w2 = w[128], w3 = w[129];
                float a = 0.f;
#pragma unroll
                for (int e = 0; e < 4; ++e) { a = fmaf(xv[e], w0[e], a); a = fmaf(xv[4 + e], w1[e], a); a = fmaf(xv[8 + e], w2[e], a); a = fmaf(xv[12 + e], w3[e], a); }
                a = wave_sum(a);
                if (F.lane == h) mine = a;
            }
            if (F.lane < 8) {
                const float f = mine * rsqrtf(ss1[row] * (1.0f / 1024.0f) + EPS) + fbias[F.lane];
                const float ls = (f >= 0.f) ? -log1pf(expf(-f)) : (f - log1pf(expf(f)));
                Fs[(F.wave * 8 + rr) * 8 + F.lane] = ls * LOG2E;
            }
        }
        __syncthreads();
        {
            float v = Fs[F.lane * 8 + F.wave];
#pragma unroll
            for (int o = 1; o < 64; o <<= 1) { const float t = __shfl_up(v, o); if (F.lane >= o) v += t; }
            const int row = chunk * 64 + F.lane, b = row / SEQ, t = row % SEQ;
            CSL[((size_t)b * NHEAD + F.wave) * SEQ + t] = v;
            { const float nv = -v; const unsigned h1 = f2bf(nv); const float r1 = nv - __uint_as_float(h1 << 16); const unsigned h2 = f2bf(r1); const float r2 = r1 - __uint_as_float(h2 << 16); const unsigned h3 = f2bf(r2);
              v4u w; w.x = h1 | (h2 << 16); w.y = h3 | 0x3F800000u; w.z = 0x3F803F80u; w.w = 0u;
              *(v4u*)((bf16*)(ws + WS_KAUG) + (((size_t)b * NHEAD + F.wave) * SEQ + t) * 8) = w; }
            if (F.lane == 63) CST[((size_t)b * NHEAD + F.wave) * 64 + t / 64] = v;
        }
        __syncthreads();
    }
}


__device__ __forceinline__ void ssm_naive_phase(int l) {
    Frame F = mk_frame();
    unsigned char* ws = KWS(); Inputs I; I.c_re = KIN(8); I.c_im = KIN(9); I.ssm_d = KIN(10);
    const int gw = opaque_s(F.vcu) * NWAVES + opaque_s(F.wave), NGW = opaque_s(F.G) * NWAVES;
    const bf16* U = (const bf16*)(ws + WS_U); bf16* GB = (bf16*)(ws + WS_GB);
    for (int it = gw; it < BATCH * SG; it += NGW) {
        const int b = it / SG, g = it % SG, n = F.lane;
        const float* bb = (const float*)(ws + WS_SPB) + ((size_t)(l * SG + g) * SN + n) * SP * 2;
        const float* pa = (const float*)(ws + WS_SPA) + ((size_t)(l * SG + g) * SN + n) * 2;
        const float* cre = I.c_re + (size_t)(l * SG + g) * SP * SN; const float* cim = I.c_im + (size_t)(l * SG + g) * SP * SN;
        float bbr[SP], bbi[SP], cr[SP], ci[SP];
#pragma unroll
        for (int p = 0; p < SP; ++p) { bbr[p] = bb[p * 2]; bbi[p] = bb[p * 2 + 1]; cr[p] = cre[p * SN + n]; ci[p] = cim[p * SN + n]; }
        const float ar = pa[0], ai = pa[1];
        const float dsk = I.ssm_d[l * DSSM + g * SP + (n & 15)];
        float xr = 0.f, xi = 0.f;
        for (int t = 0; t < SEQ; ++t) {
            const size_t row = (size_t)b * SEQ + t;
            const v4u u0 = *(const v4u*)(U + ((size_t)g * MROWS + row) * 16), u1 = *(const v4u*)(U + ((size_t)g * MROWS + row) * 16 + 8);
            float u[16] = {pg8::bflo(u0.x), pg8::bfhi(u0.x), pg8::bflo(u0.y), pg8::bfhi(u0.y), pg8::bflo(u0.z), pg8::bfhi(u0.z), pg8::bflo(u0.w), pg8::bfhi(u0.w),
                           pg8::bflo(u1.x), pg8::bfhi(u1.x), pg8::bflo(u1.y), pg8::bfhi(u1.y), pg8::bflo(u1.z), pg8::bfhi(u1.z), pg8::bflo(u1.w), pg8::bfhi(u1.w)};
            float bur = 0.f, bui = 0.f;
#pragma unroll
            for (int p = 0; p < SP; ++p) { bur = fmaf(bbr[p], u[p], bur); bui = fmaf(bbi[p], u[p], bui); }
            const float nxr = ar * xr - ai * xi + bur, nxi = ar * xi + ai * xr + bui;
            xr = nxr; xi = nxi;
            float mine = 0.f;
#pragma unroll
            for (int p = 0; p < SP; ++p) { const float v = wave_sum(cr[p] * xr - ci[p] * xi); if ((n & 15) == p) mine = v + dsk * u[p]; }
            if (n < SP) GB[row * 512 + g * SP + n] = (bf16)f2bf(gelu_tanh(mine));
        }
    }
}

__device__ __forceinline__ void attn_naive_phase(int l) {
    Frame F = mk_frame();
    unsigned char* ws = KWS(); float* ss_att = ss_arr(ws, 4 * l + 2);
    const int gw = opaque_s(F.vcu) * NWAVES + opaque_s(F.wave), NGW = opaque_s(F.G) * NWAVES;
    const bf16* Q = (const bf16*)(ws + WS_Q); const bf16* K = (const bf16*)(ws + WS_K); const bf16* V = (const bf16*)(ws + WS_V); bf16* MIX = (bf16*)(ws + WS_MIX);
    const float* CSL = (const float*)(ws + WS_CSL); const float* CST = (const float*)(ws + WS_CST);
    LAS unsigned char* wl = F.lds + F.wave * 8448;
    LAS v4u* Kt = (LAS v4u*)wl; LAS v4u* Vt = (LAS v4u*)(wl + 4096); LAS float* Cs = (LAS float*)(wl + 8192);
    for (int it = gw; it < BATCH * NHEAD * 64; it += NGW) {
        const int qb = 63 - it / 32, bh = it % 32, b = bh / NHEAD, h = bh % NHEAD;
        const int i = qb * 64 + F.lane; const size_t qrow = (size_t)b * SEQ + i;
        float q[64], o[64];
#pragma unroll
        for (int c = 0; c < 8; ++c) { const v4u w = *(const v4u*)(Q + qrow * 512 + h * 64 + c * 8);
            q[c * 8 + 0] = pg8::bflo(w.x); q[c * 8 + 1] = pg8::bfhi(w.x); q[c * 8 + 2] = pg8::bflo(w.y); q[c * 8 + 3] = pg8::bfhi(w.y);
            q[c * 8 + 4] = pg8::bflo(w.z); q[c * 8 + 5] = pg8::bfhi(w.z); q[c * 8 + 6] = pg8::bflo(w.w); q[c * 8 + 7] = pg8::bfhi(w.w); }
#pragma unroll
        for (int d = 0; d < 64; ++d) o[d] = 0.f;
        const float* cst = CST + (size_t)bh * 64; const float* csl = CSL + (size_t)bh * SEQ;
        float offq = 0.f; for (int c = 0; c < qb; ++c) offq += cst[c];
        const float ci = csl[i] + offq;
        float offk = 0.f, m = -INFINITY, lsum = 0.f;
        for (int kt = 0; kt < 2 * qb + 2; ++kt) {
            if (kt > 0 && (kt & 1) == 0) offk += cst[kt / 2 - 1];
            asm volatile("s_waitcnt lgkmcnt(0)" ::: "memory");
#pragma unroll
            for (int r = 0; r < 4; ++r) { const int idx = r * 64 + F.lane, key = idx >> 3, ch = idx & 7; const size_t krow = (size_t)b * SEQ + kt * 32 + key;
                Kt[idx] = *(const v4u*)(K + krow * 512 + h * 64 + ch * 8); Vt[idx] = *(const v4u*)(V + krow * 512 + h * 64 + ch * 8); }
            if (F.lane < 32) Cs[F.lane] = csl[kt * 32 + F.lane] + offk;
            asm volatile("s_waitcnt vmcnt(0) lgkmcnt(0)" ::: "memory");
            for (int j = 0; j < 32; ++j) {
                const int kj = kt * 32 + j;
                float s = 0.f;
#pragma unroll
                for (int c = 0; c < 8; ++c) { const v4u w = Kt[j * 8 + c];
                    s = fmaf(q[c * 8 + 0], pg8::bflo(w.x), s); s = fmaf(q[c * 8 + 1], pg8::bfhi(w.x), s); s = fmaf(q[c * 8 + 2], pg8::bflo(w.y), s); s = fmaf(q[c * 8 + 3], pg8::bfhi(w.y), s);
                    s = fmaf(q[c * 8 + 4], pg8::bflo(w.z), s); s = fmaf(q[c * 8 + 5], pg8::bfhi(w.z), s); s = fmaf(q[c * 8 + 6], pg8::bflo(w.w), s); s = fmaf(q[c * 8 + 7], pg8::bfhi(w.w), s); }
                s += ci - Cs[j];
                if (kj <= i) {
                    if (s > m) { const float f = __builtin_amdgcn_exp2f(m - s); lsum *= f;
#pragma unroll
                        for (int d = 0; d < 64; ++d) o[d] *= f;
                        m = s; }
                    const float p = __builtin_amdgcn_exp2f(s - m); lsum += p;
#pragma unroll
                    for (int c = 0; c < 8; ++c) { const v4u w = Vt[j * 8 + c];
                        o[c * 8 + 0] = fmaf(p, pg8::bflo(w.x), o[c * 8 + 0]); o[c * 8 + 1] = fmaf(p, pg8::bfhi(w.x), o[c * 8 + 1]); o[c * 8 + 2] = fmaf(p, pg8::bflo(w.y), o[c * 8 + 2]); o[c * 8 + 3] = fmaf(p, pg8::bfhi(w.y), o[c * 8 + 3]);
                        o[c * 8 + 4] = fmaf(p, pg8::bflo(w.z), o[c * 8 + 4]); o[c * 8 + 5] = fmaf(p, pg8::bfhi(w.z), o[c * 8 + 5]); o[c * 8 + 6] = fmaf(p, pg8::bflo(w.w), o[c * 8 + 6]); o[c * 8 + 7] = fmaf(p, pg8::bfhi(w.w), o[c * 8 + 7]); }
                }
            }
        }
        const float inv = 1.0f / lsum; float part = 0.f;
#pragma unroll
        for (int c = 0; c < 8; ++c) { float e[8];
#pragma unroll
            for (int d = 0; d < 8; ++d) { e[d] = o[c * 8 + d] * inv; part += e[d] * e[d]; }
            v4u w; w.x = pk2(e[0], e[1]); w.y = pk2(e[2], e[3]); w.z = pk2(e[4], e[5]); w.w = pk2(e[6], e[7]);
            *(v4u*)(MIX + qrow * 1024 + 512 + h * 64 + c * 8) = w; }
        atomicAdd(ss_att + qrow, part);
    }
}

__device__ __forceinline__ void attn_fox_phase(int l, int rep) {
    unsigned char* ws = KWS();
    const attn_body::AttnTensors AT{(const attn_body::bf16*)(ws + WS_Q), (const attn_body::bf16*)(ws + WS_K), (const attn_body::bf16*)(ws + WS_V), (const attn_body::bf16*)(ws + WS_KAUG),
                                    (const float*)(ws + WS_CSL), (const float*)(ws + WS_CST), (attn_body::bf16*)(ws + WS_MIX) + 512, ss_arr(ws, rep == 0 ? 4 * l + 2 : 9)};
    const attn_body::StaticOrder S(GRIDG_(), BLK_());
    attn_body::attn_phase<attn_body::StaticOrder>((char*)g_lds + RING_OFF, AT, S);
}

__device__ __forceinline__ void mixer_phase(int l, int rep) {
    unsigned char* ws = KWS();
    const int G = GRIDG_(), bx = BLK_();
    const int npass = (G >= 8 && G % 8 == 0) ? 1 : 8;
    volatile LAS unsigned* bc = (volatile LAS unsigned*)((LAS unsigned char*)g_lds + MISC_OFF) + 12;
    for (int ps = 0; ps < npass; ++ps) {
        const int xq = (bx + ps) & 7;
        unsigned* head = (unsigned*)(ws + WS_CTL) + CW_Q + 64 * (16 * rep + 8 * l + xq);
        for (;;) {
            if (threadIdx.x == 0) *bc = __hip_atomic_fetch_add(head, 1u, __ATOMIC_RELAXED, __HIP_MEMORY_SCOPE_AGENT);
            __syncthreads();
            const int idx = (int)__builtin_amdgcn_readfirstlane(*bc);
            __syncthreads();
            if (idx >= 80) break;
            if (idx < 16) ssm_item(l, xq * 16 + idx);
            else { const int j = idx - 16, bh = 4 * xq + (j & 3), qb = 15 - (j >> 2);
                attn_body::attn_unit<16>(bh >> 3, bh & 7, qb, (const attn_body::bf16*)(ws + WS_Q), (const attn_body::bf16*)(ws + WS_K), (const attn_body::bf16*)(ws + WS_V), (const attn_body::bf16*)(ws + WS_KAUG),
                                         (const float*)(ws + WS_CSL), (const float*)(ws + WS_CST), (attn_body::bf16*)(ws + WS_MIX) + 512, ss_arr(ws, rep == 0 ? 4 * l + 2 : 9), (char*)g_lds + RING_OFF); }
        }
    }
}

__device__ __forceinline__ void final_norm_phase() {
    Frame F = mk_frame();
    float* out = KOUT(); const float* ssf = ss_arr(KWS(), 8); const float* g = KIN(20);
    const int gw = opaque_s(F.vcu) * NWAVES + opaque_s(F.wave), NGW = opaque_s(F.G) * NWAVES;
    for (int m = gw; m < MROWS; m += NGW) {
        GAS f32x4* xr = (GAS f32x4*)(out + (size_t)m * DM) + F.lane; const f32x4* gr = (const f32x4*)g + F.lane;
        const float r = rsqrtf(ssf[m] * (1.0f / 1024.0f) + EPS);
#pragma unroll
        for (int j = 0; j < 4; ++j) { const f32x4 v = xr[64 * j]; const f32x4 gg = gr[64 * j]; xr[64 * j] = v * r * gg; }
    }
}

struct Args { const float* in[21]; float* out; unsigned char* ws; int pad0, pad1; };
__global__ void __launch_bounds__(NWAVES * 64, 2) fwd_megakernel(Args args) {
    if (DBG_STOP == -4) return;
    {
        Frame F = mk_frame();
        for (int u = F.tid; u < (LDS_BYTES - LDSCTL_OFF) / 4; u += NWAVES * 64) ((LAS unsigned*)(F.lds + LDSCTL_OFF))[u] = 0u;
        __syncthreads();
    }
    if (DBG_STOP == -5) return;
    XcdBarrier bar = xcd_barrier_post((unsigned*)(KWS() + WS_CTL) + CW_BAR, (volatile LAS unsigned*)((LAS unsigned char*)g_lds + MISC_OFF) + 8);
#ifndef REP_BAR
#define REP_BAR 1
#endif
#define GRID_BAR() do { for (int rb_ = 0; rb_ < REP_BAR; ++rb_) xcd_barrier(bar); } while (0)
#define LDSRING ((LAS unsigned char*)g_lds + RING_OFF)
#define GRIDG opaque_s((int)gridDim.x)
#define BLK opaque_s((int)blockIdx.x)

    if (DBG_STOP == -2) return;
    for (int rep = 0; rep < REP_PRO; ++rep) { p0_prologue(); __syncthreads(); }
    GRID_BAR();
    if (DBG_STOP == 0 || DBG_STOP == -3) return;

    for (int l = 0; l < DEPTH; ++l) {
        for (int rep = 0; rep < REP_P1; ++rep) {
        csum_items(l);
        {
            unsigned char* ws = KWS();
            pg8::Gemm g{(const bf16*)(ws + WS_HB), (const bf16*)(ws + WS_WIN) + (size_t)l * 2048 * DM, MROWS, 2048, DM}; pg8::StaticOrder S; S.init(MROWS, 2048, GRIDG, BLK);
            pg8::EpiProj E{(bf16*)(ws + WS_U), (size_t)(WS_Q - WS_U) / 2, ss_arr(ws, 4 * l), C2, 0};
            pg8::gemm_phase<pg8::EpiProj, pg8::StaticOrder, true, true>(LDSRING, g, S, E);
        }
        __syncthreads();
        }
        GRID_BAR();
        if (DBG_STOP == 1) return;
#ifndef REP_MIX
#define REP_MIX 1
#endif
        for (int rep = 0; rep < REP_MIX; ++rep) mixer_phase(l, rep);
        GRID_BAR();
        if (DBG_STOP == 2) return;
        for (int rep = 0; rep < REP_GLU; ++rep) {
            unsigned char* ws = KWS();
            pg8::Gemm g{(const bf16*)(ws + WS_GB), (const bf16*)(ws + WS_WGLU) + (size_t)l * DSSM * DSSM, MROWS, DSSM, DSSM}; pg8::StaticOrder S; S.init(MROWS, DSSM, GRIDG, BLK);
            pg8::EpiGlu E{(const bf16*)(ws + WS_GB), (bf16*)(ws + WS_MIX), KIN(12) + l * DSSM, ss_arr(ws, rep == 0 ? 4 * l + 1 : 9), 0};
            pg8::gemm_phase<pg8::EpiGlu, pg8::StaticOrder, true, true>(LDSRING, g, S, E);
            __syncthreads();
            if (REP_SYNC && rep + 1 < REP_GLU) GRID_BAR();
        }
        GRID_BAR();
        for (int rep = REP_OUT - 1; rep >= 0; --rep) {
            unsigned char* ws = KWS(); float* out = KOUT();
            pg8::Gemm g{(const bf16*)(ws + WS_MIX), (const bf16*)(ws + WS_WOUT) + (size_t)l * DM * DM, MROWS, DM, DM}; pg8::StaticOrder S; S.init(MROWS, DM, GRIDG, BLK);
            pg8::EpiOut E{l, 8, rep};
            pg8::gemm_phase<pg8::EpiOut, pg8::StaticOrder, true, true>(LDSRING, g, S, E);
            __syncthreads();
            if (REP_SYNC && rep != 0) GRID_BAR();
        }
        GRID_BAR();
        for (int rep = 0; rep < REP_UP; ++rep) {
            unsigned char* ws = KWS();
            pg8::Gemm g{(const bf16*)(ws + WS_HB), (const bf16*)(ws + WS_WUP) + (size_t)l * DFF * DM, MROWS, DFF, DM}; pg8::StaticOrder S; S.init(MROWS, DFF, GRIDG, BLK);
            pg8::EpiUp E{(bf16*)(ws + WS_HID), ss_arr(ws, 4 * l + 3), 0};
            pg8::gemm_phase<pg8::EpiUp, pg8::StaticOrder, true, true>(LDSRING, g, S, E);
            __syncthreads();
            if (REP_SYNC && rep + 1 < REP_UP) GRID_BAR();
        }
        GRID_BAR();
        for (int rep = REP_DN - 1; rep >= 0; --rep) {
            unsigned char* ws = KWS(); float* out = KOUT();
            pg8::Gemm g{(const bf16*)(ws + WS_HID), (const bf16*)(ws + WS_WDN) + (size_t)l * DM * DFF, MROWS, DM, DFF}; pg8::StaticOrder S; S.init(MROWS, DM, GRIDG, BLK);
            pg8::EpiDown E{out, (bf16*)(ws + WS_HB), ss_arr(ws, rep ? 9 : 4 * l + 4), 0, rep};
            pg8::gemm_phase<pg8::EpiDown, pg8::StaticOrder, true, true>(LDSRING, g, S, E);
            __syncthreads();
            if (REP_SYNC && rep != 0) GRID_BAR();
        }
        GRID_BAR();
    }
    final_norm_phase();
}

extern "C" void kernel_launch(void* const* d_in, const int* in_sizes, int n_in, void* d_out, int out_size, void* d_ws, size_t ws_size, hipStream_t stream) {
    static int grid = 0;
    if (grid == 0) {
        if (n_in != 21 || out_size != MROWS * DM || ws_size < WS_END) { fprintf(stderr, "kernel_launch: unexpected shapes (n_in %d, out %d, ws %zu)\n", n_in, out_size, ws_size); grid = -1; return; }
        int dev = 0, cus = 0, per_cu = 0;
        if (hipGetDevice(&dev) != hipSuccess || hipDeviceGetAttribute(&cus, hipDeviceAttributeMultiprocessorCount, dev) != hipSuccess) { grid = -1; return; }
        if (hipFuncSetAttribute((const void*)fwd_megakernel, hipFuncAttributeMaxDynamicSharedMemorySize, LDS_BYTES) != hipSuccess) { fprintf(stderr, "kernel_launch: hipFuncSetAttribute failed\n"); grid = -1; return; }
        if (hipOccupancyMaxActiveBlocksPerMultiprocessor(&per_cu, (const void*)fwd_megakernel, NWAVES * 64, LDS_BYTES) != hipSuccess || per_cu < 1) { fprintf(stderr, "kernel_launch: occupancy query says %d blocks per CU\n", per_cu); }
        (void)hipGetLastError();
        grid = cus;
    }
    if (grid < 0) return;
    if (hipMemsetAsync((char*)d_ws + WS_CTL, 0, CTL_ZERO_BYTES, stream) != hipSuccess) { fprintf(stderr, "kernel_launch: memset failed\n"); return; }
    Args a{};
    for (int i = 0; i < 21; ++i) a.in[i] = (const float*)d_in[i];
    a.out = (float*)d_out; a.ws = (unsigned char*)d_ws;
    hipLaunchKernelGGL(fwd_megakernel, dim3(grid), dim3(NWAVES * 64), LDS_BYTES, stream, a);
    const hipError_t le = hipPeekAtLastError();
    if (le != hipSuccess) fprintf(stderr, "kernel_launch: launch failed: %s\n", hipGetErrorName(le));
}
```

```cpp
#include <hip/hip_runtime.h>
#include <cstdio>
#include <cstdint>

constexpr int BATCH = 4, SEQ = 4096, DM = 1024, MROWS = BATCH * SEQ, DEPTH = 2;
constexpr int DSSM = 512, DATT = 512, NHEAD = 8, HDIM = 64, DFF = 4096, DIN = 2056;
constexpr int SG = 32, SP = 16, SN = 64;
constexpr float EPS = 1e-6f;
constexpr float LOG2E = 1.4426950408889634f;
constexpr float C2 = 0.125f * 1.4426950408889634f;
namespace pg8 {
#define PG8_LAS __attribute__((address_space(3)))
typedef unsigned short bf16_t;
typedef short bf16x8 __attribute__((ext_vector_type(8)));
typedef float f32x4 __attribute__((ext_vector_type(4)));
typedef unsigned u32x4 __attribute__((ext_vector_type(4)));
constexpr int BM = 256, BK = 64, HALF = 128, HTB = HALF * BK * 2  , STAGE_BYTES = 8 * HTB, NXCD = 8, WGM = 8;

__host__ __device__ __forceinline__ int lds_byte(int r, int c) { const int st = (r >> 4) * 2 + (c >> 5), rr = r & 15, cc = c & 31, ob = rr * 64 + cc * 2; return st * 1024 + (ob ^ (((ob >> 9) & 1) << 5)); }
__host__ __device__ __forceinline__ void stage_rc(int b, int& R, int& C) { const int st = b / 1024, sb = b % 1024, swz = sb ^ (((sb >> 9) & 1) << 5); R = (st >> 1) * 16 + swz / 64; C = (st & 1) * 32 + (swz % 64) / 2; }
__host__ __device__ __forceinline__ int perm32(int rho) { const int n = rho >> 4, i = rho & 15; return 8 * (i >> 2) + 4 * n + (i & 3); }

struct Unit { int pm, pn; };
struct Gemm { const bf16_t* A; const bf16_t* Bt; int M, N, K; };

struct StaticOrder {
    int nM, nN, nwg, G, c;
    __host__ __device__ void init(int M, int N, int G_, int c_) { nM = M / BM; nN = N / BM; nwg = nM * nN; G = G_; c = c_; }
    __host__ __device__ bool next(int i, Unit& u) const {
        const long L = (long)i * G + c; if (L >= nwg) return false;
        int wgid = (int)L; { const int q = nwg / NXCD, r = nwg % NXCD, xcd = wgid % NXCD, off = wgid / NXCD; wgid = (xcd < r ? xcd * (q + 1) : r * (q + 1) + (xcd - r) * q) + off; }
        const int nig = WGM * nN, gid = wgid / nig, fm = gid * WGM, gsz = (nM - fm) < WGM ? (nM - fm) : WGM;
        u.pm = fm + ((wgid % nig) % gsz); u.pn = (wgid % nig) / gsz; return true;
    }
    __device__ __forceinline__ void a_ready(const Unit&) const {}
    __device__ __forceinline__ void done(const Unit&) const {}
};


__device__ __forceinline__ unsigned cvt_pk_bf16(float lo, float hi) { unsigned r; asm volatile("v_cvt_pk_bf16_f32 %0, %1, %2" : "=v"(r) : "v"(lo), "v"(hi)); return r; }
__device__ __forceinline__ float bflo(unsigned w) { return __uint_as_float(w << 16); }
__device__ __forceinline__ float bfhi(unsigned w) { return __uint_as_float(w & 0xffff0000u); }
typedef unsigned u32x2 __attribute__((ext_vector_type(2)));
constexpr int EP_M = 16384;
typedef __attribute__((address_space(4))) const unsigned char* ep_kptr_t;
template <class T> __device__ __forceinline__ T* ep_karg(int i) { ep_kptr_t p = (ep_kptr_t)__builtin_amdgcn_kernarg_segment_ptr(); asm volatile("" : "+s"(p)); return *(T* const __attribute__((address_space(4)))*)(p + 8 * i); }
typedef unsigned long long ssq_t;
__device__ __forceinline__ void ss_add(ssq_t* a, int row, float v) { atomicAdd(a + row, (ssq_t)(v * 16777216.0f)); }
__device__ __forceinline__ float ss_get(const ssq_t* a, int row) { return (float)a[row] * (1.0f / 16777216.0f); }
__device__ __forceinline__ ssq_t* ep_ss(int i) { return (ssq_t*)(ep_karg<unsigned char>(22) + (228u << 20)) + (size_t)i * EP_M; }
__device__ __forceinline__ float* ep_out() { return ep_karg<float>(21); }
__device__ __forceinline__ const float* ep_x() { return ep_karg<const float>(0); }
__device__ __forceinline__ bf16_t* ep_hb() { return (bf16_t*)(ep_karg<unsigned char>(22) + (66u << 20)); }

struct EpiProj {
    static constexpr bool PERM = true, AFTER_DRAIN = false, MIDK = false;
    bf16_t* O; size_t stride; const ssq_t* ss; float qscale; int midk_t;
    __device__ __forceinline__ void midk(f32x4 (&)[2][2][4][2], const Unit&, int, int, int, int) const {}
    __device__ __forceinline__ void operator()(const f32x4 (&acc)[2][2][4][2], const Unit& u, int wr, int wc, int fr, int fq) const {
        const int row0 = u.pm * BM + wr * 64 + fr; int colt = u.pn * BM; const int t = colt / 512; colt -= t * 512;
        bf16_t* base = O + (size_t)t * stride; const float sc = (t == 1) ? qscale : 1.0f;
        const int col0 = colt + wc * 32 + 8 * fq;
#pragma unroll
        for (int ai = 0; ai < 2; ++ai)
#pragma unroll
            for (int m = 0; m < 4; ++m) { const int row = row0 + ai * HALF + m * 16; const float rs = rsqrtf(ss_get(ss, row) * (1.0f / 1024.0f) + 1e-6f) * sc;
                bf16_t* rowp = (t == 0) ? base + ((size_t)(col0 >> 4) * EP_M + row) * 16 + (col0 & 15) : base + (size_t)row * 512 + col0;
#pragma unroll
                for (int bj = 0; bj < 2; ++bj) { const f32x4 v0 = acc[ai][bj][m][0] * rs, v1 = acc[ai][bj][m][1] * rs;
                    u32x4 w; w.x = cvt_pk_bf16(v0[0], v0[1]); w.y = cvt_pk_bf16(v0[2], v0[3]); w.z = cvt_pk_bf16(v1[0], v1[1]); w.w = cvt_pk_bf16(v1[2], v1[3]);
                    *(u32x4*)(rowp + (t == 0 ? (size_t)bj * 8 * EP_M * 16 : (size_t)bj * HALF)) = w; } }
    }
};
struct EpiGlu {
    static constexpr bool PERM = true, AFTER_DRAIN = false, MIDK = false;
    const bf16_t* GB; bf16_t* MIX; const float* bias; ssq_t* ss; int midk_t;
    __device__ __forceinline__ void midk(f32x4 (&)[2][2][4][2], const Unit&, int, int, int, int) const {}
    __device__ __forceinline__ void operator()(const f32x4 (&acc)[2][2][4][2], const Unit& u, int wr, int wc, int fr, int fq) const {
        const int row0 = u.pm * BM + wr * 64 + fr, col0 = u.pn * BM + wc * 32 + 8 * fq;
        f32x4 bv[2][2];
#pragma unroll
        for (int bj = 0; bj < 2; ++bj)
#pragma unroll
            for (int n = 0; n < 2; ++n) bv[bj][n] = *(const f32x4*)(bias + col0 + bj * HALF + 4 * n);
#pragma unroll
        for (int ai = 0; ai < 2; ++ai)
#pragma unroll
            for (int m = 0; m < 4; ++m) { const int row = row0 + ai * HALF + m * 16; float part = 0.f;
#pragma unroll
                for (int bj = 0; bj < 2; ++bj) {
                    const u32x4 gw = *(const u32x4*)(GB + (size_t)row * 512 + col0 + bj * HALF);
                    const f32x4 z0 = acc[ai][bj][m][0] + bv[bj][0], z1 = acc[ai][bj][m][1] + bv[bj][1];
                    float g[8] = {bflo(gw.x), bfhi(gw.x), bflo(gw.y), bfhi(gw.y), bflo(gw.z), bfhi(gw.z), bflo(gw.w), bfhi(gw.w)};
                    float z[8] = {z0[0], z0[1], z0[2], z0[3], z1[0], z1[1], z1[2], z1[3]}; float o[8];
#pragma unroll
                    for (int e = 0; e < 8; ++e) { const float s = __builtin_amdgcn_rcpf(1.0f + __builtin_amdgcn_exp2f(-z[e] * 1.4426950408889634f)); o[e] = g[e] * s; part += o[e] * o[e]; }
                    u32x4 w; w.x = cvt_pk_bf16(o[0], o[1]); w.y = cvt_pk_bf16(o[2], o[3]); w.z = cvt_pk_bf16(o[4], o[5]); w.w = cvt_pk_bf16(o[6], o[7]);
                    *(u32x4*)(MIX + (size_t)row * 1024 + col0 + bj * HALF) = w; }
                part += __shfl_xor(part, 16); part += __shfl_xor(part, 32);
                if (fq == 0) ss_add(ss, row, part); }
    }
};
struct EpiOut {
    static constexpr bool PERM = false, AFTER_DRAIN = false, MIDK = true;
    int l; int midk_t;
    __device__ __forceinline__ void midk(f32x4 (&acc)[2][2][4][2], const Unit& u, int wr, int wc, int fr, int fq) const {
        const ssq_t* ss_ssm = ep_ss(4 * l + 1); const ssq_t* ss_att = ss_ssm + EP_M;
        const int row0 = u.pm * BM + wr * 64 + fr;
#pragma unroll
        for (int ai = 0; ai < 2; ++ai)
#pragma unroll
            for (int m = 0; m < 4; ++m) { const int row = row0 + ai * HALF + m * 16;
                const float ra = sqrtf((ss_get(ss_att, row) * (1.0f / 512.0f) + 1e-6f) / (ss_get(ss_ssm, row) * (1.0f / 512.0f) + 1e-6f));
#pragma unroll
                for (int bj = 0; bj < 2; ++bj)
#pragma unroll
                    for (int n = 0; n < 2; ++n) acc[ai][bj][m][n] *= ra; }
    }
    __device__ __forceinline__ void operator()(const f32x4 (&acc)[2][2][4][2], const Unit& u, int wr, int wc, int fr, int fq) const {
        const ssq_t* ss_att = ep_ss(4 * l + 2); ssq_t* ss2 = (ssq_t*)ss_att + EP_M; const float* x = ep_x(); bf16_t* HB = ep_hb();
        const int row0 = u.pm * BM + wr * 64 + fr, col0 = u.pn * BM + wc * 32 + 4 * fq;
#pragma unroll
        for (int ai = 0; ai < 2; ++ai)
#pragma unroll
            for (int m = 0; m < 4; ++m) { const int row = row0 + ai * HALF + m * 16; const float r2 = rsqrtf(ss_get(ss_att, row) * (1.0f / 512.0f) + 1e-6f); float part = 0.f;
                const size_t off = (size_t)row * 1024 + col0;
#pragma unroll
                for (int bj = 0; bj < 2; ++bj)
#pragma unroll
                    for (int n = 0; n < 2; ++n) { f32x4 bs;
                        if (l == 0) bs = *(const f32x4*)(x + off + bj * HALF + n * 16);
                        else { const u32x2 hw = *(const u32x2*)(HB + off + bj * HALF + n * 16); bs = (f32x4){bflo(hw.x), bfhi(hw.x), bflo(hw.y), bfhi(hw.y)}; }
                        const f32x4 o = bs + acc[ai][bj][m][n] * r2; part += (o[0] * o[0] + o[1] * o[1]) + (o[2] * o[2] + o[3] * o[3]);
                        u32x2 w; w.x = cvt_pk_bf16(o[0], o[1]); w.y = cvt_pk_bf16(o[2], o[3]); *(u32x2*)(HB + off + bj * HALF + n * 16) = w; }
                part += __shfl_xor(part, 16); part += __shfl_xor(part, 32);
                if (fq == 0) ss_add(ss2, row, part); }
    }
};
struct EpiUp {
    static constexpr bool PERM = true, AFTER_DRAIN = false, MIDK = false;
    bf16_t* O; const ssq_t* ss; int midk_t;
    __device__ __forceinline__ void midk(f32x4 (&)[2][2][4][2], const Unit&, int, int, int, int) const {}
    __device__ __forceinline__ void operator()(const f32x4 (&acc)[2][2][4][2], const Unit& u, int wr, int wc, int fr, int fq) const {
        const int row0 = u.pm * BM + wr * 64 + fr, col0 = u.pn * BM + wc * 32 + 8 * fq;
#pragma unroll
        for (int ai = 0; ai < 2; ++ai)
#pragma unroll
            for (int m = 0; m < 4; ++m) { const int row = row0 + ai * HALF + m * 16; const float rs = rsqrtf(ss_get(ss, row) * (1.0f / 1024.0f) + 1e-6f);
                bf16_t* rowp = O + (size_t)row * 4096 + col0;
#pragma unroll
                for (int bj = 0; bj < 2; ++bj) { f32x4 v0 = acc[ai][bj][m][0] * rs, v1 = acc[ai][bj][m][1] * rs;
#pragma unroll
                    for (int e = 0; e < 4; ++e) { v0[e] = fmaxf(v0[e], 0.f); v0[e] *= v0[e]; v1[e] = fmaxf(v1[e], 0.f); v1[e] *= v1[e]; }
                    u32x4 w; w.x = cvt_pk_bf16(v0[0], v0[1]); w.y = cvt_pk_bf16(v0[2], v0[3]); w.z = cvt_pk_bf16(v1[0], v1[1]); w.w = cvt_pk_bf16(v1[2], v1[3]);
                    *(u32x4*)(rowp + bj * HALF) = w; } }
    }
};
struct EpiDown {
    static constexpr bool PERM = false, AFTER_DRAIN = false, MIDK = false;
    bf16_t* HB; ssq_t* ssn; int midk_t;
    __device__ __forceinline__ void midk(f32x4 (&)[2][2][4][2], const Unit&, int, int, int, int) const {}
    __device__ __forceinline__ void operator()(const f32x4 (&acc)[2][2][4][2], const Unit& u, int wr, int wc, int fr, int fq) const {
        const int row0 = u.pm * BM + wr * 64 + fr, col0 = u.pn * BM + wc * 32 + 4 * fq;
#pragma unroll
        for (int ai = 0; ai < 2; ++ai)
#pragma unroll
            for (int m = 0; m < 4; ++m) { const int row = row0 + ai * HALF + m * 16; float part = 0.f;
                const size_t off = (size_t)row * 1024 + col0;
#pragma unroll
                for (int bj = 0; bj < 2; ++bj)
#pragma unroll
                    for (int n = 0; n < 2; ++n) { const u32x2 hw = *(const u32x2*)(HB + off + bj * HALF + n * 16);
                        const f32x4 o = (f32x4){bflo(hw.x), bfhi(hw.x), bflo(hw.y), bfhi(hw.y)} + acc[ai][bj][m][n]; part += (o[0] * o[0] + o[1] * o[1]) + (o[2] * o[2] + o[3] * o[3]);
                        u32x2 w; w.x = cvt_pk_bf16(o[0], o[1]); w.y = cvt_pk_bf16(o[2], o[3]); *(u32x2*)(HB + off + bj * HALF + n * 16) = w; }
                part += __shfl_xor(part, 16); part += __shfl_xor(part, 32);
                if (fq == 0) ss_add(ssn, row, part); }
    }
};
template <class Epi, class Sched, bool ALIGN_EPI = false, bool SP2 = false>
__device__ __forceinline__ void gemm_phase(PG8_LAS unsigned char* lds, const Gemm g, const Sched& S, const Epi& E) {
    int tid_ = threadIdx.x; asm volatile("" : "+v"(tid_));
    const int tid = tid_, wid = __builtin_amdgcn_readfirstlane(tid >> 6), lane = tid & 63, wr = wid >> 2, wc = wid & 3, fr = lane & 15, fq = lane >> 4;
    const int K = g.K, nt = K / BK;
    unsigned voffA[2], voffB[2];
#pragma unroll
    for (int i = 0; i < 2; ++i) { int R, C; stage_rc(tid * 16 + i * 8192, R, C); const int Rb = Epi::PERM ? ((R & ~31) + perm32(R & 31)) : R;
        voffA[i] = (unsigned)(R * K + C) * 2u; voffB[i] = (unsigned)(Rb * K + C) * 2u; }
    const size_t kstep = (size_t)(BK * 2);
    const size_t hstep = (size_t)HALF * K * 2;
    const size_t tstep = 2 * hstep;
    const unsigned ldsw = (unsigned)wid * 1024u;
    const int aoff = lds_byte(wr * 64 + fr, fq * 8), boff = lds_byte(wc * 32 + fr, fq * 8);
#define PG8_SA(b, h) (((b) * 2 + (h)) * HTB)
#define PG8_SB(b, h) ((4 + (b) * 2 + (h)) * HTB)
#define PG8_STAGE(bufoff, gbase, voff) do { _Pragma("unroll") for (int _i = 0; _i < 2; ++_i) \
        __builtin_amdgcn_global_load_lds((const unsigned*)((const char*)(gbase) + (voff)[_i]), (PG8_LAS unsigned*)(lds + (bufoff) + ldsw + _i * 8192), 16, 0, 0); } while (0)
#define PG8_LDA(dst, b, h) do { _Pragma("unroll") for (int m = 0; m < 4; ++m) _Pragma("unroll") for (int k = 0; k < 2; ++k) dst[m][k] = *(const PG8_LAS bf16x8*)(lds + PG8_SA(b, h) + aoff + m * 2048 + k * 1024); } while (0)
#define PG8_LDB(dst, b, h) do { _Pragma("unroll") for (int n = 0; n < 2; ++n) _Pragma("unroll") for (int k = 0; k < 2; ++k) dst[n][k] = *(const PG8_LAS bf16x8*)(lds + PG8_SB(b, h) + boff + n * 2048 + k * 1024); } while (0)
#define PG8_MMA(ai, bj, At, Bt) do { __builtin_amdgcn_s_setprio(1); _Pragma("unroll") for (int m = 0; m < 4; ++m) _Pragma("unroll") for (int n = 0; n < 2; ++n) _Pragma("unroll") for (int k = 0; k < 2; ++k) \
        acc[ai][bj][m][n] = __builtin_amdgcn_mfma_f32_16x16x32_bf16(Bt[n][k], At[m][k], acc[ai][bj][m][n], 0, 0, 0); __builtin_amdgcn_s_setprio(0); } while (0)
#define PG8_WAIT_V(n) asm volatile("s_waitcnt vmcnt(" #n ")" ::: "memory")
#define PG8_WAIT_L(n) asm volatile("s_waitcnt lgkmcnt(" #n ")" ::: "memory")
#define PG8_BAR __builtin_amdgcn_s_barrier()
#define PG8_SCHED __builtin_amdgcn_sched_barrier(0)
    Unit cur, nxt; int ui = 0;
    if (!S.next(0, cur)) return;
    f32x4 acc[2][2][4][2];
#pragma unroll
    for (int a = 0; a < 2; ++a)
#pragma unroll
        for (int b = 0; b < 2; ++b)
#pragma unroll
            for (int m = 0; m < 4; ++m)
#pragma unroll
                for (int n = 0; n < 2; ++n) acc[a][b][m][n] = (f32x4){0.f, 0.f, 0.f, 0.f};
    bf16x8 At[4][2], B0[2][2], B1[2][2];
    const char* cA = (const char*)g.A + (size_t)cur.pm * tstep; const char* cB = (const char*)g.Bt + (size_t)cur.pn * tstep;
    S.a_ready(cur);
    if constexpr (SP2) {
        PG8_STAGE(PG8_SB(0, 0), cB, voffB); PG8_STAGE(PG8_SB(0, 1), cB + hstep, voffB); PG8_STAGE(PG8_SA(0, 0), cA, voffA); PG8_STAGE(PG8_SA(0, 1), cA + hstep, voffA);
        if (wr == 1) PG8_BAR;
        PG8_WAIT_V(2); PG8_BAR;
        PG8_STAGE(PG8_SB(1, 0), cB + kstep, voffB); PG8_STAGE(PG8_SA(1, 0), cA + kstep, voffA); PG8_STAGE(PG8_SB(1, 1), cB + hstep + kstep, voffB);
        PG8_WAIT_V(6); PG8_BAR;
    } else {
        PG8_STAGE(PG8_SB(0, 0), cB, voffB); PG8_STAGE(PG8_SA(0, 0), cA, voffA); PG8_STAGE(PG8_SB(0, 1), cB + hstep, voffB); PG8_STAGE(PG8_SA(0, 1), cA + hstep, voffA);
        if (wr == 1) PG8_BAR;
        PG8_WAIT_V(4); PG8_BAR;
        PG8_STAGE(PG8_SB(1, 0), cB + kstep, voffB); PG8_STAGE(PG8_SA(1, 0), cA + kstep, voffA); PG8_STAGE(PG8_SB(1, 1), cB + hstep + kstep, voffB);
        PG8_WAIT_V(6); PG8_BAR;
    }
    for (;;) {
        const bool has_next = S.next(ui + 1, nxt);
        const char* nA = has_next ? (const char*)g.A + (size_t)nxt.pm * tstep : cA; const char* nB = has_next ? (const char*)g.Bt + (size_t)nxt.pn * tstep : cB;
        for (int t = 0; t < nt; t += 2) {
            if constexpr (Epi::MIDK) { if (t == E.midk_t) E.midk(acc, cur, wr, wc, fr, fq); }
            const bool last = (t == nt - 2);
            const char* a1 = cA + (size_t)(t + 1) * kstep;
            const char* a2 = last ? nA : cA + (size_t)(t + 2) * kstep; const char* b2 = last ? nB : cB + (size_t)(t + 2) * kstep;
            const char* a3 = a2 + kstep; const char* b3 = b2 + kstep;
            if (last && has_next) S.a_ready(nxt);
            if constexpr (SP2) {
            PG8_LDB(B0, 0, 0); PG8_LDB(B1, 0, 1); PG8_SCHED; PG8_LDA(At, 0, 0); PG8_STAGE(PG8_SA(1, 1), a1 + hstep, voffA);
            PG8_WAIT_V(8); PG8_WAIT_L(0); PG8_BAR; PG8_MMA(0, 0, At, B0); PG8_MMA(0, 1, At, B1); PG8_BAR; PG8_SCHED;
            PG8_LDA(At, 0, 1); PG8_STAGE(PG8_SB(0, 0), b2, voffB); PG8_STAGE(PG8_SB(0, 1), b2 + hstep, voffB); PG8_STAGE(PG8_SA(0, 0), a2, voffA);
            PG8_WAIT_V(8); PG8_WAIT_L(0); PG8_BAR; PG8_MMA(1, 0, At, B0); PG8_MMA(1, 1, At, B1); PG8_BAR; PG8_SCHED;
            PG8_LDB(B0, 1, 0); PG8_LDB(B1, 1, 1); PG8_SCHED; PG8_LDA(At, 1, 0); PG8_STAGE(PG8_SA(0, 1), a2 + hstep, voffA);
            PG8_WAIT_V(8); PG8_WAIT_L(0); PG8_BAR; PG8_MMA(0, 0, At, B0); PG8_MMA(0, 1, At, B1); PG8_BAR; PG8_SCHED;
            PG8_LDA(At, 1, 1); PG8_STAGE(PG8_SB(1, 0), b3, voffB); PG8_STAGE(PG8_SB(1, 1), b3 + hstep, voffB); PG8_STAGE(PG8_SA(1, 0), a3, voffA);
            PG8_WAIT_V(8); PG8_WAIT_L(0); PG8_BAR; PG8_MMA(1, 0, At, B0); PG8_MMA(1, 1, At, B1); PG8_BAR; PG8_SCHED;
            } else {
            PG8_LDB(B0, 0, 0); PG8_SCHED; PG8_LDA(At, 0, 0); PG8_STAGE(PG8_SA(1, 1), a1 + hstep, voffA);
            PG8_WAIT_L(8); PG8_BAR; PG8_WAIT_L(0); PG8_MMA(0, 0, At, B0); PG8_BAR; PG8_SCHED;
            PG8_LDB(B1, 0, 1); PG8_STAGE(PG8_SB(0, 0), b2, voffB);
            PG8_BAR; PG8_WAIT_L(0); PG8_MMA(0, 1, At, B1); PG8_BAR;
            PG8_LDA(At, 0, 1); PG8_STAGE(PG8_SA(0, 0), a2, voffA);
            PG8_BAR; PG8_WAIT_L(0); PG8_MMA(1, 0, At, B0); PG8_BAR; PG8_SCHED;
            PG8_STAGE(PG8_SB(0, 1), b2 + hstep, voffB);
            PG8_WAIT_V(6); PG8_BAR; PG8_MMA(1, 1, At, B1); PG8_BAR;
            PG8_LDB(B0, 1, 0); PG8_SCHED; PG8_LDA(At, 1, 0); PG8_STAGE(PG8_SA(0, 1), a2 + hstep, voffA);
            PG8_WAIT_L(8); PG8_BAR; PG8_WAIT_L(0); PG8_MMA(0, 0, At, B0); PG8_BAR; PG8_SCHED;
            PG8_LDB(B1, 1, 1); PG8_STAGE(PG8_SB(1, 0), b3, voffB);
            PG8_BAR; PG8_WAIT_L(0); PG8_MMA(0, 1, At, B1); PG8_BAR;
            PG8_LDA(At, 1, 1); PG8_STAGE(PG8_SA(1, 0), a3, voffA);
            PG8_BAR; PG8_WAIT_L(0); PG8_MMA(1, 0, At, B0); PG8_BAR; PG8_SCHED;
            PG8_STAGE(PG8_SB(1, 1), b3 + hstep, voffB);
            PG8_WAIT_V(6); PG8_BAR; PG8_MMA(1, 1, At, B1); PG8_BAR;
            }
        }
        if constexpr (ALIGN_EPI) { if (wr == 0) PG8_BAR; }
        if constexpr (!Epi::AFTER_DRAIN) { E(acc, cur, wr, wc, fr, fq); S.done(cur); }
        if (!has_next) break;
#pragma unroll
        for (int a = 0; a < 2; ++a)
#pragma unroll
            for (int b = 0; b < 2; ++b)
#pragma unroll
                for (int m = 0; m < 4; ++m)
#pragma unroll
                    for (int n = 0; n < 2; ++n) acc[a][b][m][n] = (f32x4){0.f, 0.f, 0.f, 0.f};
        cur = nxt; cA = nA; cB = nB; ++ui;
        if constexpr (ALIGN_EPI) { if (wr == 1) PG8_BAR; }
    }
    PG8_WAIT_V(0);
    if constexpr (!ALIGN_EPI) { if (wr == 0) PG8_BAR; }
    PG8_BAR;
    if constexpr (Epi::AFTER_DRAIN) { E.fused(acc, cur, wr, wc, fr, fq, lds, wid, lane); S.done(cur); }
#undef PG8_SA
#undef PG8_SB
#undef PG8_STAGE
#undef PG8_LDA
#undef PG8_LDB
#undef PG8_MMA
#undef PG8_WAIT_V
#undef PG8_WAIT_L
#undef PG8_BAR
#undef PG8_SCHED
}
}

#define GAS __attribute__((address_space(1)))
#define LAS __attribute__((address_space(3)))
typedef unsigned short bf16;
typedef unsigned v4u __attribute__((ext_vector_type(4)));
typedef float f32x4 __attribute__((ext_vector_type(4)));
typedef short bf16x8 __attribute__((ext_vector_type(8)));
typedef GAS unsigned gu32;
typedef GAS unsigned long long gu64;
#define RLX_AGENT __ATOMIC_RELAXED, __HIP_MEMORY_SCOPE_AGENT
#define LDS_WAIT() asm volatile("s_waitcnt lgkmcnt(0)" ::: "memory")
#define VM_WAIT() asm volatile("s_waitcnt vmcnt(0)" ::: "memory")
__device__ __forceinline__ unsigned long long rt() { return __builtin_amdgcn_s_memrealtime(); }
__device__ __forceinline__ unsigned f2bf(float f) { unsigned u = __builtin_bit_cast(unsigned, f); return (u + 0x7fffu + ((u >> 16) & 1u)) >> 16; }
__device__ __forceinline__ unsigned pk2(float lo, float hi) { return f2bf(lo) | (f2bf(hi) << 16); }
#define XB_TMO      128
#define XB_XCNT(j)  (256  + 64 * (j))
#define XB_XSUB(j)  (1280 + 64 * (j))
#define XB_XGEN(j)  (2304 + 64 * (j))
#define XB_TOP      3328
#define XB_TOPGEN   3392
#define XCD_BAR_WORDS 3456
#define XB_SPIN_CAP (1u << 18)

__device__ __forceinline__ unsigned xb_ld(unsigned* p)              { return __hip_atomic_load(p, __ATOMIC_RELAXED, __HIP_MEMORY_SCOPE_AGENT); }
__device__ __forceinline__ unsigned xb_add(unsigned* p, unsigned v) { return __hip_atomic_fetch_add(p, v, __ATOMIC_RELAXED, __HIP_MEMORY_SCOPE_AGENT); }
__device__ __forceinline__ unsigned xb_xcc_id() { return (unsigned)__builtin_amdgcn_s_getreg((3 << 11) | 20) & 0xFu; }
#define XB_SPIN(cond, bar) do { unsigned _sp = 0; while (cond) { __builtin_amdgcn_s_sleep(1); \
    if ((++_sp & 255u) == 0u) { if (xb_ld(&(bar)[XB_TMO])) break; if (_sp > XB_SPIN_CAP) { atomicAdd(&(bar)[XB_TMO], 1u); break; } } } } while (0)

struct XcdBarrier {
    unsigned* bar; unsigned x;
    volatile LAS unsigned* st;
};

__device__ __forceinline__ XcdBarrier xcd_barrier_post(unsigned* bar, volatile LAS unsigned* st) {
    XcdBarrier b; b.bar = bar; b.x = xb_xcc_id(); b.st = st;
    if (threadIdx.x == 0) (void)xb_add(&bar[XB_XCNT(b.x)], 1u);
    return b;
}
__device__ __forceinline__ void xcd_barrier_complete(unsigned* bar, unsigned x, unsigned& nloc, unsigned& nx) {
    const unsigned G = gridDim.x * gridDim.y * gridDim.z;
    unsigned sum, cnt, mine, sp = 0u;
    for (;;) {
        sum = 0u; cnt = 0u; mine = 0u;
#pragma unroll
        for (unsigned j = 0; j < 16; ++j) { const unsigned c = xb_ld(&bar[XB_XCNT(j)]); sum += c; cnt += (c > 0u) ? 1u : 0u; mine = (j == x) ? c : mine; }
        if (sum == G) break;
        __builtin_amdgcn_s_sleep(1);
        if ((++sp & 255u) == 0u) { if (xb_ld(&bar[XB_TMO])) break; if (sp > XB_SPIN_CAP) { atomicAdd(&bar[XB_TMO], 1u); break; } }
    }
    nloc = mine > 0u ? mine : 1u; nx = cnt > 0u ? cnt : 1u;
}

__device__ __forceinline__ void xcd_barrier(const XcdBarrier& b) {
    asm volatile("s_waitcnt vmcnt(0)" ::: "memory");
    __syncthreads();
    if (threadIdx.x == 0) {
        unsigned* bar = b.bar; unsigned bx = b.x; asm volatile("" : "+s"(bar), "+s"(bx));
        __builtin_amdgcn_s_waitcnt(0);
        unsigned nloc = b.st[0], nx = b.st[1];
        if (nloc == 0u) { xcd_barrier_complete(bar, bx, nloc, nx); b.st[0] = nloc; b.st[1] = nx; }
        const unsigned old = xb_add(&bar[XB_XSUB(bx)], 1u);
        const unsigned gen = old / nloc;
        if (old + 1u == (gen + 1u) * nloc) {
            __builtin_amdgcn_fence(__ATOMIC_RELEASE, "agent");
            asm volatile("s_waitcnt vmcnt(0)" ::: "memory");
            const unsigned og = xb_add(&bar[XB_TOP], 1u);
            const unsigned tg = og / nx;
            if (og + 1u == (tg + 1u) * nx) xb_add(&bar[XB_TOPGEN], 1u);
            else XB_SPIN(xb_ld(&bar[XB_TOPGEN]) == tg, bar);
            __builtin_amdgcn_fence(__ATOMIC_ACQUIRE, "agent");
            xb_add(&bar[XB_XGEN(bx)], 1u);
            asm volatile("s_waitcnt vmcnt(0)" ::: "memory");
        } else {
            XB_SPIN(xb_ld(&bar[XB_XGEN(bx)]) == gen, bar);
            __builtin_amdgcn_fence(__ATOMIC_ACQUIRE, "agent");
            asm volatile("s_waitcnt vmcnt(0)" ::: "memory");
        }
    }
    __syncthreads();
}
#include <hip/hip_bf16.h>
#include <cmath>
namespace attn_body {
using bf16=__hip_bfloat16;
using bf16x8=__attribute__((ext_vector_type(8)))short;
using s16x4=__attribute__((ext_vector_type(4)))short;
using f32x16=__attribute__((ext_vector_type(16)))float;
using u32x4=__attribute__((ext_vector_type(4)))unsigned;
constexpr int BATCH=4,NHEAD=8,SEQ=4096,D=64,DM=NHEAD*D,OPITCH=1024;
constexpr int NW=8,QBLK=32,QB=QBLK*NW,KVBLK=64,NQB=SEQ/QB;
constexpr int ATTN_PITCH=DM, ATTN_UNIT_ROWS=QB;
__device__ __forceinline__ int crow(int r,int hi){return (r&3)+8*(r>>2)+4*hi;}
#define SBAR() __builtin_amdgcn_sched_barrier(0)
__device__ __forceinline__ void cmask(f32x16&p0,f32x16&p1,int jb,int qrel,int hi){
  const float NEG=-INFINITY; int kb=64*jb+4*hi;
  #pragma unroll
  for(int r=0;r<16;++r){int kv=kb+(r&3)+8*(r>>2); if(kv>qrel)p0[r]=NEG; if(kv+32>qrel)p1[r]=NEG;}
}

constexpr int NSLOT=3, SLOTB=9216;
constexpr int LDS_K=0, LDS_V=NSLOT*SLOTB, LDS_WS=2*NSLOT*SLOTB, LDS_OST=LDS_WS+NW*64*4, LDS_OFFT=LDS_OST+NW*4096, LDS_BYTES=LDS_OFFT+256;
constexpr float C2=0.125f*1.4426950408889634f;
__device__ __forceinline__ void glds16(const void*gsrc,unsigned lds_dst){unsigned keep;
  asm volatile("s_mov_b32 %0, m0\n\ts_mov_b32 m0, %2\n\ts_nop 0\n\tglobal_load_lds_dwordx4 %1, off\n\ts_mov_b32 m0, %0":"=&s"(keep):"v"(gsrc),"s"(lds_dst):"memory");}
__device__ __forceinline__ float max3f(float a,float b,float c){float r;asm("v_max3_f32 %0, %1, %2, %3":"=v"(r):"v"(a),"v"(b),"v"(c));return r;}
__device__ __forceinline__ float max2f(float a,float b){float r;asm("v_max_f32_e32 %0, %1, %2":"=v"(r):"v"(a),"v"(b));return r;}
__device__ __forceinline__ float fadd_s(float a,float b){float r;asm("v_add_f32_e32 %0, %1, %2":"=v"(r):"v"(a),"v"(b));return r;}
__device__ __forceinline__ float fsub_s(float a,float b){float r;asm("v_sub_f32_e32 %0, %1, %2":"=v"(r):"v"(a),"v"(b));return r;}
typedef float f32x2_t __attribute__((ext_vector_type(2))); typedef __bf16 bf16x2_t __attribute__((ext_vector_type(2)));
__device__ __forceinline__ unsigned cvtpk_s(float lo,float hi){f32x2_t v={lo,hi};bf16x2_t b=__builtin_convertvector(v,bf16x2_t);return __builtin_bit_cast(unsigned,b);}
#define WAIT_BAR_(N) asm volatile("s_waitcnt vmcnt(" #N ") lgkmcnt(0)\n\ts_barrier":::"memory")
#define WAIT_BAR(N,N0) do{ if(wid==0){WAIT_BAR_(N0);}else{WAIT_BAR_(N);} }while(0)
__device__ __forceinline__ bf16x8 mk_qaug(float x,unsigned himask){
  const unsigned w1=cvtpk_s(1.0f,x); const float r1=x-__uint_as_float(w1&0xffff0000u);
  const unsigned t=cvtpk_s(r1,0.f); const float r2=r1-__uint_as_float(t<<16); const unsigned w2=cvtpk_s(r1,r2);
  u32x4 w; w.x=0x3F803F80u&himask; w.y=w1&himask; w.z=w2&himask; w.w=0u; return __builtin_bit_cast(bf16x8,w);}

__device__ __forceinline__ void qkt(f32x16&p0,f32x16&p1,const char*Kslot,const bf16x8*qr,bf16x8 qa,int r32,int hi){
  const char*kb=Kslot+hi*1024+r32*16; const char*ka=Kslot+8192+r32*16;
  { const bf16x8 a0=*reinterpret_cast<const bf16x8*>(ka), a1=*reinterpret_cast<const bf16x8*>(ka+512); const f32x16 z=f32x16{};
    p0=__builtin_amdgcn_mfma_f32_32x32x16_bf16(a0,qa,z,0,0,0); p1=__builtin_amdgcn_mfma_f32_32x32x16_bf16(a1,qa,z,0,0,0); }
  #pragma unroll
  for(int d0=0;d0<4;++d0){
    const bf16x8 b0=*reinterpret_cast<const bf16x8*>(kb+d0*2048);
    const bf16x8 b1=*reinterpret_cast<const bf16x8*>(kb+d0*2048+512);
    {p0=__builtin_amdgcn_mfma_f32_32x32x16_bf16(b0,qr[d0],p0,0,0,0);p1=__builtin_amdgcn_mfma_f32_32x32x16_bf16(b1,qr[d0],p1,0,0,0);}}
}
typedef __attribute__((address_space(3))) const char* lds_cptr;
typedef short v4i16_t __attribute__((ext_vector_type(4)));
__device__ __forceinline__ void kload8(bf16x8*kf,lds_cptr kp){
  kf[0]=*(const __attribute__((address_space(3))) bf16x8*)(kp);      kf[1]=*(const __attribute__((address_space(3))) bf16x8*)(kp+512);
  kf[2]=*(const __attribute__((address_space(3))) bf16x8*)(kp+2048); kf[3]=*(const __attribute__((address_space(3))) bf16x8*)(kp+2560);
  kf[4]=*(const __attribute__((address_space(3))) bf16x8*)(kp+4096); kf[5]=*(const __attribute__((address_space(3))) bf16x8*)(kp+4608);
  kf[6]=*(const __attribute__((address_space(3))) bf16x8*)(kp+6144); kf[7]=*(const __attribute__((address_space(3))) bf16x8*)(kp+6656);
}
__device__ __forceinline__ void kloada(bf16x8*kf,lds_cptr kpa){ kf[8]=*(const __attribute__((address_space(3))) bf16x8*)(kpa); kf[9]=*(const __attribute__((address_space(3))) bf16x8*)(kpa+512); }
__device__ __forceinline__ void kload2(bf16x8*kf,lds_cptr kp,int j){ kf[2*j]=*(const __attribute__((address_space(3))) bf16x8*)(kp+j*2048); kf[2*j+1]=*(const __attribute__((address_space(3))) bf16x8*)(kp+j*2048+512); }
__device__ __forceinline__ s16x4 vtr(lds_cptr p){ return __builtin_bit_cast(s16x4,__builtin_amdgcn_ds_read_tr16_b64_v4i16((__attribute__((address_space(3))) v4i16_t*)p)); }
__device__ __forceinline__ float rowmax(const f32x16&p0,const f32x16&p1){
  float a=max3f(p0[0],p0[1],p1[0]),b=max3f(p0[2],p0[3],p1[1]);a=max3f(a,p1[2],p1[3]);
  #pragma unroll
  for(int r=4;r<16;r+=4){a=max3f(a,p0[r],p0[r+1]);b=max3f(b,p0[r+2],p0[r+3]);a=max3f(a,p1[r],p1[r+1]);b=max3f(b,p1[r+2],p1[r+3]);}
  const float m=max2f(a,b);
  auto rr=__builtin_amdgcn_permlane32_swap(__float_as_uint(m),__float_as_uint(m),false,false);
  return max2f(__uint_as_float(rr[0]),__uint_as_float(rr[1]));
}
__device__ __forceinline__ void pv(f32x16*o,int vb,bf16x8 pa0,bf16x8 pa1,bf16x8 pa2,bf16x8 pa3){
  #pragma unroll
  for(int d0=0;d0<2;++d0){s16x4 lo[4],hi[4];
    #pragma unroll
    for(int ks=0;ks<4;++ks){
      asm volatile("ds_read_b64_tr_b16 %0,%1 offset:%c2":"=&v"(lo[ks]):"v"(vb),"i"(d0*4096+ks*1024):"memory");
      asm volatile("ds_read_b64_tr_b16 %0,%1 offset:%c2":"=&v"(hi[ks]):"v"(vb),"i"(d0*4096+ks*1024+512):"memory");}
    asm volatile("s_waitcnt lgkmcnt(0)":::"memory");SBAR();
    #define PK(k) (bf16x8){lo[k][0],lo[k][1],lo[k][2],lo[k][3],hi[k][0],hi[k][1],hi[k][2],hi[k][3]}
    o[d0]=__builtin_amdgcn_mfma_f32_32x32x16_bf16(pa0,PK(0),o[d0],0,0,0);
    o[d0]=__builtin_amdgcn_mfma_f32_32x32x16_bf16(pa1,PK(1),o[d0],0,0,0);
    o[d0]=__builtin_amdgcn_mfma_f32_32x32x16_bf16(pa2,PK(2),o[d0],0,0,0);
    o[d0]=__builtin_amdgcn_mfma_f32_32x32x16_bf16(pa3,PK(3),o[d0],0,0,0);
    #undef PK
  }
}

#ifndef ATTN_STORE16
#define ATTN_STORE16(p,v) (*(u32x4*)(p)=(v))
#endif
template<int THRL> __device__ __forceinline__ void attn_unit(int b,int h,int qb,const bf16*Q,const bf16*__restrict__ K,const bf16*__restrict__ V,const bf16*__restrict__ KAUG,const float*CSL,const float*CST,bf16*O,unsigned long long*ssq,char*shm){
  int tid_=threadIdx.x; asm volatile("":"+v"(tid_));
  const int tid=tid_,lane=tid&63,r32=lane&31,hi=lane>>5; const int wid=__builtin_amdgcn_readfirstlane(tid>>6);
  const long rowbase=(long)b*SEQ; const int q0=qb*QB; const int bh=b*NHEAD+h;
  const bf16*Qw=Q+(rowbase+q0+wid*QBLK)*DM+h*D;
  const bf16*Kh=K+rowbase*DM+h*D,*Vh=V+rowbase*DM+h*D;
  const unsigned lds0=(unsigned)(uintptr_t)shm;
  float*wsf=(float*)(shm+LDS_WS)+wid*64;
  const bf16*ksrc=Kh+(long)lane*DM+wid*8;
  const bf16*vsrc=Vh+(long)(16*(wid&3)+(lane>>2))*DM+(wid>>2)*32+(lane&3)*8;
  const unsigned kdst=lds0+LDS_K+wid*1024, vdst=lds0+LDS_V+wid*1024, kadst=lds0+LDS_K+8192;
  const bf16*kasrc=KAUG+((long)bh*SEQ+lane)*8;
  __attribute__((address_space(3))) float*offt=(__attribute__((address_space(3))) float*)((__attribute__((address_space(3))) char*)shm+LDS_OFFT);
  if(wid==0){ const float v=CST[(long)bh*64+lane]; float inc=v;
    _Pragma("unroll") for(int o_=1;o_<64;o_<<=1){ const float t_=__shfl_up(inc,o_); if(lane>=o_)inc+=t_; }
    offt[lane]=inc-v; }
  const unsigned himask=hi?0u:0xffffffffu;
  #define DMA_K(t,slot) do{ glds16(ksrc+(long)(t)*KVBLK*DM,(unsigned)__builtin_amdgcn_readfirstlane(kdst+(slot))); if(wid==0)glds16(kasrc+(long)(t)*KVBLK*8,(unsigned)__builtin_amdgcn_readfirstlane(kadst+(slot))); }while(0)
  #define DMA_V(t,slot) glds16(vsrc+(long)(t)*KVBLK*DM,(unsigned)__builtin_amdgcn_readfirstlane(vdst+(slot)))
  const int vb0=(int)(lds0+LDS_V)+((lane>>4)&1)*32+(lane&3)*8+(4*hi+((lane&15)>>2))*64;
  const char*Kbase=shm+LDS_K; bf16x8 kf[10];
  const lds_cptr shm3=(lds_cptr)shm; const lds_cptr kp0=shm3+LDS_K+hi*1024+r32*16; const lds_cptr kpa=shm3+LDS_K+8192+r32*16; const lds_cptr vp0=shm3+LDS_V+((lane>>4)&1)*32+(lane&3)*8+(4*hi+((lane&15)>>2))*64;
  const int NT=(q0+QB)/KVBLK;
  DMA_K(0,0);DMA_V(0,0);DMA_K(1,SLOTB);
  bf16x8 qr[4];
  #pragma unroll
  for(int d0=0;d0<4;++d0)qr[d0]=*reinterpret_cast<const bf16x8*>(&Qw[(long)r32*DM+d0*16+hi*8]);
  const float csl_i=CSL[(long)bh*SEQ+q0+wid*QBLK+r32];
  float cm=0.f,l_reg=0.f;f32x16 o[2];o[0]=f32x16{};o[1]=f32x16{};
  const int qrel=wid*QBLK+r32;
  #define CMASK(P0,P1,t) do{int jb_=(t)-(NT-4); if(jb_>=0)cmask(P0,P1,jb_,qrel,hi);}while(0)
  bool resc=false;
  #define START(P0,P1) do{ const float rm=rowmax(P0,P1); resc=false; \
    { const float dl=rm; cm=fsub_s(cm,dl); \
      _Pragma("unroll") for(int r=0;r<16;++r){P0[r]=fsub_s(P0[r],dl);P1[r]=fsub_s(P1[r],dl);} } \
    _Pragma("unroll") for(int r=0;r<16;++r)P0[r]=__builtin_amdgcn_exp2f(P0[r]); }while(0)
  #define RESC() do{ if(resc){ asm volatile("s_waitcnt lgkmcnt(0)":::"memory"); \
      _Pragma("unroll") for(int d_=0;d_<2;++d_) _Pragma("unroll") for(int r=0;r<16;++r)o[d_][r]*=wsf[crow(r,hi)]; } }while(0)
  f32x16 pA0,pA1,pB0,pB1;
  int sl_prev=0,sl_cur=0,sl_next=SLOTB;
  #define ROT() do{sl_prev=sl_cur;sl_cur=sl_next;sl_next=(sl_next==(NSLOT-1)*SLOTB)?0:sl_next+SLOTB;}while(0)
  DMA_K(2,2*SLOTB);
  WAIT_BAR(3,5);
  cm=csl_i+offt[(q0+wid*QBLK)>>6];
  qkt(pA0,pA1,Kbase,qr,mk_qaug(cm,himask),r32,hi);asm volatile("s_nop 15\n\ts_nop 7":"+v"(pA0),"+v"(pA1));CMASK(pA0,pA1,0);
  START(pA0,pA1);
  _Pragma("unroll") for(int r=0;r<16;++r)pA1[r]=__builtin_amdgcn_exp2f(pA1[r]);
  WAIT_BAR(0,0);
  DMA_K(3,0);DMA_V(1,SLOTB);
  ROT();
  kload8(kf,kp0+sl_cur); kloada(kf,kpa+sl_cur);
  WAIT_BAR(2,3);
  s16x4 vlo[8],vhi[8]; u32x4 pw0,pw1,pw2,pw3;
  #define PKW(P,B) cvtpk_s(P[B],P[B+1])
  #define PAF(k) __builtin_bit_cast(bf16x8,pw##k)
  #define VFR(i) (bf16x8){vlo[i][0],vlo[i][1],vlo[i][2],vlo[i][3],vhi[i][0],vhi[i][1],vhi[i][2],vhi[i][3]}
  #define PIN(x) asm volatile("":"+v"(x))
  #define MX3(a,b,c) __builtin_fmaxf(__builtin_fmaxf((a),(b)),(c))
  #define GAPA(MF,A0,A1,A2,A3,W0,W1,PW) do{ MF; sacc+=A0; sacc+=A1; sacc+=A2; sacc+=A3; PIN(sacc); W0; W1; PIN(PW); SBAR(); }while(0)
  #define EX(v) __builtin_amdgcn_exp2f(v)
  #define GAPB(MF,X,B) do{ MF; X[B]=EX(X[B]); X[B+1]=EX(X[B+1]); X[B+2]=EX(X[B+2]); X[B+3]=EX(X[B+3]); PIN(X); SBAR(); }while(0)
  #define VRD(i) do{ vlo[i]=vtr(vp_+(((i)>>2)*4096+((i)&3)*1024)); vhi[i]=vtr(vp_+(((i)>>2)*4096+((i)&3)*1024+512)); }while(0)
  #define KRD(G,j) do{ if(G){ kload2(kf,kp0+sl_next,j); SBAR(); } }while(0)
  #define KRDA(G) do{ if(G){ kloada(kf,kpa+sl_next); SBAR(); } }while(0)
  #define STEP(C0,C1,P0,P1,t,GK,GV,GL) do{ SBAR(); \
    const lds_cptr vp_=vp0+sl_prev; \
    { const bf16x8 qa_=mk_qaug(cm-offt[t],himask); const f32x16 z_=f32x16{}; SBAR(); \
      C0=__builtin_amdgcn_mfma_f32_32x32x16_bf16(kf[8],qa_,z_,0,0,0); SBAR(); C1=__builtin_amdgcn_mfma_f32_32x32x16_bf16(kf[9],qa_,z_,0,0,0); SBAR(); } \
    VRD(0); SBAR(); float sacc=(P0[0]+P0[1]); \
    GAPA(C0=__builtin_amdgcn_mfma_f32_32x32x16_bf16(kf[0],qr[0],C0,0,0,0), P0[2],P0[3],P0[4],P0[5],     pw0[0]=PKW(P0,0), pw0[1]=PKW(P0,2), pw0); \
    VRD(4); SBAR(); GAPA(C1=__builtin_amdgcn_mfma_f32_32x32x16_bf16(kf[1],qr[0],C1,0,0,0), P0[6],P0[7],P0[8],P0[9],     pw0[2]=PKW(P0,4), pw0[3]=PKW(P0,6), pw0); \
    VRD(1); SBAR(); GAPA(C0=__builtin_amdgcn_mfma_f32_32x32x16_bf16(kf[2],qr[1],C0,0,0,0),   P0[10],P0[11],P0[12],P0[13], pw1[0]=PKW(P0,8), pw1[1]=PKW(P0,10), pw1); \
    VRD(5); SBAR(); GAPA(C1=__builtin_amdgcn_mfma_f32_32x32x16_bf16(kf[3],qr[1],C1,0,0,0),   P0[14],P0[15],P1[0],P1[1],   pw1[2]=PKW(P0,12),pw1[3]=PKW(P0,14), pw1); \
    VRD(2); SBAR(); GAPA(C0=__builtin_amdgcn_mfma_f32_32x32x16_bf16(kf[4],qr[2],C0,0,0,0),   P1[2],P1[3],P1[4],P1[5],     pw2[0]=PKW(P1,0), pw2[1]=PKW(P1,2), pw2); \
    VRD(6); SBAR(); GAPA(C1=__builtin_amdgcn_mfma_f32_32x32x16_bf16(kf[5],qr[2],C1,0,0,0),   P1[6],P1[7],P1[8],P1[9],     pw2[2]=PKW(P1,4), pw2[3]=PKW(P1,6), pw2); \
    VRD(3); SBAR(); GAPA(C0=__builtin_amdgcn_mfma_f32_32x32x16_bf16(kf[6],qr[3],C0,0,0,0),   P1[10],P1[11],P1[12],P1[13], pw3[0]=PKW(P1,8), pw3[1]=PKW(P1,10), pw3); \
    VRD(7); SBAR(); GAPA(C1=__builtin_amdgcn_mfma_f32_32x32x16_bf16(kf[7],qr[3],C1,0,0,0),   P1[14],P1[15],0.f,0.f,       pw3[2]=PKW(P1,12),pw3[3]=PKW(P1,14), pw3); \
    l_reg+=sacc; \
    if(GK){DMA_K((t)+3,sl_cur);} if(GV){DMA_V((t)+1,sl_next);} \
    CMASK(C0,C1,t); \
    { float a=MX3(C0[0],C0[1],C1[0]),b=MX3(C0[2],C0[3],C1[1]); a=MX3(a,C1[2],C1[3]); \
      _Pragma("unroll") for(int r=4;r<16;r+=4){a=MX3(a,C0[r],C0[r+1]);b=MX3(b,C0[r+2],C0[r+3]);a=MX3(a,C1[r],C1[r+1]);b=MX3(b,C1[r+2],C1[r+3]);} \
      float rm=__builtin_fmaxf(a,b); { auto rr=__builtin_amdgcn_permlane32_swap(__float_as_uint(rm),__float_as_uint(rm),false,false); rm=__builtin_fmaxf(__uint_as_float(rr[0]),__uint_as_float(rr[1])); } \
      resc=false; \
      if(__builtin_expect(__any(rm>(float)THRL),0)){ const float dl=__builtin_fmaxf(rm,0.f); cm-=dl; \
        _Pragma("unroll") for(int r=0;r<16;++r){C0[r]-=dl;C1[r]-=dl;} \
        const float f=__builtin_amdgcn_exp2f(-dl); l_reg*=f; if(hi==0)wsf[r32]=f; resc=true; } } \
    SBAR(); \
    GAPB(o[0]=__builtin_amdgcn_mfma_f32_32x32x16_bf16(PAF(0),VFR(0),o[0],0,0,0), C0,0); \
    GAPB(o[1]=__builtin_amdgcn_mfma_f32_32x32x16_bf16(PAF(0),VFR(4),o[1],0,0,0), C0,4); \
    KRD(GL,0); GAPB(o[0]=__builtin_amdgcn_mfma_f32_32x32x16_bf16(PAF(1),VFR(1),o[0],0,0,0), C0,8); \
    KRD(GL,1); GAPB(o[1]=__builtin_amdgcn_mfma_f32_32x32x16_bf16(PAF(1),VFR(5),o[1],0,0,0), C0,12); \
    KRD(GL,2); GAPB(o[0]=__builtin_amdgcn_mfma_f32_32x32x16_bf16(PAF(2),VFR(2),o[0],0,0,0), C1,0); \
    KRD(GL,3); GAPB(o[1]=__builtin_amdgcn_mfma_f32_32x32x16_bf16(PAF(2),VFR(6),o[1],0,0,0), C1,4); \
    KRDA(GL); GAPB(o[0]=__builtin_amdgcn_mfma_f32_32x32x16_bf16(PAF(3),VFR(3),o[0],0,0,0), C1,8); \
    GAPB(o[1]=__builtin_amdgcn_mfma_f32_32x32x16_bf16(PAF(3),VFR(7),o[1],0,0,0), C1,12); \
    }while(0)
  int t=1;
  #undef CMASK
  #define CMASK(P0,P1,t) do{}while(0)
  for(;t+5<NT;t+=2){
    STEP(pB0,pB1,pA0,pA1,t,true,true,true);     WAIT_BAR(2,3); RESC(); ROT();
    STEP(pA0,pA1,pB0,pB1,t+1,true,true,true);   WAIT_BAR(2,3); RESC(); ROT();
  }
  #undef CMASK
  #define CMASK(P0,P1,t) do{int jb_=(t)-(NT-4); if(jb_>=0)cmask(P0,P1,jb_,qrel,hi);}while(0)
  #define ENDW(tt) do{ if((tt)+3<NT){WAIT_BAR(2,3);} else if((tt)+2<NT){WAIT_BAR(1,1);} else {WAIT_BAR(0,0);} }while(0)
  for(;t+1<NT;t+=2){
    STEP(pB0,pB1,pA0,pA1,t,(t+3<NT),(t+1<NT),(t+1<NT));       ENDW(t);   RESC(); ROT();
    STEP(pA0,pA1,pB0,pB1,t+1,(t+4<NT),(t+2<NT),(t+2<NT));     ENDW(t+1); RESC(); ROT();
  }
  STEP(pB0,pB1,pA0,pA1,NT-1,false,false,false); RESC();
  { float sacc=pB0[0]+pB0[1]; _Pragma("unroll") for(int r=2;r<16;++r)sacc+=pB0[r]; _Pragma("unroll") for(int r=0;r<16;++r)sacc+=pB1[r]; l_reg+=sacc;
    pw0=(u32x4){PKW(pB0,0),PKW(pB0,2),PKW(pB0,4),PKW(pB0,6)};pw1=(u32x4){PKW(pB0,8),PKW(pB0,10),PKW(pB0,12),PKW(pB0,14)};pw2=(u32x4){PKW(pB1,0),PKW(pB1,2),PKW(pB1,4),PKW(pB1,6)};pw3=(u32x4){PKW(pB1,8),PKW(pB1,10),PKW(pB1,12),PKW(pB1,14)};
    SBAR(); pv(o,vb0+sl_cur,PAF(0),PAF(1),PAF(2),PAF(3)); }
  #undef PKW
  #undef PAF
  #undef VFR
  #undef PIN
  #undef MX3
  #undef GAPA
  #undef GAPB
  #undef EX
  #undef VRD
  #undef KRD
  #undef KRDA
  #undef STEP
  #undef ENDW
  {auto rr=__builtin_amdgcn_permlane32_swap(__float_as_uint(l_reg),__float_as_uint(l_reg),false,false);l_reg=__uint_as_float(rr[0])+__uint_as_float(rr[1]);}
  if(hi==0)wsf[32+r32]=l_reg;asm volatile("s_waitcnt lgkmcnt(0)":::"memory");
  float rli[16];
  #pragma unroll
  for(int r=0;r<16;++r)rli[r]=__builtin_amdgcn_rcpf(wsf[32+crow(r,hi)]);
  bf16*Ow=O+(rowbase+q0+wid*QBLK)*OPITCH+h*D; unsigned long long*ssw=ssq+rowbase+q0+wid*QBLK;
  { bf16*stg=(bf16*)(shm+LDS_OST)+wid*2048;
    #pragma unroll
    for(int r=0;r<16;++r){const int orow=crow(r,hi);
      #pragma unroll
      for(int d0=0;d0<2;++d0)stg[orow*64+d0*32+r32]=__float2bfloat16(o[d0][r]*rli[r]);}
    asm volatile("s_waitcnt lgkmcnt(0)":::"memory");
    #pragma unroll
    for(int i=0;i<4;++i){const int row=i*8+(lane>>3),ch=lane&7; const u32x4 v=*(const u32x4*)(stg+row*64+ch*8); ATTN_STORE16(Ow+(long)row*OPITCH+ch*8,v);
      float sq=0.f;
      _Pragma("unroll") for(int e=0;e<4;++e){ const float a_=__uint_as_float(v[e]<<16), b_=__uint_as_float(v[e]&0xffff0000u); sq+=a_*a_+b_*b_; }
      sq+=__shfl_xor(sq,1); sq+=__shfl_xor(sq,2); sq+=__shfl_xor(sq,4); if(ch==0)atomicAdd(ssw+row,(unsigned long long)(sq*16777216.0f)); } }
  asm volatile("s_waitcnt lgkmcnt(0)\n\ts_barrier":::"memory");
  #undef DMA_K
  #undef DMA_V
  #undef CMASK
  #undef START
  #undef RESC
  #undef ROT
}
constexpr int ATTN_LDS_BYTES=LDS_BYTES;
struct AttnTensors { const bf16* Q; const bf16* K; const bf16* V; const bf16* KAUG; const float* CSL; const float* CST; bf16* O; unsigned long long* ssq; };
struct AttnUnit { int bh; int qb; };
struct StaticOrder {
  int vcu, G;
  __device__ __forceinline__ explicit StaticOrder(int grid,int block):vcu((grid%8==0)?(block%8)*(grid/8)+block/8:block),G(grid){}
  __device__ __forceinline__ bool next(int i,AttnUnit&u)const{ const int j=vcu+i*G; if(j>=512)return false; const int s=j&7; u.bh=(j&255)>>3; u.qb=(j<256)?15-s:s; return true; }
  __device__ __forceinline__ void a_ready(const AttnUnit&)const{}
  __device__ __forceinline__ void done(const AttnUnit&)const{}
};
template<class Sched,int THRL=16> __device__ __forceinline__ void attn_phase(char*lds,const AttnTensors&T,const Sched&S){
  AttnUnit u;
  for(int i=0;S.next(i,u);++i){ S.a_ready(u); attn_unit<THRL>(u.bh/NHEAD,u.bh%NHEAD,u.qb,T.Q,T.K,T.V,T.KAUG,T.CSL,T.CST,T.O,T.ssq,lds); S.done(u); }
}
#undef SBAR
#undef WAIT_BAR
#undef WAIT_BAR_
}

constexpr size_t MiB = 1u << 20;
constexpr size_t WS_CTL = 0, CTL_ZERO_BYTES = 256 * 1024;
constexpr size_t WS_SS = 228 * MiB;
constexpr size_t WS_CST = 1 * MiB + 640 * 1024;
constexpr size_t WS_CSL = 2 * MiB;
constexpr size_t WS_WF = 3 * MiB;
constexpr size_t WS_SPA = 3 * MiB + 64 * 1024;
constexpr size_t WS_SPB = 3 * MiB + 128 * 1024;
constexpr size_t WS_SA16 = 3 * MiB + 704 * 1024;
constexpr size_t WS_WIN = 4 * MiB, WS_WOUT = 12 * MiB, WS_WUP = 16 * MiB, WS_WDN = 32 * MiB, WS_WGLU = 48 * MiB;
constexpr size_t WS_SSMM = 49 * MiB;
constexpr size_t WS_HB = 66 * MiB;
constexpr size_t WS_U = 98 * MiB, WS_Q = 114 * MiB, WS_K = 130 * MiB, WS_V = 146 * MiB;
constexpr size_t WS_MIX = 162 * MiB;
constexpr size_t WS_GB = 194 * MiB;
constexpr size_t WS_ST = 210 * MiB;
constexpr size_t WS_HID = 98 * MiB;
constexpr size_t WS_KAUG = 226 * MiB;
constexpr size_t WS_END = 230 * MiB;
static_assert(WS_SS == (228u << 20) && WS_HB == (66u << 20) && MROWS == pg8::EP_M, "epilogue helper constants");
constexpr int CW_Q = 8192;
constexpr int CW_BAR = 4096;

constexpr int RING_OFF = 0, RING_BYTES = 131072;
constexpr int LDSCTL_OFF = RING_BYTES, MISC_OFF = LDSCTL_OFF + 320;
constexpr int LDS_BYTES = 147456;
constexpr int NWAVES = 8;
constexpr bool USE_NAIVE_ATTN = false, USE_NAIVE_SSM = false;
#ifndef REP_P1
#define REP_P1 1
#endif
#ifndef REP_SSM
#define REP_SSM 1
#endif
#ifndef REP_ATT
#define REP_ATT 1
#endif
#ifndef REP_GLU
#define REP_GLU 1
#endif
#ifndef REP_UP
#define REP_UP 1
#endif
#ifndef REP_OUT
#define REP_OUT 1
#endif
#ifndef REP_DN
#define REP_DN 1
#endif
#ifndef REP_SYNC
#define REP_SYNC 0
#endif
#ifndef REP_PRO
#define REP_PRO 1
#endif
static_assert(attn_body::LDS_BYTES <= RING_BYTES, "attention LDS");
#ifndef DBG_STOP_V
#define DBG_STOP_V 99
#endif
constexpr int DBG_STOP = DBG_STOP_V;

struct Frame {
    LAS unsigned char* lds;
    volatile LAS unsigned* MISC;
    int tid, lane, wave, vcu, G;
};
typedef __attribute__((address_space(4))) const unsigned char* kptr_t;
template <class T> __device__ __forceinline__ T* karg(int i) {
    kptr_t p = (kptr_t)__builtin_amdgcn_kernarg_segment_ptr(); asm volatile("" : "+s"(p));
    return *(T* const __attribute__((address_space(4)))*)(p + 8 * i);
}
__device__ __forceinline__ int opaque_s(int x) { asm volatile("" : "+s"(x)); return x; }
__device__ __forceinline__ int opaque_v(int x) { asm volatile("" : "+v"(x)); return x; }
__device__ __forceinline__ int GRIDG_() { return opaque_s((int)gridDim.x); }
__device__ __forceinline__ int BLK_() { return opaque_s((int)blockIdx.x); }
#define KIN(i) karg<const float>(i)
#define KOUT() karg<float>(21)
#define KWS() karg<unsigned char>(22)
extern __shared__ __attribute__((aligned(16))) unsigned char g_lds[];
__device__ __forceinline__ Frame mk_frame() {
    Frame F;
    F.lds = (LAS unsigned char*)g_lds; F.MISC = (volatile LAS unsigned*)(F.lds + MISC_OFF);
    F.tid = opaque_v((int)threadIdx.x); F.lane = F.tid & 63; F.wave = __builtin_amdgcn_readfirstlane(F.tid >> 6);
    F.G = opaque_s((int)gridDim.x); { const int bx = opaque_s((int)blockIdx.x); F.vcu = (F.G % 8 == 0) ? (bx % 8) * (F.G / 8) + bx / 8 : bx; }
    return F;
}
typedef pg8::ssq_t ssq_t;
__device__ __forceinline__ ssq_t* ss_arr(unsigned char* ws, int i) { return (ssq_t*)(ws + WS_SS) + (size_t)i * MROWS; }

__device__ __forceinline__ float wave_sum(float v) {
#pragma unroll
    for (int o = 1; o < 64; o <<= 1) v += __shfl_xor(v, o);
    return v;
}
__device__ __forceinline__ void p0_transpose_item(const float* W, int K, int N, int ldw, const float* gain, bf16* WT, LAS float* scr, int item, int lane) {
    const int nblk = N / 32, kb = item / nblk, nb = item % nblk, k0 = 64 * kb, n0 = 32 * nb;
    f32x4 v[8]; float gv[8];
#pragma unroll
    for (int i = 0; i < 8; ++i) { const int idx = i * 64 + lane, kk = idx >> 3, c4 = (idx & 7) * 4; v[i] = *(const GAS f32x4*)(W + (size_t)(k0 + kk) * ldw + n0 + c4); gv[i] = gain ? gain[k0 + kk] : 1.0f; }
#pragma unroll
    for (int i = 0; i < 8; ++i) { const int idx = i * 64 + lane, kk = idx >> 3, c4 = (idx & 7) * 4; LAS float* d = scr + kk * 33 + c4; const f32x4 x = v[i] * gv[i]; d[0] = x.x; d[1] = x.y; d[2] = x.z; d[3] = x.w; }
    LDS_WAIT(); asm volatile("" ::: "memory");
    const int c = lane & 7;
#pragma unroll
    for (int j = 0; j < 4; ++j) { const int n = (lane >> 3) + 8 * j; const LAS float* s = scr + (8 * c) * 33 + n;
        v4u o; o.x = pk2(s[0 * 33], s[1 * 33]); o.y = pk2(s[2 * 33], s[3 * 33]); o.z = pk2(s[4 * 33], s[5 * 33]); o.w = pk2(s[6 * 33], s[7 * 33]);
        *(GAS v4u*)(WT + (size_t)(n0 + n) * K + k0 + 8 * c) = o; }
    LDS_WAIT(); asm volatile("" ::: "memory");
}

struct Inputs {
    const float *x, *ln1_g, *w_in, *log_dt, *lam_re, *lam_im, *b_re, *b_im, *c_re, *c_im, *ssm_d, *glu_w, *glu_b, *fgate_b, *gn_ssm_g, *gn_attn_g, *w_out, *ln2_g, *w_up, *w_down, *final_g;
};

__device__ __forceinline__ float gelu_tanh(float x) {
    const float k = 0.7978845608028654f;
    const float inner = k * (x + 0.044715f * x * x * x);
    const float e = __builtin_amdgcn_exp2f(inner * (2.0f * LOG2E));
    const float th = 1.0f - 2.0f * __builtin_amdgcn_rcpf(e + 1.0f);
    return 0.5f * x * (1.0f + th);
}

typedef float f32x2f __attribute__((ext_vector_type(2)));
constexpr int SSM_MAT_ELEMS = 131072;
__device__ __forceinline__ void ssm_mats_item(Frame& F, const Inputs& I, unsigned char* ws, int l, int g) {
    LAS f32x2f* AP = (LAS f32x2f*)(F.lds);
    LAS f32x2f* BB = (LAS f32x2f*)(F.lds + 8704);
    LAS f32x2f* CC = (LAS f32x2f*)(F.lds + 16896);
    LAS float* KT = (LAS float*)(F.lds + 25088);
    LAS float* DSK = (LAS float*)(F.lds + 41472);
    const int lg = l * SG + g, tid = F.tid;
    const float dt = expf(I.log_dt[lg]);
    for (int i = tid; i < 17 * 64; i += 512) { const int j = i >> 6, n = i & 63; const float lr = I.lam_re[lg * SN + n], li = I.lam_im[lg * SN + n];
        const float mag = expf(lr * dt * (float)j); float sn, cs; sincosf(li * dt * (float)j, &sn, &cs); AP[i] = (f32x2f){mag * cs, mag * sn}; }
    for (int i = tid; i < 64 * 16; i += 512) { const int n = i >> 4; const float lr = I.lam_re[lg * SN + n], li = I.lam_im[lg * SN + n];
        const float mag = expf(lr * dt); float sn, cs; sincosf(li * dt, &sn, &cs);
        const float are = mag * cs, aim = mag * sn, den = lr * lr + li * li, nr = are - 1.0f;
        const float sre = (nr * lr + aim * li) / den, sim = (aim * lr - nr * li) / den;
        const float br = I.b_re[(size_t)lg * SN * SP + i], bi = I.b_im[(size_t)lg * SN * SP + i];
        BB[i] = (f32x2f){sre * br - sim * bi, sre * bi + sim * br}; }
    for (int i = tid; i < 16 * 64; i += 512) CC[i] = (f32x2f){I.c_re[(size_t)lg * SP * SN + i], I.c_im[(size_t)lg * SP * SN + i]};
    if (tid < 16) DSK[tid] = I.ssm_d[l * DSSM + g * SP + tid];
    __syncthreads();
    {
        const int ln = F.lane, pq = ln & 15, kk = ln >> 4, part = kk & 1;
        for (int jj = 0; jj < 2; ++jj) { const int j = 2 * F.wave + jj; f32x4 acc = (f32x4){0.f, 0.f, 0.f, 0.f};
#pragma unroll 4
            for (int n0 = 0; n0 < 64; n0 += 2) { const int n = n0 + (kk >> 1); const f32x2f c = CC[pq * 64 + n], a = AP[j * 64 + n], b = BB[n * 16 + pq];
                const float av = part ? -c.y : c.x, bv = part ? (a.x * b.y + a.y * b.x) : (a.x * b.x - a.y * b.y);
                acc = __builtin_amdgcn_mfma_f32_16x16x4f32(av, bv, acc, 0, 0, 0); }
#pragma unroll
            for (int r = 0; r < 4; ++r) KT[(j * 16 + 4 * kk + r) * 16 + pq] = acc[r]; }
    }
    __syncthreads();
    bf16* base = (bf16*)(ws + WS_SSMM) + (size_t)lg * SSM_MAT_ELEMS;
    for (int i = 0; i < 8; ++i) {
        const int li_ = tid + 512 * i, frg = li_ >> 6, ln = li_ & 63, rt = frg >> 3, ks = frg & 7, row = 16 * rt + (ln & 15), n = row & 63, isim = row >> 6;
        const int k0 = 32 * ks + 8 * (ln >> 4), s = k0 >> 4, q0 = k0 & 15; const f32x2f a = AP[(15 - s) * 64 + n]; float v[8];
#pragma unroll
        for (int j8 = 0; j8 < 8; ++j8) { const f32x2f b = BB[n * 16 + q0 + j8]; v[j8] = isim ? (a.x * b.y + a.y * b.x) : (a.x * b.x - a.y * b.y); }
        v4u w; w.x = pk2(v[0], v[1]); w.y = pk2(v[2], v[3]); w.z = pk2(v[4], v[5]); w.w = pk2(v[6], v[7]);
        *(GAS v4u*)(base + (size_t)li_ * 8) = w; }
    for (int i = 0; i < 24; ++i) {
        const int li_ = tid + 512 * i, frg = li_ >> 6, ln = li_ & 63, t = frg / 12, ks = frg % 12, p = ln & 15, k0 = 32 * ks + 8 * (ln >> 4); float v[8];
        if (k0 < 256) { const int s = k0 >> 4, q0 = k0 & 15;
#pragma unroll
            for (int j8 = 0; j8 < 8; ++j8) { const int q = q0 + j8; float x = 0.f; if (s <= t) { x = KT[((t - s) * 16 + p) * 16 + q]; if (s == t && p == q) x += DSK[p]; } v[j8] = x; }
        } else { const bool im = k0 >= 320; const int n0 = k0 - (im ? 320 : 256);
#pragma unroll
            for (int j8 = 0; j8 < 8; ++j8) { const f32x2f a = AP[(t + 1) * 64 + n0 + j8], c = CC[p * 64 + n0 + j8]; v[j8] = im ? -(c.x * a.y + c.y * a.x) : (c.x * a.x - c.y * a.y); }
        }
        v4u w; w.x = pk2(v[0], v[1]); w.y = pk2(v[2], v[3]); w.z = pk2(v[4], v[5]); w.w = pk2(v[6], v[7]);
        *(GAS v4u*)(base + (size_t)(4096 + li_) * 8) = w; }
    if (tid < 64) ((f32x2f*)(ws + WS_SA16))[lg * SN + tid] = AP[16 * 64 + tid];
    __syncthreads();
}

constexpr int SSM_UT = 8448, SSM_XROW = 272;
#ifndef REP_SA
#define REP_SA 1
#endif
#ifndef REP_CA
#define REP_CA 1
#endif
#ifndef REP_SC
#define REP_SC 1
#endif
#define SSM_ULOAD(T) (*(const v4u*)(Ug + (size_t)(T) * 8192 + tid * 16))
__device__ __forceinline__ void ssm_item(int l, int item) {
    Frame F = mk_frame(); unsigned char* ws = KWS();
    LAS unsigned char* UT = F.lds; LAS unsigned char* XB = F.lds + 2 * SSM_UT; LAS f32x2f* EX = (LAS f32x2f*)(F.lds + 2 * SSM_UT + 256 * SSM_XROW);
    const int lane = F.lane, wave = F.wave, tid = F.tid, fr = lane & 15, fq = lane >> 4;
    const int uoff = tid * 16 + (tid >> 5) * 16;
    const int boff = fr * 528 + (lane >> 5) * 32 + ((lane >> 4) & 1) * 16;
    {
        const int b = item >> 5, g = item & 31, lg = l * SG + g;
        const unsigned char* Ug = (const unsigned char*)((const bf16*)(ws + WS_U) + ((size_t)g * MROWS + (size_t)b * SEQ) * 16);
        const bf16* MAT = (const bf16*)(ws + WS_SSMM) + (size_t)lg * SSM_MAT_ELEMS;
        float* SL = (float*)(ws + WS_ST) + (size_t)item * 256 * 128;
        v4u ur[8];
        for (int repa = 0; repa < REP_SA; ++repa) {
            bf16x8 wa[8];
#pragma unroll
            for (int ks = 0; ks < 8; ++ks) wa[ks] = *(const bf16x8*)(MAT + (size_t)((wave * 8 + ks) * 64 + lane) * 8);
#pragma unroll
            for (int k = 0; k < 6; ++k) ur[k] = SSM_ULOAD(k);
            __syncthreads();
            *(LAS v4u*)(UT + uoff) = ur[0];
            for (int jo = 0; jo < 16; jo += 8) {
#pragma unroll
                for (int ji = 0; ji < 8; ++ji) { const int j = jo + ji;
                    __syncthreads();
                    ur[(ji + 6) & 7] = SSM_ULOAD((j + 6) & 15);
                    const LAS unsigned char* ut = UT + (j & 1) * SSM_UT + boff;
                    f32x4 acc = (f32x4){0.f, 0.f, 0.f, 0.f};
#pragma unroll
                    for (int ks = 0; ks < 8; ++ks) acc = __builtin_amdgcn_mfma_f32_16x16x32_bf16(wa[ks], *(const LAS bf16x8*)(ut + ks * 64), acc, 0, 0, 0);
                    *(f32x4*)(SL + (size_t)(16 * j + fr) * 128 + 16 * wave + 4 * fq) = acc;
                    *(LAS v4u*)(UT + ((j + 1) & 1) * SSM_UT + uoff) = ur[(ji + 1) & 7];
                }
            }
        }
        asm volatile("s_waitcnt vmcnt(0)" ::: "memory");
        __syncthreads();
#pragma unroll
        for (int k = 0; k < 6; ++k) ur[k] = SSM_ULOAD(k);
        for (int repc = 0; repc < REP_CA; ++repc) {
            __syncthreads();
            const f32x2f a16 = ((const f32x2f*)(ws + WS_SA16))[lg * SN + lane];
            float pr = a16.x, pi = a16.y;
#pragma unroll
            for (int i = 0; i < 5; ++i) { const float nr = pr * pr - pi * pi, ni = 2.0f * pr * pi; pr = nr; pi = ni; }
            float sr[32], si[32];
#pragma unroll
            for (int i = 0; i < 32; ++i) { sr[i] = SL[(size_t)(32 * wave + i) * 128 + lane]; si[i] = SL[(size_t)(32 * wave + i) * 128 + 64 + lane]; }
            float xr = 0.f, xi = 0.f;
#pragma unroll
            for (int i = 0; i < 32; ++i) { const float nr = a16.x * xr - a16.y * xi + sr[i], ni = a16.x * xi + a16.y * xr + si[i]; xr = nr; xi = ni; }
            EX[wave * 64 + lane] = (f32x2f){xr, xi};
            __syncthreads();
            xr = 0.f; xi = 0.f;
            for (int w2 = 0; w2 < wave; ++w2) { const f32x2f e = EX[w2 * 64 + lane]; const float nr = pr * xr - pi * xi + e.x, ni = pr * xi + pi * xr + e.y; xr = nr; xi = ni; }
#pragma unroll
            for (int i = 0; i < 32; ++i) {
                LAS unsigned short* xrow = (LAS unsigned short*)(XB + (32 * wave + i) * SSM_XROW);
                xrow[lane] = (unsigned short)f2bf(xr); xrow[64 + lane] = (unsigned short)f2bf(xi);
                const float nr = a16.x * xr - a16.y * xi + sr[i], ni = a16.x * xi + a16.y * xr + si[i]; xr = nr; xi = ni; }
        }
        for (int reps = 0; reps < REP_SC; ++reps) {
            if (reps) { __syncthreads(); _Pragma("unroll") for (int k = 0; k < 6; ++k) ur[k] = SSM_ULOAD(k); }
            const int t0 = wave, t1 = 15 - wave;
            bf16x8 wc0[12], wc1[12];
#pragma unroll
            for (int ks = 0; ks < 12; ++ks) { wc0[ks] = *(const bf16x8*)(MAT + (size_t)(4096 + (t0 * 12 + ks) * 64 + lane) * 8); wc1[ks] = *(const bf16x8*)(MAT + (size_t)(4096 + (t1 * 12 + ks) * 64 + lane) * 8); }
            bf16* GB = (bf16*)(ws + WS_GB);
            *(LAS v4u*)(UT + uoff) = ur[0];
            for (int jo = 0; jo < 16; jo += 8) {
#pragma unroll
                for (int ji = 0; ji < 8; ++ji) { const int j = jo + ji;
                    __syncthreads();
                    ur[(ji + 6) & 7] = SSM_ULOAD((j + 6) & 15);
                    const LAS unsigned char* ut = UT + (j & 1) * SSM_UT + boff;
                    const LAS unsigned char* xb = XB + (16 * j + fr) * SSM_XROW + fq * 16;
                    f32x4 acc0 = (f32x4){0.f, 0.f, 0.f, 0.f}, acc1 = (f32x4){0.f, 0.f, 0.f, 0.f};
#pragma unroll
                    for (int ks = 0; ks < 8; ++ks) { const bf16x8 ub = *(const LAS bf16x8*)(ut + ks * 64);
                        acc0 = __builtin_amdgcn_mfma_f32_16x16x32_bf16(wc0[ks], ub, acc0, 0, 0, 0);
                        acc1 = __builtin_amdgcn_mfma_f32_16x16x32_bf16(wc1[ks], ub, acc1, 0, 0, 0); }
#pragma unroll
                    for (int kp = 0; kp < 4; ++kp) { const bf16x8 xf = *(const LAS bf16x8*)(xb + kp * 64);
                        acc0 = __builtin_amdgcn_mfma_f32_16x16x32_bf16(wc0[8 + kp], xf, acc0, 0, 0, 0);
                        acc1 = __builtin_amdgcn_mfma_f32_16x16x32_bf16(wc1[8 + kp], xf, acc1, 0, 0, 0); }
                    const size_t row0 = (size_t)b * SEQ + 16 * (16 * j + fr);
                    { pg8::u32x2 w; w.x = pk2(gelu_tanh(acc0[0]), gelu_tanh(acc0[1])); w.y = pk2(gelu_tanh(acc0[2]), gelu_tanh(acc0[3])); *(pg8::u32x2*)(GB + (row0 + t0) * 512 + g * SP + 4 * fq) = w; }
                    { pg8::u32x2 w; w.x = pk2(gelu_tanh(acc1[0]), gelu_tanh(acc1[1])); w.y = pk2(gelu_tanh(acc1[2]), gelu_tanh(acc1[3])); *(pg8::u32x2*)(GB + (row0 + t1) * 512 + g * SP + 4 * fq) = w; }
                    *(LAS v4u*)(UT + ((j + 1) & 1) * SSM_UT + uoff) = ur[(ji + 1) & 7];
                }
            }
        }
        __syncthreads();
    }
}
__device__ __forceinline__ void ssm_mfma_phase(int l) {
    const int G = GRIDG_(), bx = BLK_(); const int vcu = (G % 8 == 0) ? (bx % 8) * (G / 8) + bx / 8 : bx;
    for (int item = vcu; item < BATCH * SG; item += G) ssm_item(l, item);
}
__device__ __forceinline__ Inputs load_inputs() {
    Inputs I;
    I.x = KIN(0); I.ln1_g = KIN(1); I.w_in = KIN(2); I.log_dt = KIN(3); I.lam_re = KIN(4); I.lam_im = KIN(5); I.b_re = KIN(6); I.b_im = KIN(7);
    I.c_re = KIN(8); I.c_im = KIN(9); I.ssm_d = KIN(10); I.glu_w = KIN(11); I.glu_b = KIN(12); I.fgate_b = KIN(13); I.gn_ssm_g = KIN(14); I.gn_attn_g = KIN(15);
    I.w_out = KIN(16); I.ln2_g = KIN(17); I.w_up = KIN(18); I.w_down = KIN(19); I.final_g = KIN(20);
    return I;
}
__device__ __forceinline__ void p0_prologue() {
    Frame F = mk_frame();
    const Inputs I = load_inputs();
    LAS float* scr = (LAS float*)(F.lds + RING_OFF + F.wave * 16384);
    const int gw = opaque_s(F.vcu) * NWAVES + opaque_s(F.wave), NGW = opaque_s(F.G) * NWAVES;
    unsigned char* ws = KWS();
    for (int it = F.vcu; it < DEPTH * SG; it += F.G) ssm_mats_item(F, I, ws, it / SG, it % SG);
    constexpr int I_IN = (DM / 64) * (2048 / 32), I_OUT = (DM / 64) * (DM / 32), I_UP = (DM / 64) * (DFF / 32), I_DN = (DFF / 64) * (DM / 32), I_GLU = (DSSM / 64) * (DSSM / 32);
    constexpr int PER_L = I_IN + I_OUT + I_UP + I_DN + I_GLU;
    for (int it = gw; it < DEPTH * PER_L; it += NGW) {
        const int l = it / PER_L; int r = it % PER_L;
        if (r < I_IN) { p0_transpose_item(I.w_in + (size_t)l * DM * DIN, DM, 2048, DIN, I.ln1_g + l * DM, (bf16*)(ws + WS_WIN) + (size_t)l * 2048 * DM, scr, r, F.lane); continue; } r -= I_IN;
        if (r < I_OUT) {
            const int kb = r / (DM / 32); const float* gain = (kb < 8) ? (I.gn_ssm_g + l * DSSM) : (I.gn_attn_g + l * DATT - 512);
            p0_transpose_item(I.w_out + (size_t)l * DM * DM, DM, DM, DM, gain, (bf16*)(ws + WS_WOUT) + (size_t)l * DM * DM, scr, r, F.lane); continue; } r -= I_OUT;
        if (r < I_UP) { p0_transpose_item(I.w_up + (size_t)l * DM * DFF, DM, DFF, DFF, I.ln2_g + l * DM, (bf16*)(ws + WS_WUP) + (size_t)l * DFF * DM, scr, r, F.lane); continue; } r -= I_UP;
        if (r < I_DN) { p0_transpose_item(I.w_down + (size_t)l * DFF * DM, DFF, DM, DM, nullptr, (bf16*)(ws + WS_WDN) + (size_t)l * DM * DFF, scr, r, F.lane); continue; } r -= I_DN;
        p0_transpose_item(I.glu_w + (size_t)l * DSSM * DSSM, DSSM, DSSM, DSSM, nullptr, (bf16*)(ws + WS_WGLU) + (size_t)l * DSSM * DSSM, scr, r, F.lane);
    }
    for (int i = gw * 64 + F.lane; i < DEPTH * 8 * DM; i += NGW * 64) { const int l = i / (8 * DM), h = (i / DM) % 8, k = i % DM;
        ((float*)(ws + WS_WF))[i] = I.w_in[(size_t)l * DM * DIN + (size_t)k * DIN + 2048 + h] * I.ln1_g[l * DM + k]; }
    for (int i = gw * 64 + F.lane; i < DEPTH * SG * SN; i += NGW * 64) {
        const int l = i / (SG * SN), gn = i % (SG * SN), g = gn / SN;
        const float dt = expf(I.log_dt[l * SG + g]);
        const float lr = I.lam_re[i], li = I.lam_im[i];
        const float mag = expf(lr * dt); float sn, cs; sincosf(li * dt, &sn, &cs);
        const float are = mag * cs, aim = mag * sn, den = lr * lr + li * li, nr = are - 1.0f;
        const float sre = (nr * lr + aim * li) / den, sim = (aim * lr - nr * li) / den;
        float* pa = (float*)(ws + WS_SPA) + (size_t)i * 2; pa[0] = are; pa[1] = aim;
        float* pb = (float*)(ws + WS_SPB) + (size_t)i * SP * 2;
        for (int p = 0; p < SP; ++p) { const float br = I.b_re[(size_t)i * SP + p], bi = I.b_im[(size_t)i * SP + p]; pb[p * 2] = sre * br - sim * bi; pb[p * 2 + 1] = sre * bi + sim * br; }
    }
    { f32x4* z = (f32x4*)ss_arr(ws, 1); for (int i = gw * 64 + F.lane; i < 9 * MROWS / 2; i += NGW * 64) z[i] = (f32x4){0.f, 0.f, 0.f, 0.f}; }
    for (int m0 = gw * 4; m0 < MROWS; m0 += NGW * 4) {
        f32x4 v[4][4];
#pragma unroll
        for (int r = 0; r < 4; ++r)
#pragma unroll
            for (int j = 0; j < 4; ++j) v[r][j] = ((const GAS f32x4*)(I.x + (size_t)(m0 + r) * DM) + F.lane)[64 * j];
#pragma unroll
        for (int r = 0; r < 4; ++r) {
            GAS unsigned long long* o8 = (GAS unsigned long long*)((bf16*)(ws + WS_HB) + (size_t)(m0 + r) * DM) + F.lane; float s = 0.f;
#pragma unroll
            for (int j = 0; j < 4; ++j) { const f32x4 x = v[r][j]; s += (x.x * x.x + x.y * x.y) + (x.z * x.z + x.w * x.w);
                o8[64 * j] = (unsigned long long)pk2(x.x, x.y) | ((unsigned long long)pk2(x.z, x.w) << 32); }
            s = wave_sum(s);
            if (F.lane == 0) ss_arr(ws, 0)[m0 + r] = (ssq_t)(s * 16777216.0f);
        }
    }
}

__device__ __forceinline__ void csum_items(int l) {
    Frame F = mk_frame();
    LAS float* wfl = (LAS float*)(F.lds); LAS float* Fs = (LAS float*)(F.lds + 32768);
    unsigned char* ws = KWS(); const float* fbias = KIN(13) + l * NHEAD; const ssq_t* ss1 = ss_arr(ws, 4 * l);
    const float* wf = (const float*)(ws + WS_WF) + (size_t)l * 8 * DM;
    for (int i = F.tid; i < 8 * DM; i += 512) wfl[i] = wf[i];
    __syncthreads();
    const bf16* HB = (const bf16*)(ws + WS_HB);
    float* CSL = (float*)(ws + WS_CSL); float* CST = (float*)(ws + WS_CST);
    for (int chunk = F.vcu; chunk < MROWS / 64; chunk += F.G) {
        for (int rr = 0; rr < 8; ++rr) {
            const int row = chunk * 64 + F.wave * 8 + rr;
            const v4u x0 = *(const v4u*)(HB + (size_t)row * DM + F.lane * 8), x1 = *(const v4u*)(HB + (size_t)row * DM + 512 + F.lane * 8);
            float xv[16] = {pg8::bflo(x0.x), pg8::bfhi(x0.x), pg8::bflo(x0.y), pg8::bfhi(x0.y), pg8::bflo(x0.z), pg8::bfhi(x0.z), pg8::bflo(x0.w), pg8::bfhi(x0.w),
                            pg8::bflo(x1.x), pg8::bfhi(x1.x), pg8::bflo(x1.y), pg8::bfhi(x1.y), pg8::bflo(x1.z), pg8::bfhi(x1.z), pg8::bflo(x1.w), pg8::bfhi(x1.w)};
            float mine = 0.f;
#pragma unroll
            for (int h = 0; h < 8; ++h) {
                const LAS f32x4* w = (const LAS f32x4*)(wfl + h * DM + F.lane * 8);
                const f32x4 w0 = w[0], w1 = w[1], w2 = w[128], w3 = w[129];
                float a = 0.f;
#pragma unroll
                for (int e = 0; e < 4; ++e) { a = fmaf(xv[e], w0[e], a); a = fmaf(xv[4 + e], w1[e], a); a = fmaf(xv[8 + e], w2[e], a); a = fmaf(xv[12 + e], w3[e], a); }
                a = wave_sum(a);
                if (F.lane == h) mine = a;
            }
            if (F.lane < 8) {
                const float f = mine * rsqrtf(pg8::ss_get(ss1, row) * (1.0f / 1024.0f) + EPS) + fbias[F.lane];
                const float ls = (f >= 0.f) ? -log1pf(expf(-f)) : (f - log1pf(expf(f)));
                Fs[(F.wave * 8 + rr) * 8 + F.lane] = ls * LOG2E;
            }
        }
        __syncthreads();
        {
            float v = Fs[F.lane * 8 + F.wave];
#pragma unroll
            for (int o = 1; o < 64; o <<= 1) { const float t = __shfl_up(v, o); if (F.lane >= o) v += t; }
            const int row = chunk * 64 + F.lane, b = row / SEQ, t = row % SEQ;
            CSL[((size_t)b * NHEAD + F.wave) * SEQ + t] = v;
            { const float nv = -v; const unsigned h1 = f2bf(nv); const float r1 = nv - __uint_as_float(h1 << 16); const unsigned h2 = f2bf(r1); const float r2 = r1 - __uint_as_float(h2 << 16); const unsigned h3 = f2bf(r2);
              v4u w; w.x = h1 | (h2 << 16); w.y = h3 | 0x3F800000u; w.z = 0x3F803F80u; w.w = 0u;
              *(v4u*)((bf16*)(ws + WS_KAUG) + (((size_t)b * NHEAD + F.wave) * SEQ + t) * 8) = w; }
            if (F.lane == 63) CST[((size_t)b * NHEAD + F.wave) * 64 + t / 64] = v;
        }
        __syncthreads();
    }
}


__device__ __forceinline__ void ssm_naive_phase(int l) {
    Frame F = mk_frame();
    unsigned char* ws = KWS(); Inputs I; I.c_re = KIN(8); I.c_im = KIN(9); I.ssm_d = KIN(10);
    const int gw = opaque_s(F.vcu) * NWAVES + opaque_s(F.wave), NGW = opaque_s(F.G) * NWAVES;
    const bf16* U = (const bf16*)(ws + WS_U); bf16* GB = (bf16*)(ws + WS_GB);
    for (int it = gw; it < BATCH * SG; it += NGW) {
        const int b = it / SG, g = it % SG, n = F.lane;
        const float* bb = (const float*)(ws + WS_SPB) + ((size_t)(l * SG + g) * SN + n) * SP * 2;
        const float* pa = (const float*)(ws + WS_SPA) + ((size_t)(l * SG + g) * SN + n) * 2;
        const float* cre = I.c_re + (size_t)(l * SG + g) * SP * SN; const float* cim = I.c_im + (size_t)(l * SG + g) * SP * SN;
        float bbr[SP], bbi[SP], cr[SP], ci[SP];
#pragma unroll
        for (int p = 0; p < SP; ++p) { bbr[p] = bb[p * 2]; bbi[p] = bb[p * 2 + 1]; cr[p] = cre[p * SN + n]; ci[p] = cim[p * SN + n]; }
        const float ar = pa[0], ai = pa[1];
        const float dsk = I.ssm_d[l * DSSM + g * SP + (n & 15)];
        float xr = 0.f, xi = 0.f;
        for (int t = 0; t < SEQ; ++t) {
            const size_t row = (size_t)b * SEQ + t;
            const v4u u0 = *(const v4u*)(U + ((size_t)g * MROWS + row) * 16), u1 = *(const v4u*)(U + ((size_t)g * MROWS + row) * 16 + 8);
            float u[16] = {pg8::bflo(u0.x), pg8::bfhi(u0.x), pg8::bflo(u0.y), pg8::bfhi(u0.y), pg8::bflo(u0.z), pg8::bfhi(u0.z), pg8::bflo(u0.w), pg8::bfhi(u0.w),
                           pg8::bflo(u1.x), pg8::bfhi(u1.x), pg8::bflo(u1.y), pg8::bfhi(u1.y), pg8::bflo(u1.z), pg8::bfhi(u1.z), pg8::bflo(u1.w), pg8::bfhi(u1.w)};
            float bur = 0.f, bui = 0.f;
#pragma unroll
            for (int p = 0; p < SP; ++p) { bur = fmaf(bbr[p], u[p], bur); bui = fmaf(bbi[p], u[p], bui); }
            const float nxr = ar * xr - ai * xi + bur, nxi = ar * xi + ai * xr + bui;
            xr = nxr; xi = nxi;
            float mine = 0.f;
#pragma unroll
            for (int p = 0; p < SP; ++p) { const float v = wave_sum(cr[p] * xr - ci[p] * xi); if ((n & 15) == p) mine = v + dsk * u[p]; }
            if (n < SP) GB[row * 512 + g * SP + n] = (bf16)f2bf(gelu_tanh(mine));
        }
    }
}

__device__ __forceinline__ void attn_naive_phase(int l) {
    Frame F = mk_frame();
    unsigned char* ws = KWS(); ssq_t* ss_att = ss_arr(ws, 4 * l + 2);
    const int gw = opaque_s(F.vcu) * NWAVES + opaque_s(F.wave), NGW = opaque_s(F.G) * NWAVES;
    const bf16* Q = (const bf16*)(ws + WS_Q); const bf16* K = (const bf16*)(ws + WS_K); const bf16* V = (const bf16*)(ws + WS_V); bf16* MIX = (bf16*)(ws + WS_MIX);
    const float* CSL = (const float*)(ws + WS_CSL); const float* CST = (const float*)(ws + WS_CST);
    LAS unsigned char* wl = F.lds + F.wave * 8448;
    LAS v4u* Kt = (LAS v4u*)wl; LAS v4u* Vt = (LAS v4u*)(wl + 4096); LAS float* Cs = (LAS float*)(wl + 8192);
    for (int it = gw; it < BATCH * NHEAD * 64; it += NGW) {
        const int qb = 63 - it / 32, bh = it % 32, b = bh / NHEAD, h = bh % NHEAD;
        const int i = qb * 64 + F.lane; const size_t qrow = (size_t)b * SEQ + i;
        float q[64], o[64];
#pragma unroll
        for (int c = 0; c < 8; ++c) { const v4u w = *(const v4u*)(Q + qrow * 512 + h * 64 + c * 8);
            q[c * 8 + 0] = pg8::bflo(w.x); q[c * 8 + 1] = pg8::bfhi(w.x); q[c * 8 + 2] = pg8::bflo(w.y); q[c * 8 + 3] = pg8::bfhi(w.y);
            q[c * 8 + 4] = pg8::bflo(w.z); q[c * 8 + 5] = pg8::bfhi(w.z); q[c * 8 + 6] = pg8::bflo(w.w); q[c * 8 + 7] = pg8::bfhi(w.w); }
#pragma unroll
        for (int d = 0; d < 64; ++d) o[d] = 0.f;
        const float* cst = CST + (size_t)bh * 64; const float* csl = CSL + (size_t)bh * SEQ;
        float offq = 0.f; for (int c = 0; c < qb; ++c) offq += cst[c];
        const float ci = csl[i] + offq;
        float offk = 0.f, m = -INFINITY, lsum = 0.f;
        for (int kt = 0; kt < 2 * qb + 2; ++kt) {
            if (kt > 0 && (kt & 1) == 0) offk += cst[kt / 2 - 1];
            asm volatile("s_waitcnt lgkmcnt(0)" ::: "memory");
#pragma unroll
            for (int r = 0; r < 4; ++r) { const int idx = r * 64 + F.lane, key = idx >> 3, ch = idx & 7; const size_t krow = (size_t)b * SEQ + kt * 32 + key;
                Kt[idx] = *(const v4u*)(K + krow * 512 + h * 64 + ch * 8); Vt[idx] = *(const v4u*)(V + krow * 512 + h * 64 + ch * 8); }
            if (F.lane < 32) Cs[F.lane] = csl[kt * 32 + F.lane] + offk;
            asm volatile("s_waitcnt vmcnt(0) lgkmcnt(0)" ::: "memory");
            for (int j = 0; j < 32; ++j) {
                const int kj = kt * 32 + j;
                float s = 0.f;
#pragma unroll
                for (int c = 0; c < 8; ++c) { const v4u w = Kt[j * 8 + c];
                    s = fmaf(q[c * 8 + 0], pg8::bflo(w.x), s); s = fmaf(q[c * 8 + 1], pg8::bfhi(w.x), s); s = fmaf(q[c * 8 + 2], pg8::bflo(w.y), s); s = fmaf(q[c * 8 + 3], pg8::bfhi(w.y), s);
                    s = fmaf(q[c * 8 + 4], pg8::bflo(w.z), s); s = fmaf(q[c * 8 + 5], pg8::bfhi(w.z), s); s = fmaf(q[c * 8 + 6], pg8::bflo(w.w), s); s = fmaf(q[c * 8 + 7], pg8::bfhi(w.w), s); }
                s += ci - Cs[j];
                if (kj <= i) {
                    if (s > m) { const float f = __builtin_amdgcn_exp2f(m - s); lsum *= f;
#pragma unroll
                        for (int d = 0; d < 64; ++d) o[d] *= f;
                        m = s; }
                    const float p = __builtin_amdgcn_exp2f(s - m); lsum += p;
#pragma unroll
                    for (int c = 0; c < 8; ++c) { const v4u w = Vt[j * 8 + c];
                        o[c * 8 + 0] = fmaf(p, pg8::bflo(w.x), o[c * 8 + 0]); o[c * 8 + 1] = fmaf(p, pg8::bfhi(w.x), o[c * 8 + 1]); o[c * 8 + 2] = fmaf(p, pg8::bflo(w.y), o[c * 8 + 2]); o[c * 8 + 3] = fmaf(p, pg8::bfhi(w.y), o[c * 8 + 3]);
                        o[c * 8 + 4] = fmaf(p, pg8::bflo(w.z), o[c * 8 + 4]); o[c * 8 + 5] = fmaf(p, pg8::bfhi(w.z), o[c * 8 + 5]); o[c * 8 + 6] = fmaf(p, pg8::bflo(w.w), o[c * 8 + 6]); o[c * 8 + 7] = fmaf(p, pg8::bfhi(w.w), o[c * 8 + 7]); }
                }
            }
        }
        const float inv = 1.0f / lsum; float part = 0.f;
#pragma unroll
        for (int c = 0; c < 8; ++c) { float e[8];
#pragma unroll
            for (int d = 0; d < 8; ++d) { e[d] = o[c * 8 + d] * inv; part += e[d] * e[d]; }
            v4u w; w.x = pk2(e[0], e[1]); w.y = pk2(e[2], e[3]); w.z = pk2(e[4], e[5]); w.w = pk2(e[6], e[7]);
            *(v4u*)(MIX + qrow * 1024 + 512 + h * 64 + c * 8) = w; }
        pg8::ss_add(ss_att, (int)qrow, part);
    }
}

__device__ __forceinline__ void attn_fox_phase(int l, int rep) {
    unsigned char* ws = KWS();
    const attn_body::AttnTensors AT{(const attn_body::bf16*)(ws + WS_Q), (const attn_body::bf16*)(ws + WS_K), (const attn_body::bf16*)(ws + WS_V), (const attn_body::bf16*)(ws + WS_KAUG),
                                    (const float*)(ws + WS_CSL), (const float*)(ws + WS_CST), (attn_body::bf16*)(ws + WS_MIX) + 512, ss_arr(ws, rep == 0 ? 4 * l + 2 : 9)};
    const attn_body::StaticOrder S(GRIDG_(), BLK_());
    attn_body::attn_phase<attn_body::StaticOrder>((char*)g_lds + RING_OFF, AT, S);
}

__device__ __forceinline__ void mixer_phase(int l, int rep) {
    unsigned char* ws = KWS();
    const int G = GRIDG_(), bx = BLK_();
    const int npass = (G >= 8 && G % 8 == 0) ? 1 : 8;
    volatile LAS unsigned* bc = (volatile LAS unsigned*)((LAS unsigned char*)g_lds + MISC_OFF) + 12;
    for (int ps = 0; ps < npass; ++ps) {
        const int xq = (bx + ps) & 7;
        unsigned* head = (unsigned*)(ws + WS_CTL) + CW_Q + 64 * (16 * rep + 8 * l + xq);
        for (;;) {
            if (threadIdx.x == 0) *bc = __hip_atomic_fetch_add(head, 1u, __ATOMIC_RELAXED, __HIP_MEMORY_SCOPE_AGENT);
            __syncthreads();
            const int idx = (int)__builtin_amdgcn_readfirstlane(*bc);
            __syncthreads();
            if (idx >= 80) break;
            if (idx >= 40 && idx < 56) ssm_item(l, xq * 16 + idx - 40);
            else { const int j = idx < 40 ? idx : idx - 16, bh = 4 * xq + (j & 3), qb = 15 - (j >> 2);
                attn_body::attn_unit<16>(bh >> 3, bh & 7, qb, (const attn_body::bf16*)(ws + WS_Q), (const attn_body::bf16*)(ws + WS_K), (const attn_body::bf16*)(ws + WS_V), (const attn_body::bf16*)(ws + WS_KAUG),
                                         (const float*)(ws + WS_CSL), (const float*)(ws + WS_CST), (attn_body::bf16*)(ws + WS_MIX) + 512, ss_arr(ws, rep == 0 ? 4 * l + 2 : 9), (char*)g_lds + RING_OFF); }
        }
    }
}

__device__ __forceinline__ void final_norm_phase() {
    Frame F = mk_frame();
    unsigned char* ws = KWS(); float* out = KOUT(); const ssq_t* ssf = ss_arr(ws, 8); const float* g = KIN(20); const bf16* HB = (const bf16*)(ws + WS_HB);
    const int gw = opaque_s(F.vcu) * NWAVES + opaque_s(F.wave), NGW = opaque_s(F.G) * NWAVES;
    for (int m = gw; m < MROWS; m += NGW) {
        const float r = rsqrtf(pg8::ss_get(ssf, m) * (1.0f / 1024.0f) + EPS);
#pragma unroll
        for (int j = 0; j < 2; ++j) { const v4u hw = *(const v4u*)(HB + (size_t)m * DM + j * 512 + F.lane * 8);
            const f32x4 g0 = *(const f32x4*)(g + j * 512 + F.lane * 8), g1 = *(const f32x4*)(g + j * 512 + F.lane * 8 + 4);
            f32x4 o0 = (f32x4){pg8::bflo(hw.x), pg8::bfhi(hw.x), pg8::bflo(hw.y), pg8::bfhi(hw.y)} * r * g0, o1 = (f32x4){pg8::bflo(hw.z), pg8::bfhi(hw.z), pg8::bflo(hw.w), pg8::bfhi(hw.w)} * r * g1;
            *(f32x4*)(out + (size_t)m * DM + j * 512 + F.lane * 8) = o0; *(f32x4*)(out + (size_t)m * DM + j * 512 + F.lane * 8 + 4) = o1; }
    }
}

struct Args { const float* in[21]; float* out; unsigned char* ws; int pad0, pad1; };
__global__ void __launch_bounds__(NWAVES * 64, 2) fwd_megakernel(Args args) {
    if (DBG_STOP == -4) return;
    {
        Frame F = mk_frame();
        for (int u = F.tid; u < (LDS_BYTES - LDSCTL_OFF) / 4; u += NWAVES * 64) ((LAS unsigned*)(F.lds + LDSCTL_OFF))[u] = 0u;
        __syncthreads();
    }
    if (DBG_STOP == -5) return;
    XcdBarrier bar = xcd_barrier_post((unsigned*)(KWS() + WS_CTL) + CW_BAR, (volatile LAS unsigned*)((LAS unsigned char*)g_lds + MISC_OFF) + 8);
#ifndef REP_BAR
#define REP_BAR 1
#endif
#define GRID_BAR() do { for (int rb_ = 0; rb_ < REP_BAR; ++rb_) xcd_barrier(bar); } while (0)
#define LDSRING ((LAS unsigned char*)g_lds + RING_OFF)
#define GRIDG opaque_s((int)gridDim.x)
#define BLK opaque_s((int)blockIdx.x)

    if (DBG_STOP == -2) return;
    for (int rep = 0; rep < REP_PRO; ++rep) { p0_prologue(); __syncthreads(); }
    GRID_BAR();
    if (DBG_STOP == 0 || DBG_STOP == -3) return;

    for (int l = 0; l < DEPTH; ++l) {
        for (int rep = 0; rep < REP_P1; ++rep) {
        csum_items(l);
        {
            unsigned char* ws = KWS();
            pg8::Gemm g{(const bf16*)(ws + WS_HB), (const bf16*)(ws + WS_WIN) + (size_t)l * 2048 * DM, MROWS, 2048, DM}; pg8::StaticOrder S; S.init(MROWS, 2048, GRIDG, BLK);
            pg8::EpiProj E{(bf16*)(ws + WS_U), (size_t)(WS_Q - WS_U) / 2, ss_arr(ws, 4 * l), C2, 0};
            pg8::gemm_phase<pg8::EpiProj, pg8::StaticOrder, true, true>(LDSRING, g, S, E);
        }
        __syncthreads();
        }
        GRID_BAR();
        if (DBG_STOP == 1) return;
#ifndef REP_MIX
#define REP_MIX 1
#endif
        for (int rep = 0; rep < REP_MIX; ++rep) mixer_phase(l, rep);
        GRID_BAR();
        if (DBG_STOP == 2) return;
        for (int rep = 0; rep < REP_GLU; ++rep) {
            unsigned char* ws = KWS();
            pg8::Gemm g{(const bf16*)(ws + WS_GB), (const bf16*)(ws + WS_WGLU) + (size_t)l * DSSM * DSSM, MROWS, DSSM, DSSM}; pg8::StaticOrder S; S.init(MROWS, DSSM, GRIDG, BLK);
            pg8::EpiGlu E{(const bf16*)(ws + WS_GB), (bf16*)(ws + WS_MIX), KIN(12) + l * DSSM, ss_arr(ws, rep == 0 ? 4 * l + 1 : 9), 0};
            pg8::gemm_phase<pg8::EpiGlu, pg8::StaticOrder, true, true>(LDSRING, g, S, E);
            __syncthreads();
            if (REP_SYNC && rep + 1 < REP_GLU) GRID_BAR();
        }
        GRID_BAR();
        for (int rep = REP_OUT - 1; rep >= 0; --rep) {
            unsigned char* ws = KWS(); float* out = KOUT();
            pg8::Gemm g{(const bf16*)(ws + WS_MIX), (const bf16*)(ws + WS_WOUT) + (size_t)l * DM * DM, MROWS, DM, DM}; pg8::StaticOrder S; S.init(MROWS, DM, GRIDG, BLK);
            pg8::EpiOut E{l, 8};
            pg8::gemm_phase<pg8::EpiOut, pg8::StaticOrder, true, true>(LDSRING, g, S, E);
            __syncthreads();
            if (REP_SYNC && rep != 0) GRID_BAR();
        }
        GRID_BAR();
        for (int rep = 0; rep < REP_UP; ++rep) {
            unsigned char* ws = KWS();
            pg8::Gemm g{(const bf16*)(ws + WS_HB), (const bf16*)(ws + WS_WUP) + (size_t)l * DFF * DM, MROWS, DFF, DM}; pg8::StaticOrder S; S.init(MROWS, DFF, GRIDG, BLK);
            pg8::EpiUp E{(bf16*)(ws + WS_HID), ss_arr(ws, 4 * l + 3), 0};
            pg8::gemm_phase<pg8::EpiUp, pg8::StaticOrder, true, true>(LDSRING, g, S, E);
            __syncthreads();
            if (REP_SYNC && rep + 1 < REP_UP) GRID_BAR();
        }
        GRID_BAR();
        for (int rep = REP_DN - 1; rep >= 0; --rep) {
            unsigned char* ws = KWS(); float* out = KOUT();
            pg8::Gemm g{(const bf16*)(ws + WS_HID), (const bf16*)(ws + WS_WDN) + (size_t)l * DM * DFF, MROWS, DM, DFF}; pg8::StaticOrder S; S.init(MROWS, DM, GRIDG, BLK);
            pg8::EpiDown E{(bf16*)(ws + WS_HB), ss_arr(ws, 4 * l + 4), 0};
            pg8::gemm_phase<pg8::EpiDown, pg8::StaticOrder, true, true>(LDSRING, g, S, E);
            __syncthreads();
            if (REP_SYNC && rep != 0) GRID_BAR();
        }
        GRID_BAR();
    }
    final_norm_phase();
}

extern "C" void kernel_launch(void* const* d_in, const int* in_sizes, int n_in, void* d_out, int out_size, void* d_ws, size_t ws_size, hipStream_t stream) {
    static int grid = 0;
    if (grid == 0) {
        if (n_in != 21 || out_size != MROWS * DM || ws_size < WS_END) { fprintf(stderr, "kernel_launch: unexpected shapes (n_in %d, out %d, ws %zu)\n", n_in, out_size, ws_size); grid = -1; return; }
        int dev = 0, cus = 0, per_cu = 0;
        if (hipGetDevice(&dev) != hipSuccess || hipDeviceGetAttribute(&cus, hipDeviceAttributeMultiprocessorCount, dev) != hipSuccess) { grid = -1; return; }
        if (hipFuncSetAttribute((const void*)fwd_megakernel, hipFuncAttributeMaxDynamicSharedMemorySize, LDS_BYTES) != hipSuccess) { fprintf(stderr, "kernel_launch: hipFuncSetAttribute failed\n"); grid = -1; return; }
        if (hipOccupancyMaxActiveBlocksPerMultiprocessor(&per_cu, (const void*)fwd_megakernel, NWAVES * 64, LDS_BYTES) != hipSuccess || per_cu < 1) { fprintf(stderr, "kernel_launch: occupancy query says %d blocks per CU\n", per_cu); }
        (void)hipGetLastError();
        grid = cus;
    }
    if (grid < 0) return;
    if (hipMemsetAsync((char*)d_ws + WS_CTL, 0, CTL_ZERO_BYTES, stream) != hipSuccess) { fprintf(stderr, "kernel_launch: memset failed\n"); return; }
    Args a{};
    for (int i = 0; i < 21; ++i) a.in[i] = (const float*)d_in[i];
    a.out = (float*)d_out; a.ws = (unsigned char*)d_ws;
    hipLaunchKernelGGL(fwd_megakernel, dim3(grid), dim3(NWAVES * 64), LDS_BYTES, stream, a);
    const hipError_t le = hipPeekAtLastError();
    if (le != hipSuccess) fprintf(stderr, "kernel_launch: launch failed: %s\n", hipGetErrorName(le));
}
```
